# Optimizing an MI355X kernel written in HIP

```python
import jax, jax.numpy as jnp
from jax import lax
import numpy as np

D_MODEL = 2048
BATCH = 2
SEQ = 16384
DEPTH = 1

FOX_HEADS = 8
FOX_HEAD_DIM = 128
FOX_WIDTH = FOX_HEADS * FOX_HEAD_DIM
ATTN_BLOCK = 128
MLSTM_HEADS = 4
MLSTM_QK_DIM = 128
MLSTM_V_DIM = 256
MLSTM_QK_WIDTH = MLSTM_HEADS * MLSTM_QK_DIM
MLSTM_V_WIDTH = MLSTM_HEADS * MLSTM_V_DIM
MLSTM_CONV = 4
MLSTM_CHUNK = 128
MIX_WIDTH = FOX_WIDTH + MLSTM_V_WIDTH
IN_SPLITS = (FOX_WIDTH, FOX_WIDTH, FOX_WIDTH, FOX_HEADS, MLSTM_QK_WIDTH, MLSTM_QK_WIDTH, MLSTM_V_WIDTH, MLSTM_HEADS, MLSTM_HEADS, MLSTM_V_WIDTH)
IN_WIDTH = 3 * FOX_WIDTH + FOX_HEADS + 2 * MLSTM_QK_WIDTH + 2 * MLSTM_V_WIDTH + 2 * MLSTM_HEADS
PEER_HEADS = 8
PEER_KEY_DIM = 256
PEER_N_KEYS = 128
PEER_TOPK = 16
PEER_N_EXPERTS = PEER_N_KEYS * PEER_N_KEYS
PEER_TOKEN_BLOCK = 128
NORM_EPS = 1e-6

kernel_name = "fox_mlstm_peer_hybrid_block"


def rmsnorm(x, w):
    xf = x.astype(jnp.float32)
    y = xf * lax.rsqrt(jnp.mean(xf * xf, axis=-1, keepdims=True) + NORM_EPS)
    return (y * w).astype(x.dtype)


def head_rmsnorm(h, w):
    B, S, H, dh = h.shape
    hf = h.astype(jnp.float32)
    hf = hf * lax.rsqrt(jnp.mean(hf * hf, axis=-1, keepdims=True) + NORM_EPS)
    return (hf.reshape(B, S, H * dh) * w).astype(h.dtype)


def causal_depthwise_conv(x, w, b):
    K = w.shape[0]
    S = x.shape[1]
    xp = jnp.pad(x, ((0, 0), (K - 1, 0), (0, 0)))
    y = b
    for j in range(K):
        y = y + w[j] * xp[:, j:j + S]
    return y


def forgetting_attention(q, k, v, f_logit):
    B, S, H, Dh = q.shape
    nb = S // ATTN_BLOCK
    F = jnp.cumsum(jax.nn.log_sigmoid(f_logit.astype(jnp.float32)), axis=1).transpose(0, 2, 1)
    qh = q.transpose(0, 2, 1, 3) * (Dh ** -0.5)
    kh = k.transpose(0, 2, 1, 3)
    vh = v.transpose(0, 2, 1, 3)
    q_blocks = qh.reshape(B, H, nb, ATTN_BLOCK, Dh).transpose(2, 0, 1, 3, 4)
    F_blocks = F.reshape(B, H, nb, ATTN_BLOCK).transpose(2, 0, 1, 3)
    q_pos = jnp.arange(S).reshape(nb, ATTN_BLOCK)
    k_pos = jnp.arange(S)

    def block(args):
        qb, Fb, pos = args
        s = jnp.einsum('bhqd,bhkd->bhqk', qb, kh, preferred_element_type=jnp.float32)
        s = s + Fb[..., :, None] - F[..., None, :]
        s = jnp.where(pos[:, None] >= k_pos[None, :], s, -jnp.inf)
        p = jax.nn.softmax(s, axis=-1)
        return jnp.einsum('bhqk,bhkd->bhqd', p.astype(vh.dtype), vh)

    out = lax.map(block, (q_blocks, F_blocks, q_pos))
    return out.transpose(1, 0, 3, 2, 4).reshape(B, S, H, Dh)


def mlstm_chunkwise(q, k, v, i_pre, f_pre):
    B, S, H, dk = q.shape
    dv = v.shape[-1]
    L = MLSTM_CHUNK
    nc = S // L
    f32 = jnp.float32

    def to_chunks(a):
        a = jnp.moveaxis(a, 2, 1)
        return a.reshape(B, H, nc, L, *a.shape[3:])

    qc = to_chunks(q).astype(f32)
    kc = to_chunks(k).astype(f32) * (dk ** -0.5)
    vc = to_chunks(v).astype(f32)
    ic = to_chunks(i_pre).astype(f32)
    b = jnp.cumsum(jax.nn.log_sigmoid(to_chunks(f_pre).astype(f32)), axis=-1)
    b_last = b[..., -1]

    w_end = b_last[..., None] - b + ic
    m_loc = jnp.max(w_end, axis=-1)
    a_end = jnp.exp(w_end - m_loc[..., None])
    C_loc = jnp.einsum('bhcl,bhcld,bhcle->bhcde', a_end, kc, vc)
    n_loc = jnp.einsum('bhcl,bhcld->bhcd', a_end, kc)

    def step(carry, inp):
        C, n, m = carry
        Cl, nl, ml, bl = inp
        m_new = jnp.maximum(bl + m, ml)
        a_prev = jnp.exp(bl + m - m_new)
        a_loc = jnp.exp(ml - m_new)
        C_new = a_prev[..., None, None] * C + a_loc[..., None, None] * Cl
        n_new = a_prev[..., None] * n + a_loc[..., None] * nl
        return (C_new, n_new, m_new), (C, n, m)

    init = (jnp.zeros((B, H, dk, dv), f32), jnp.zeros((B, H, dk), f32), jnp.zeros((B, H), f32))
    xs = (jnp.moveaxis(C_loc, 2, 0), jnp.moveaxis(n_loc, 2, 0), jnp.moveaxis(m_loc, 2, 0), jnp.moveaxis(b_last, 2, 0))
    _, (C_prev, n_prev, m_prev) = lax.scan(step, init, xs)
    C_prev = jnp.moveaxis(C_prev, 0, 2)
    n_prev = jnp.moveaxis(n_prev, 0, 2)
    m_prev = jnp.moveaxis(m_prev, 0, 2)

    g = b + m_prev[..., None]
    D = b[..., :, None] - b[..., None, :] + ic[..., None, :]
    causal = jnp.tril(jnp.ones((L, L), dtype=bool))
    D = jnp.where(causal, D, -jnp.inf)
    m_t = jnp.maximum(g, jnp.max(D, axis=-1))
    Sm = jnp.einsum('bhctd,bhcsd->bhcts', qc, kc) * jnp.exp(D - m_t[..., None])
    inter = jnp.exp(g - m_t)
    num = jnp.einsum('bhcts,bhcse->bhcte', Sm, vc) + inter[..., None] * jnp.einsum('bhctd,bhcde->bhcte', qc, C_prev)
    den = jnp.sum(Sm, axis=-1) + inter * jnp.einsum('bhctd,bhcd->bhct', qc, n_prev)
    h = num / jnp.maximum(jnp.abs(den), jnp.exp(-m_t))[..., None]
    return h.reshape(B, H, S, dv).transpose(0, 2, 1, 3).astype(v.dtype)


def peer_ffn(x, w_q, keys, u, v):
    B, S, D = x.shape
    T = B * S
    xt = x.reshape(T, D)
    q = (xt @ w_q).reshape(T, PEER_HEADS, 2, PEER_KEY_DIM // 2)
    scores = jnp.einsum('thpd,pnd->thpn', q, keys, preferred_element_type=jnp.float32)
    s_top, i_top = lax.top_k(scores, PEER_TOPK)
    cand = (s_top[:, :, 0, :, None] + s_top[:, :, 1, None, :]).reshape(T, PEER_HEADS, PEER_TOPK * PEER_TOPK)
    cand_idx = (i_top[:, :, 0, :, None] * PEER_N_KEYS + i_top[:, :, 1, None, :]).reshape(T, PEER_HEADS, PEER_TOPK * PEER_TOPK)
    s_fin, pos = lax.top_k(cand, PEER_TOPK)
    idx = jnp.take_along_axis(cand_idx, pos, axis=-1)
    gate = jax.nn.softmax(s_fin, axis=-1)
    nblk = T // PEER_TOKEN_BLOCK

    def blk(args):
        xb, ib, gb = args
        ub = jnp.take(u, ib, axis=0)
        act = jax.nn.gelu(jnp.einsum('thkd,td->thk', ub, xb, preferred_element_type=jnp.float32), approximate=False) * gb
        vb = jnp.take(v, ib, axis=0)
        return jnp.einsum('thk,thkd->td', act.astype(vb.dtype), vb)

    y = lax.map(blk, (xt.reshape(nblk, PEER_TOKEN_BLOCK, D),
                      idx.reshape(nblk, PEER_TOKEN_BLOCK, PEER_HEADS, PEER_TOPK),
                      gate.reshape(nblk, PEER_TOKEN_BLOCK, PEER_HEADS, PEER_TOPK)))
    return y.reshape(B, S, D)


def setup_inputs(seed: int = 0) -> dict:
    key = jax.random.key(seed)
    ks = jax.random.split(key, 18)
    f32 = jnp.float32

    def nrm(k, shape, scale):
        return jax.random.normal(k, shape, f32) * scale

    return {
        "x": nrm(ks[0], (BATCH, SEQ, D_MODEL), 1.0),
        "norm1_w": 1.0 + nrm(ks[1], (DEPTH, D_MODEL), 0.02),
        "w_in": nrm(ks[2], (DEPTH, D_MODEL, IN_WIDTH), D_MODEL ** -0.5),
        "fox_f_bias": jnp.linspace(2.0, 6.0, FOX_HEADS, dtype=f32)[None] + nrm(ks[3], (DEPTH, FOX_HEADS), 0.1),
        "mlstm_conv_w": nrm(ks[4], (DEPTH, MLSTM_CONV, 2 * MLSTM_QK_WIDTH), MLSTM_CONV ** -0.5),
        "mlstm_conv_b": nrm(ks[5], (DEPTH, 2 * MLSTM_QK_WIDTH), 0.01),
        "mlstm_i_bias": nrm(ks[6], (DEPTH, MLSTM_HEADS), 0.1),
        "mlstm_f_bias": jnp.linspace(3.0, 6.0, MLSTM_HEADS, dtype=f32)[None] + nrm(ks[7], (DEPTH, MLSTM_HEADS), 0.1),
        "fox_out_norm_w": 1.0 + nrm(ks[8], (DEPTH, FOX_WIDTH), 0.02),
        "mlstm_out_norm_w": 1.0 + nrm(ks[9], (DEPTH, MLSTM_V_WIDTH), 0.02),
        "w_out": nrm(ks[10], (DEPTH, MIX_WIDTH, D_MODEL), MIX_WIDTH ** -0.5),
        "norm2_w": 1.0 + nrm(ks[11], (DEPTH, D_MODEL), 0.02),
        "peer_w_q": nrm(ks[12], (DEPTH, D_MODEL, PEER_HEADS * PEER_KEY_DIM), D_MODEL ** -0.5),
        "peer_keys": nrm(ks[13], (DEPTH, 2, PEER_N_KEYS, PEER_KEY_DIM // 2), (PEER_KEY_DIM // 2) ** -0.5),
        "peer_u": nrm(ks[14], (DEPTH, PEER_N_EXPERTS, D_MODEL), D_MODEL ** -0.5),
        "peer_v": nrm(ks[15], (DEPTH, PEER_N_EXPERTS, D_MODEL), PEER_HEADS ** -0.5),
        "final_norm_w": 1.0 + nrm(ks[16], (D_MODEL,), 0.02),
    }


def reference(x, norm1_w, w_in, fox_f_bias, mlstm_conv_w, mlstm_conv_b, mlstm_i_bias, mlstm_f_bias,
              fox_out_norm_w, mlstm_out_norm_w, w_out, norm2_w, peer_w_q, peer_keys, peer_u, peer_v,
              final_norm_w):
    B, S, _ = x.shape
    split_points = [int(p) for p in np.cumsum(IN_SPLITS)[:-1]]
    for l in range(DEPTH):
        h = rmsnorm(x, norm1_w[l])
        z = h @ w_in[l]
        fq, fk, fv, ff, mq, mk, mv, mi, mf, mo = jnp.split(z, split_points, axis=-1)

        att = forgetting_attention(fq.reshape(B, S, FOX_HEADS, FOX_HEAD_DIM),
                                   fk.reshape(B, S, FOX_HEADS, FOX_HEAD_DIM),
                                   fv.reshape(B, S, FOX_HEADS, FOX_HEAD_DIM),
                                   ff + fox_f_bias[l])

        mqk = jax.nn.silu(causal_depthwise_conv(jnp.concatenate([mq, mk], axis=-1), mlstm_conv_w[l], mlstm_conv_b[l]))
        mq_c, mk_c = jnp.split(mqk, 2, axis=-1)
        cell = mlstm_chunkwise(mq_c.reshape(B, S, MLSTM_HEADS, MLSTM_QK_DIM),
                               mk_c.reshape(B, S, MLSTM_HEADS, MLSTM_QK_DIM),
                               mv.reshape(B, S, MLSTM_HEADS, MLSTM_V_DIM),
                               mi + mlstm_i_bias[l], mf + mlstm_f_bias[l])
        cell = jax.nn.sigmoid(mo.astype(jnp.float32)).astype(cell.dtype).reshape(B, S, MLSTM_HEADS, MLSTM_V_DIM) * cell

        mixed = jnp.concatenate([head_rmsnorm(att, fox_out_norm_w[l]),
                                 head_rmsnorm(cell, mlstm_out_norm_w[l])], axis=-1)
        x = x + mixed @ w_out[l]

        x = x + peer_ffn(rmsnorm(x, norm2_w[l]), peer_w_q[l], peer_keys[l], peer_u[l], peer_v[l])
    return rmsnorm(x, final_norm_w)
```

```cpp
#include <hip/hip_runtime.h>
#include <hip/hip_bf16.h>
#include <cstdio>
#include <cstdint>
namespace pg8 {
#define PG8_LAS __attribute__((address_space(3)))
typedef unsigned short bf16_t;
typedef short bf16x8 __attribute__((ext_vector_type(8)));
typedef float f32x4 __attribute__((ext_vector_type(4)));
typedef unsigned u32x4 __attribute__((ext_vector_type(4)));
constexpr int BM = 256, BK = 64, HALF = 128, HTB = HALF * BK * 2  , STAGE_BYTES = 8 * HTB, NXCD = 8, WGM = 8;

__host__ __device__ __forceinline__ int lds_byte(int r, int c) { const int st = (r >> 4) * 2 + (c >> 5), rr = r & 15, cc = c & 31, ob = rr * 64 + cc * 2; return st * 1024 + (ob ^ (((ob >> 9) & 1) << 5)); }
__host__ __device__ __forceinline__ void stage_rc(int b, int& R, int& C) { const int st = b / 1024, sb = b % 1024, swz = sb ^ (((sb >> 9) & 1) << 5); R = (st >> 1) * 16 + swz / 64; C = (st & 1) * 32 + (swz % 64) / 2; }
__host__ __device__ __forceinline__ int perm32(int rho) { const int n = rho >> 4, i = rho & 15; return 8 * (i >> 2) + 4 * n + (i & 3); }

struct Unit { int pm, pn; };
struct Gemm { const bf16_t* A; const bf16_t* Bt; int M, N, K; };

struct StaticOrder {
    int nM, nN, nwg, G, c;
    __host__ __device__ void init(int M, int N, int G_, int c_) { nM = M / BM; nN = N / BM; nwg = nM * nN; G = G_; c = c_; }
    __host__ __device__ bool next(int i, Unit& u) const {
        const long L = (long)i * G + c; if (L >= nwg) return false;
        int wgid = (int)L; { const int q = nwg / NXCD, r = nwg % NXCD, xcd = wgid % NXCD, off = wgid / NXCD; wgid = (xcd < r ? xcd * (q + 1) : r * (q + 1) + (xcd - r) * q) + off; }
        const int nig = WGM * nN, gid = wgid / nig, fm = gid * WGM, gsz = (nM - fm) < WGM ? (nM - fm) : WGM;
        u.pm = fm + ((wgid % nig) % gsz); u.pn = (wgid % nig) / gsz; return true;
    }
    __device__ __forceinline__ void a_ready(const Unit&) const {}
    __device__ __forceinline__ void done(const Unit&) const {}
};

__device__ __forceinline__ unsigned cvt_pk_bf16(float lo, float hi) { unsigned r; asm volatile("v_cvt_pk_bf16_f32 %0, %1, %2" : "=v"(r) : "v"(lo), "v"(hi)); return r; }
typedef float f32x2 __attribute__((ext_vector_type(2)));
__device__ __forceinline__ f32x2 gelu_pk(f32x2 v) {
    const f32x2 av = __builtin_elementwise_abs(v), d = av * 0.2316418882f + 1.0f;
    f32x2 t; t.x = __builtin_amdgcn_rcpf(d.x); t.y = __builtin_amdgcn_rcpf(d.y);
    f32x2 q = t * 0.5307027145f + (-0.7265760135f); q = q * t + 0.7107068705f; q = q * t + (-0.142248368f); q = q * t + 0.127414796f; q = q * t;
    const f32x2 s = (v * v) * (-0.72134752044f);
    f32x2 e; e.x = __builtin_amdgcn_exp2f(s.x); e.y = __builtin_amdgcn_exp2f(s.y);
    const f32x2 m = v * (q * e), r = v - m;
    f32x2 o; o.x = v.x < 0.f ? m.x : r.x; o.y = v.y < 0.f ? m.y : r.y; return o;
}

template <int ACT  > struct EpiBf16 {
    static constexpr bool PERM = true, AFTER_DRAIN = false; static_assert(ACT == 0 || ACT == 1, "EpiBf16: ACT is 0 (none) or 1 (gelu_pk)");
    bf16_t* O; int ldc; const float* bias; int split_cols; size_t split_stride; float scale0;
    __device__ __forceinline__ void operator()(const f32x4 (&acc)[2][2][4][2], const Unit& u, int wr, int wc, int fr, int fq) const {
        const int row0 = u.pm * BM + wr * 64 + fr; int colt = u.pn * BM; bf16_t* base = O;
        float sc = 1.f; if (split_cols) { const int t = colt / split_cols; base += (size_t)t * split_stride; colt -= t * split_cols; if (t == 0) sc = scale0; }
        const int col0 = colt + wc * 32 + 8 * fq, bcol0 = u.pn * BM + wc * 32 + 8 * fq;
        f32x4 bv[2][2];
#pragma unroll
        for (int bj = 0; bj < 2; ++bj)
#pragma unroll
            for (int n = 0; n < 2; ++n) bv[bj][n] = bias ? *(const f32x4*)(bias + bcol0 + bj * HALF + 4 * n) : (f32x4){0.f, 0.f, 0.f, 0.f};
#pragma unroll
        for (int ai = 0; ai < 2; ++ai)
#pragma unroll
            for (int m = 0; m < 4; ++m) { bf16_t* rowp = base + (size_t)(row0 + ai * HALF + m * 16) * ldc + col0;
#pragma unroll
                for (int bj = 0; bj < 2; ++bj) { f32x4 v0 = acc[ai][bj][m][0] + bv[bj][0], v1 = acc[ai][bj][m][1] + bv[bj][1];
                    if (ACT == 1) { f32x2 a = gelu_pk((f32x2){v0[0], v0[1]}), b = gelu_pk((f32x2){v0[2], v0[3]}), c = gelu_pk((f32x2){v1[0], v1[1]}), d = gelu_pk((f32x2){v1[2], v1[3]});
                        v0 = (f32x4){a.x, a.y, b.x, b.y}; v1 = (f32x4){c.x, c.y, d.x, d.y}; }
                    v0 = v0 * sc; v1 = v1 * sc; u32x4 w; w.x = cvt_pk_bf16(v0[0], v0[1]); w.y = cvt_pk_bf16(v0[2], v0[3]); w.z = cvt_pk_bf16(v1[0], v1[1]); w.w = cvt_pk_bf16(v1[2], v1[3]);
                    *(u32x4*)(rowp + bj * HALF) = w; } }
    }
};

struct EpiZ {
    static constexpr bool PERM = true, AFTER_DRAIN = false;
    unsigned char* ws; size_t off_fq, off_mq, off_mv, off_gates;
    __device__ __forceinline__ void operator()(const f32x4 (&acc)[2][2][4][2], const Unit& u, int wr, int wc, int fr, int fq) const {
        const int pn = u.pn, row0 = u.pm * BM + wr * 64 + fr;
        if (pn < 12) {
            bf16_t* base = (bf16_t*)(ws + off_fq + ((size_t)(pn >> 2) << 26)); const int hp = (pn & 3) * 2, d = wc * 32 + 8 * fq;
#pragma unroll
            for (int ai = 0; ai < 2; ++ai)
#pragma unroll
                for (int m = 0; m < 4; ++m) { const int row = row0 + ai * HALF + m * 16, b = row >> 14, s = row & 16383;
#pragma unroll
                    for (int bj = 0; bj < 2; ++bj) { const f32x4 v0 = acc[ai][bj][m][0], v1 = acc[ai][bj][m][1];
                        u32x4 w; w.x = cvt_pk_bf16(v0[0], v0[1]); w.y = cvt_pk_bf16(v0[2], v0[3]); w.z = cvt_pk_bf16(v1[0], v1[1]); w.w = cvt_pk_bf16(v1[2], v1[3]);
                        *(u32x4*)(base + ((size_t)(b * 8 + hp + bj) * 16384 + s) * 128 + d) = w; } }
        } else if (pn < 24) {
            const bool isqk = pn < 16;
            const size_t boff = isqk ? off_mq + ((size_t)((pn - 12) >> 1) << 25) : off_mv + ((size_t)((pn - 16) >> 2) << 26);
            bf16_t* base = (bf16_t*)(ws + boff); const int ld = isqk ? 512 : 1024, cb = isqk ? ((pn - 12) & 1) * 256 : ((pn - 16) & 3) * 256;
            const int col0 = cb + wc * 32 + 8 * fq;
#pragma unroll
            for (int ai = 0; ai < 2; ++ai)
#pragma unroll
                for (int m = 0; m < 4; ++m) { bf16_t* rowp = base + (size_t)(row0 + ai * HALF + m * 16) * ld + col0;
#pragma unroll
                    for (int bj = 0; bj < 2; ++bj) { const f32x4 v0 = acc[ai][bj][m][0], v1 = acc[ai][bj][m][1];
                        u32x4 w; w.x = cvt_pk_bf16(v0[0], v0[1]); w.y = cvt_pk_bf16(v0[2], v0[3]); w.z = cvt_pk_bf16(v1[0], v1[1]); w.w = cvt_pk_bf16(v1[2], v1[3]);
                        *(u32x4*)(rowp + bj * HALF) = w; } }
        } else {
            if (wc == 0 && fq < 2) {
#pragma unroll
                for (int ai = 0; ai < 2; ++ai)
#pragma unroll
                    for (int m = 0; m < 4; ++m) { float* rowp = (float*)(ws + off_gates) + (size_t)(row0 + ai * HALF + m * 16) * 16 + 8 * fq;
                        *(f32x4*)rowp = acc[ai][0][m][0]; *(f32x4*)(rowp + 4) = acc[ai][0][m][1]; }
            }
        }
    }
};
struct EpiRes {
    static constexpr bool PERM = true, AFTER_DRAIN = false;
    const float* res; float* O; int ldc;
    __device__ __forceinline__ void operator()(const f32x4 (&acc)[2][2][4][2], const Unit& u, int wr, int wc, int fr, int fq) const {
        const int row0 = u.pm * BM + wr * 64 + fr, col0 = u.pn * BM + wc * 32 + 8 * fq;
#pragma unroll
        for (int ai = 0; ai < 2; ++ai)
#pragma unroll
            for (int m = 0; m < 4; ++m) { const size_t off = (size_t)(row0 + ai * HALF + m * 16) * ldc + col0;
#pragma unroll
                for (int bj = 0; bj < 2; ++bj) { const f32x4 r0 = *(const f32x4*)(res + off + bj * HALF), r1 = *(const f32x4*)(res + off + bj * HALF + 4);
                    *(f32x4*)(O + off + bj * HALF) = acc[ai][bj][m][0] + r0; *(f32x4*)(O + off + bj * HALF + 4) = acc[ai][bj][m][1] + r1; } }
    }
};
template <class Epi, class Sched, bool ALIGN_EPI = false, bool SP2 = false>
__device__ __forceinline__ void gemm_phase(PG8_LAS unsigned char* lds, const Gemm g, const Sched& S, const Epi& E) {
    const int tid = threadIdx.x, wid = __builtin_amdgcn_readfirstlane(tid >> 6), lane = tid & 63, wr = wid >> 2, wc = wid & 3, fr = lane & 15, fq = lane >> 4;
    const int K = g.K, nt = K / BK;
    unsigned voffA[2], voffB[2];
#pragma unroll
    for (int i = 0; i < 2; ++i) { int R, C; stage_rc(tid * 16 + i * 8192, R, C); const int Rb = Epi::PERM ? ((R & ~31) + perm32(R & 31)) : R;
        voffA[i] = (unsigned)(R * K + C) * 2u; voffB[i] = (unsigned)(Rb * K + C) * 2u; }
    const size_t kstep = (size_t)(BK * 2);
    const size_t hstep = (size_t)HALF * K * 2;
    const size_t tstep = 2 * hstep;
    const unsigned ldsw = (unsigned)wid * 1024u;
    const int aoff = lds_byte(wr * 64 + fr, fq * 8), boff = lds_byte(wc * 32 + fr, fq * 8);
#define PG8_SA(b, h) (((b) * 2 + (h)) * HTB)
#define PG8_SB(b, h) ((4 + (b) * 2 + (h)) * HTB)
#define PG8_STAGE(bufoff, gbase, voff) do { _Pragma("unroll") for (int _i = 0; _i < 2; ++_i) \
        __builtin_amdgcn_global_load_lds((const unsigned*)((const char*)(gbase) + (voff)[_i]), (PG8_LAS unsigned*)(lds + (bufoff) + ldsw + _i * 8192), 16, 0, 0); } while (0)
#define PG8_LDA(dst, b, h) do { _Pragma("unroll") for (int m = 0; m < 4; ++m) _Pragma("unroll") for (int k = 0; k < 2; ++k) dst[m][k] = *(const PG8_LAS bf16x8*)(lds + PG8_SA(b, h) + aoff + m * 2048 + k * 1024); } while (0)
#define PG8_LDB(dst, b, h) do { _Pragma("unroll") for (int n = 0; n < 2; ++n) _Pragma("unroll") for (int k = 0; k < 2; ++k) dst[n][k] = *(const PG8_LAS bf16x8*)(lds + PG8_SB(b, h) + boff + n * 2048 + k * 1024); } while (0)
#define PG8_MMA(ai, bj, At, Bt) do { __builtin_amdgcn_s_setprio(1); _Pragma("unroll") for (int m = 0; m < 4; ++m) _Pragma("unroll") for (int n = 0; n < 2; ++n) _Pragma("unroll") for (int k = 0; k < 2; ++k) \
        acc[ai][bj][m][n] = __builtin_amdgcn_mfma_f32_16x16x32_bf16(Bt[n][k], At[m][k], acc[ai][bj][m][n], 0, 0, 0); __builtin_amdgcn_s_setprio(0); } while (0)
#define PG8_WAIT_V(n) asm volatile("s_waitcnt vmcnt(" #n ")" ::: "memory")
#define PG8_WAIT_L(n) asm volatile("s_waitcnt lgkmcnt(" #n ")" ::: "memory")
#define PG8_BAR __builtin_amdgcn_s_barrier()
#define PG8_SCHED __builtin_amdgcn_sched_barrier(0)
    Unit cur, nxt; int ui = 0;
    if (!S.next(0, cur)) return;
    f32x4 acc[2][2][4][2];
#pragma unroll
    for (int a = 0; a < 2; ++a)
#pragma unroll
        for (int b = 0; b < 2; ++b)
#pragma unroll
            for (int m = 0; m < 4; ++m)
#pragma unroll
                for (int n = 0; n < 2; ++n) acc[a][b][m][n] = (f32x4){0.f, 0.f, 0.f, 0.f};
    bf16x8 At[4][2], B0[2][2], B1[2][2];
    const char* cA = (const char*)g.A + (size_t)cur.pm * tstep; const char* cB = (const char*)g.Bt + (size_t)cur.pn * tstep;
    S.a_ready(cur);
    if constexpr (SP2) {
        PG8_STAGE(PG8_SB(0, 0), cB, voffB); PG8_STAGE(PG8_SB(0, 1), cB + hstep, voffB); PG8_STAGE(PG8_SA(0, 0), cA, voffA); PG8_STAGE(PG8_SA(0, 1), cA + hstep, voffA);
        if (wr == 1) PG8_BAR;
        PG8_WAIT_V(2); PG8_BAR;
        PG8_STAGE(PG8_SB(1, 0), cB + kstep, voffB); PG8_STAGE(PG8_SA(1, 0), cA + kstep, voffA); PG8_STAGE(PG8_SB(1, 1), cB + hstep + kstep, voffB);
        PG8_WAIT_V(6); PG8_BAR;
    } else {
        PG8_STAGE(PG8_SB(0, 0), cB, voffB); PG8_STAGE(PG8_SA(0, 0), cA, voffA); PG8_STAGE(PG8_SB(0, 1), cB + hstep, voffB); PG8_STAGE(PG8_SA(0, 1), cA + hstep, voffA);
        if (wr == 1) PG8_BAR;
        PG8_WAIT_V(4); PG8_BAR;
        PG8_STAGE(PG8_SB(1, 0), cB + kstep, voffB); PG8_STAGE(PG8_SA(1, 0), cA + kstep, voffA); PG8_STAGE(PG8_SB(1, 1), cB + hstep + kstep, voffB);
        PG8_WAIT_V(6); PG8_BAR;
    }
    for (;;) {
        const bool has_next = S.next(ui + 1, nxt);
        const char* nA = has_next ? (const char*)g.A + (size_t)nxt.pm * tstep : cA; const char* nB = has_next ? (const char*)g.Bt + (size_t)nxt.pn * tstep : cB;
        for (int t = 0; t < nt; t += 2) {
            const bool last = (t == nt - 2);
            const char* a1 = cA + (size_t)(t + 1) * kstep;
            const char* a2 = last ? nA : cA + (size_t)(t + 2) * kstep; const char* b2 = last ? nB : cB + (size_t)(t + 2) * kstep;
            const char* a3 = a2 + kstep; const char* b3 = b2 + kstep;
            if (last && has_next) S.a_ready(nxt);
            if constexpr (SP2) {
            PG8_LDB(B0, 0, 0); PG8_LDB(B1, 0, 1); PG8_SCHED; PG8_LDA(At, 0, 0); PG8_STAGE(PG8_SA(1, 1), a1 + hstep, voffA);
            PG8_WAIT_V(8); PG8_WAIT_L(0); PG8_BAR; PG8_MMA(0, 0, At, B0); PG8_MMA(0, 1, At, B1); PG8_BAR; PG8_SCHED;
            PG8_LDA(At, 0, 1); PG8_STAGE(PG8_SB(0, 0), b2, voffB); PG8_STAGE(PG8_SB(0, 1), b2 + hstep, voffB); PG8_STAGE(PG8_SA(0, 0), a2, voffA);
            PG8_WAIT_V(8); PG8_WAIT_L(0); PG8_BAR; PG8_MMA(1, 0, At, B0); PG8_MMA(1, 1, At, B1); PG8_BAR; PG8_SCHED;
            PG8_LDB(B0, 1, 0); PG8_LDB(B1, 1, 1); PG8_SCHED; PG8_LDA(At, 1, 0); PG8_STAGE(PG8_SA(0, 1), a2 + hstep, voffA);
            PG8_WAIT_V(8); PG8_WAIT_L(0); PG8_BAR; PG8_MMA(0, 0, At, B0); PG8_MMA(0, 1, At, B1); PG8_BAR; PG8_SCHED;
            PG8_LDA(At, 1, 1); PG8_STAGE(PG8_SB(1, 0), b3, voffB); PG8_STAGE(PG8_SB(1, 1), b3 + hstep, voffB); PG8_STAGE(PG8_SA(1, 0), a3, voffA);
            PG8_WAIT_V(8); PG8_WAIT_L(0); PG8_BAR; PG8_MMA(1, 0, At, B0); PG8_MMA(1, 1, At, B1); PG8_BAR; PG8_SCHED;
            } else {
            PG8_LDB(B0, 0, 0); PG8_SCHED; PG8_LDA(At, 0, 0); PG8_STAGE(PG8_SA(1, 1), a1 + hstep, voffA);
            PG8_WAIT_L(8); PG8_BAR; PG8_WAIT_L(0); PG8_MMA(0, 0, At, B0); PG8_BAR; PG8_SCHED;
            PG8_LDB(B1, 0, 1); PG8_STAGE(PG8_SB(0, 0), b2, voffB);
            PG8_BAR; PG8_WAIT_L(0); PG8_MMA(0, 1, At, B1); PG8_BAR;
            PG8_LDA(At, 0, 1); PG8_STAGE(PG8_SA(0, 0), a2, voffA);
            PG8_BAR; PG8_WAIT_L(0); PG8_MMA(1, 0, At, B0); PG8_BAR; PG8_SCHED;
            PG8_STAGE(PG8_SB(0, 1), b2 + hstep, voffB);
            PG8_WAIT_V(6); PG8_BAR; PG8_MMA(1, 1, At, B1); PG8_BAR;
            PG8_LDB(B0, 1, 0); PG8_SCHED; PG8_LDA(At, 1, 0); PG8_STAGE(PG8_SA(0, 1), a2 + hstep, voffA);
            PG8_WAIT_L(8); PG8_BAR; PG8_WAIT_L(0); PG8_MMA(0, 0, At, B0); PG8_BAR; PG8_SCHED;
            PG8_LDB(B1, 1, 1); PG8_STAGE(PG8_SB(1, 0), b3, voffB);
            PG8_BAR; PG8_WAIT_L(0); PG8_MMA(0, 1, At, B1); PG8_BAR;
            PG8_LDA(At, 1, 1); PG8_STAGE(PG8_SA(1, 0), a3, voffA);
            PG8_BAR; PG8_WAIT_L(0); PG8_MMA(1, 0, At, B0); PG8_BAR; PG8_SCHED;
            PG8_STAGE(PG8_SB(1, 1), b3 + hstep, voffB);
            PG8_WAIT_V(6); PG8_BAR; PG8_MMA(1, 1, At, B1); PG8_BAR;
            }
        }
        if constexpr (ALIGN_EPI) { if (wr == 0) PG8_BAR; }
        if constexpr (!Epi::AFTER_DRAIN) { E(acc, cur, wr, wc, fr, fq); S.done(cur); }
        if (!has_next) break;
#pragma unroll
        for (int a = 0; a < 2; ++a)
#pragma unroll
            for (int b = 0; b < 2; ++b)
#pragma unroll
                for (int m = 0; m < 4; ++m)
#pragma unroll
                    for (int n = 0; n < 2; ++n) acc[a][b][m][n] = (f32x4){0.f, 0.f, 0.f, 0.f};
        cur = nxt; cA = nA; cB = nB; ++ui;
        if constexpr (ALIGN_EPI) { if (wr == 1) PG8_BAR; }
    }
    PG8_WAIT_V(0);
    if constexpr (!ALIGN_EPI) { if (wr == 0) PG8_BAR; }
    PG8_BAR;
    if constexpr (Epi::AFTER_DRAIN) { E.fused(acc, cur, wr, wc, fr, fq, lds, wid, lane); S.done(cur); }
#undef PG8_SA
#undef PG8_SB
#undef PG8_STAGE
#undef PG8_LDA
#undef PG8_LDB
#undef PG8_MMA
#undef PG8_WAIT_V
#undef PG8_WAIT_L
#undef PG8_BAR
#undef PG8_SCHED
}
}
namespace fox {
constexpr int D = 128, OPITCH = 2048;
constexpr bool WSKIP = false;
constexpr float THR = 8.f;
constexpr float SCALE = 0.08838834764831845f;
constexpr float INV_SCALE = 11.313708498984761f;
constexpr int NW = 8, QBLK = 32, KVBLK = 64, QB = NW * QBLK;
constexpr int SHM_V = KVBLK * D * 2, SHM_K = KVBLK * D * 2;
constexpr int LDS_BIAS = 2 * SHM_V + 2 * SHM_K + NW * 64 * 4;
constexpr int LDS_BYTES = LDS_BIAS + 2 * 64 * 4;

using bf16 = __hip_bfloat16;
typedef short bf16x8 __attribute__((ext_vector_type(8)));
typedef short s16x4 __attribute__((ext_vector_type(4)));
typedef float f32x16 __attribute__((ext_vector_type(16)));
typedef float f32x4 __attribute__((ext_vector_type(4)));
typedef unsigned u32x4 __attribute__((ext_vector_type(4)));
template <class A, class Bt> struct same_t { static constexpr bool v = false; };
template <class A> struct same_t<A, A> { static constexpr bool v = true; };

#define KSWZ(row, colB) ((row) * 256 + ((colB) ^ (((row) & 7) << 4)))
#define SBAR() __builtin_amdgcn_sched_barrier(0)
__device__ __forceinline__ int v_st(int k, int c) { const int kk = (k & ~0xC) | ((k & 4) << 1) | ((k & 8) >> 1); return ((kk >> 3) * 4 + (c >> 5)) * 512 + ((kk & 7) * 32 + (c & 31)) * 2; }
__device__ __forceinline__ int v_rd_base(int lane) { return ((lane & 3) << 3) | (((lane >> 2) & 3) << 6) | (((lane >> 4) & 1) << 5) | (((lane >> 5) & 1) << 8); }
constexpr int v_rd_off(int d0, int ks, int half) { return d0 * 512 + ks * 4096 + half * 2048; }
__device__ __forceinline__ int crow(int r, int hi) { return (r & 3) + 8 * (r >> 2) + 4 * hi; }
__device__ __forceinline__ unsigned cvtpk(float lo, float hi) {
    unsigned r; asm volatile("v_cvt_pk_bf16_f32 %0, %1, %2" : "=v"(r) : "v"(lo), "v"(hi)); return r;
}
__device__ __forceinline__ bf16x8 pack8(f32x4 a, f32x4 b) {
    u32x4 w = {cvtpk(a[0], a[1]), cvtpk(a[2], a[3]), cvtpk(b[0], b[1]), cvtpk(b[2], b[3])};
    return *reinterpret_cast<bf16x8*>(&w);
}
template <class T> __device__ __forceinline__ bf16x8 load8(const T* p) {
    if constexpr (same_t<T, float>::v) { return pack8(*(const f32x4*)p, *(const f32x4*)(p + 4)); }
    else { return *reinterpret_cast<const bf16x8*>(p); }
}
__device__ __forceinline__ void mask_tile(f32x16& p0, f32x16& p1, int dq, unsigned W) {
    const float NEG = -__builtin_inff();
#pragma unroll
    for (int r = 0; r < 16; ++r) {
        const int c = (r & 3) + 8 * (r >> 2);
        if ((unsigned)(dq - c) >= W) p0[r] = NEG;
        if ((unsigned)(dq - c - 32) >= W) p1[r] = NEG;
    }
}
__device__ __forceinline__ void partialSM(f32x16& p0, f32x16& p1, float& m_reg, float& mn, float& alpha) {
    float pmax = p0[0]; for (int r = 1; r < 16; ++r) pmax = fmaxf(pmax, p0[r]); for (int r = 0; r < 16; ++r) pmax = fmaxf(pmax, p1[r]);
    { auto rr = __builtin_amdgcn_permlane32_swap(__float_as_uint(pmax), __float_as_uint(pmax), false, false);
      pmax = fmaxf(__uint_as_float(rr[0]), __uint_as_float(rr[1])); }
    constexpr float C2 = 1.4426950408889634f * SCALE;
    if (__builtin_expect(__all((pmax - m_reg) * SCALE <= THR), 1)) { mn = m_reg; alpha = 1.f; }
    else { mn = fmaxf(m_reg, pmax); alpha = __builtin_amdgcn_exp2f((m_reg - mn) * C2); m_reg = mn; }
    const float mnL = -mn * C2;
    for (int r = 0; r < 16; ++r) p0[r] = fmaf(p0[r], C2, mnL); for (int r = 0; r < 16; ++r) p1[r] = fmaf(p1[r], C2, mnL);
    for (int r = 0; r < 16; ++r) p0[r] = __builtin_amdgcn_exp2f(p0[r]);
}
__device__ __forceinline__ void finishSM(f32x16& p0, f32x16& p1, float alpha, float& l_reg, bf16x8& pa0, bf16x8& pa1, bf16x8& pa2, bf16x8& pa3) {
    for (int r = 0; r < 16; ++r) p1[r] = __builtin_amdgcn_exp2f(p1[r]);
    float ps = 0; for (int r = 0; r < 16; ++r) ps += p0[r]; for (int r = 0; r < 16; ++r) ps += p1[r];
    { auto rr = __builtin_amdgcn_permlane32_swap(__float_as_uint(ps), __float_as_uint(ps), false, false);
      ps = __uint_as_float(rr[0]) + __uint_as_float(rr[1]); }
    l_reg = l_reg * alpha + ps;
#define PK4(P, B_, OUT) do { unsigned a0 = cvtpk(P[B_+0], P[B_+1]), a1 = cvtpk(P[B_+2], P[B_+3]);                          \
        unsigned b0 = cvtpk(P[B_+4], P[B_+5]), b1 = cvtpk(P[B_+6], P[B_+7]);                                             \
        auto r0 = __builtin_amdgcn_permlane32_swap(a0, b0, false, false); auto r1 = __builtin_amdgcn_permlane32_swap(a1, b1, false, false); \
        u32x4 w = {r0[0], r1[0], r0[1], r1[1]}; OUT = *reinterpret_cast<bf16x8*>(&w); } while (0)
    PK4(p0, 0, pa0); PK4(p0, 8, pa1); PK4(p1, 0, pa2); PK4(p1, 8, pa3);
#undef PK4
}
template <int KB, bool SK>
__device__ __forceinline__ void qkt(f32x16& p0, f32x16& p1, const char* K_lds, int r32, int hi, const bf16x8* qr, bool act) {
    const float* bl_ = (const float*)(K_lds + 2 * SHM_K + NW * 64 * 4) + KB * 64 + 4 * hi;
    if (SK && !act) { const float NEG = -__builtin_inff();
#pragma unroll
        for (int r = 0; r < 16; ++r) { p0[r] = NEG; p1[r] = NEG; } return; }
#pragma unroll
    for (int g = 0; g < 4; ++g) { const f32x4 v0_ = *(const f32x4*)(bl_ + 8 * g), v1_ = *(const f32x4*)(bl_ + 32 + 8 * g);
        p0[4 * g] = v0_[0]; p0[4 * g + 1] = v0_[1]; p0[4 * g + 2] = v0_[2]; p0[4 * g + 3] = v0_[3];
        p1[4 * g] = v1_[0]; p1[4 * g + 1] = v1_[1]; p1[4 * g + 2] = v1_[2]; p1[4 * g + 3] = v1_[3]; }
    const char* kb[4];
#pragma unroll
    for (int dd = 0; dd < 4; ++dd) kb[dd] = K_lds + KB * SHM_K + KSWZ(r32, (dd * 16 + hi * 8) * 2);
#pragma unroll
    for (int d0 = 0; d0 < 8; ++d0) { const char* a = kb[d0 & 3] + (d0 >> 2) * 128;
        bf16x8 b0 = *reinterpret_cast<const bf16x8*>(a);
        bf16x8 b1 = *reinterpret_cast<const bf16x8*>(a + 32 * 256);
        p0 = __builtin_amdgcn_mfma_f32_32x32x16_bf16(b0, qr[d0], p0, 0, 0, 0);
        p1 = __builtin_amdgcn_mfma_f32_32x32x16_bf16(b1, qr[d0], p1, 0, 0, 0); }
}
template <int VB, bool SK>
__device__ __forceinline__ void pv_tile(f32x16* o, int vb0, bf16x8 pa0, bf16x8 pa1, bf16x8 pa2, bf16x8 pa3, bool act) {
    if (SK && !act) return;
#define TRRD(dst, off) asm volatile("ds_read_b64_tr_b16 %0, %1 offset:%2" : "=&v"(dst) : "v"(vb0), "i"(off) : "memory")
#define PV_D0(d0) do { s16x4 l0, l1, l2, l3, h0, h1, h2, h3; constexpr int b_ = VB * SHM_V + v_rd_off(d0, 0, 0);     \
        TRRD(l0, b_); TRRD(h0, b_ + 2048); TRRD(l1, b_ + 4096); TRRD(h1, b_ + 6144); TRRD(l2, b_ + 8192); TRRD(h2, b_ + 10240); TRRD(l3, b_ + 12288); TRRD(h3, b_ + 14336); \
        asm volatile("s_waitcnt lgkmcnt(0)" ::: "memory"); SBAR();                 \
        o[d0] = __builtin_amdgcn_mfma_f32_32x32x16_bf16(pa0, (bf16x8){l0[0], l0[1], l0[2], l0[3], h0[0], h0[1], h0[2], h0[3]}, o[d0], 0, 0, 0);   \
        o[d0] = __builtin_amdgcn_mfma_f32_32x32x16_bf16(pa1, (bf16x8){l1[0], l1[1], l1[2], l1[3], h1[0], h1[1], h1[2], h1[3]}, o[d0], 0, 0, 0);   \
        o[d0] = __builtin_amdgcn_mfma_f32_32x32x16_bf16(pa2, (bf16x8){l2[0], l2[1], l2[2], l2[3], h2[0], h2[1], h2[2], h2[3]}, o[d0], 0, 0, 0);   \
        o[d0] = __builtin_amdgcn_mfma_f32_32x32x16_bf16(pa3, (bf16x8){l3[0], l3[1], l3[2], l3[3], h3[0], h3[1], h3[2], h3[3]}, o[d0], 0, 0, 0); } while (0)
    PV_D0(0); PV_D0(1); PV_D0(2); PV_D0(3);
#undef PV_D0
#undef TRRD
}

template <class TIn, class TOut> struct BlockRef { const TIn* Q; const TIn* K; const TIn* V; TOut* O; int P0; const float* F; const float* NW_; };
template <class TIn> struct Seam {
    bf16x8 qr[8];
    bf16x8 st_v0, st_v1, st_k0, st_k1; f32x4 sf0, sf1, sf2, sf3;
    f32x4 tq[16];
};
__device__ __forceinline__ int swa_jlo(int P0, int W) { const int lowk = P0 - W + 1; return lowk > 0 ? lowk / KVBLK : 0; }
#define ROW(p, k0, rr) ((p) + (size_t)((k0) + (rr)) * D + sc)
#define VMW() asm volatile("s_waitcnt vmcnt(0)" ::: "memory")
#define VMWN(n) asm volatile("s_waitcnt vmcnt(%0)" :: "i"(n) : "memory")
#define SLOAD_H(Kp, Vp, Fp, k0, bfb) do { S.st_v0 = load8<TIn>(ROW(Vp, k0, sr)); S.st_v1 = load8<TIn>(ROW(Vp, k0, 32 + sr));              \
                         S.st_k0 = load8<TIn>(ROW(Kp, k0, sr)); S.st_k1 = load8<TIn>(ROW(Kp, k0, 32 + sr));                         \
                         if (wid == 0) __builtin_amdgcn_global_load_lds((const unsigned*)((Fp) + (k0) + lane),                          \
                             (__attribute__((address_space(3))) unsigned*)(bias_las + (bfb) * 256), 4, 0, 0); } while (0)
#define SWRITE_HK(bf) do { *(bf16x8*)(K_lds + (bf) * SHM_K + kws) = S.st_k0; *(bf16x8*)(K_lds + (bf) * SHM_K + kws + 32 * 256) = S.st_k1; } while (0)
#define SWRITE_HV(bf) do { *(bf16x8*)(V_lds + (bf) * SHM_V + vst0) = S.st_v0; *(bf16x8*)(V_lds + (bf) * SHM_V + vst1) = S.st_v1; } while (0)
#define SWRITE_H(bf) do { SWRITE_HV(bf); SWRITE_HK(bf); } while (0)
#define SLOAD_F(p, k0) do { S.sf0 = *(const f32x4*)ROW(p, k0, sr); S.sf1 = *(const f32x4*)(ROW(p, k0, sr) + 4);                \
                            S.sf2 = *(const f32x4*)ROW(p, k0, 32 + sr); S.sf3 = *(const f32x4*)(ROW(p, k0, 32 + sr) + 4); } while (0)
#define SWRITE_KF(bf) do { *(bf16x8*)(K_lds + (bf) * SHM_K + kws) = pack8(S.sf0, S.sf1); *(bf16x8*)(K_lds + (bf) * SHM_K + kws + 32 * 256) = pack8(S.sf2, S.sf3); } while (0)
#define SWRITE_VF(bf) do { *(bf16x8*)(V_lds + (bf) * SHM_V + vst0) = pack8(S.sf0, S.sf1); *(bf16x8*)(V_lds + (bf) * SHM_V + vst1) = pack8(S.sf2, S.sf3); } while (0)
template <class TIn, class TOut>
__device__ __forceinline__ void causal_swa_prime(const BlockRef<TIn, TOut>& cur, int W, char* lds, Seam<TIn>& S) {
    constexpr bool F32 = same_t<TIn, float>::v;
    const int tid = threadIdx.x, wid = __builtin_amdgcn_readfirstlane(tid >> 6), lane = tid & 63, r32 = lane & 31, hi = lane >> 5;
    const int sr = tid >> 4, sc = (tid & 15) * 8, kws = KSWZ(sr, sc * 2); char* K_lds = lds + 2 * SHM_V;
    __attribute__((address_space(3))) unsigned char* bias_las = (__attribute__((address_space(3))) unsigned char*)lds + LDS_BIAS;
    const int kb0 = swa_jlo(cur.P0, W) * KVBLK;
    for (int d0 = 0; d0 < 8; ++d0) S.qr[d0] = load8<TIn>(cur.Q + (size_t)(wid * QBLK + r32) * D + d0 * 16 + hi * 8);
    if constexpr (F32) { SLOAD_F((const float*)cur.K, kb0); VMW(); SWRITE_KF(0); SBAR(); SLOAD_F((const float*)cur.V, kb0); }
    else { SLOAD_H(cur.K, cur.V, cur.F, kb0, 0); VMW(); SWRITE_HK(0); }
    __syncthreads();
}
template <class TIn, class TOut>
__device__ __forceinline__ void causal_swa_block(const BlockRef<TIn, TOut>& cur, const BlockRef<TIn, TOut>& nxt, int skv, int W, char* lds, Seam<TIn>& S) {
    constexpr bool F32 = same_t<TIn, float>::v;
    const int tid = threadIdx.x, wid = __builtin_amdgcn_readfirstlane(tid >> 6), lane = tid & 63, r32 = lane & 31, hi = lane >> 5;
    const int j_lo = swa_jlo(cur.P0, W);
    int j_hi = (cur.P0 + QB - 1) / KVBLK + 1; if (j_hi > skv / KVBLK) j_hi = skv / KVBLK;
    const int NT = j_hi - j_lo;
    const int kbn = swa_jlo(nxt.P0, W) * KVBLK;
    const int qlo = cur.P0 + wid * QBLK, qm = qlo + r32 - 4 * hi;
    char* V_lds = lds; char* K_lds = lds + 2 * SHM_V;
    __attribute__((address_space(3))) unsigned char* bias_las = (__attribute__((address_space(3))) unsigned char*)lds + LDS_BIAS;
    float* ws = (float*)(lds + 2 * SHM_V + 2 * SHM_K) + wid * 64; float* li_l = ws, * al_l = ws + 32;
    float m_reg = -1e30f, l_reg = 0; f32x16 o[4] = {};
    const int sr = tid >> 4, sc = (tid & 15) * 8, vst0 = v_st(sr, sc), vst1 = v_st(32 + sr, sc), kws = KSWZ(sr, sc * 2);
    const int vb0 = (int)(uintptr_t)V_lds + v_rd_base(lane);
    const TIn* Kh = cur.K; const TIn* Vh = cur.V; const float* Fh = cur.F;
#define RESC(a) do { if (__any((a) < 1.f)) { if (hi == 0) al_l[r32] = (a); asm volatile("s_waitcnt lgkmcnt(0)" ::: "memory");              \
                     for (int d_ = 0; d_ < 4; ++d_) for (int r = 0; r < 16; ++r) o[d_][r] *= al_l[crow(r, hi)]; } } while (0)
#define KBASE(t) ((j_lo + (t)) * KVBLK)
#define ACT(t) (KBASE(t) <= qlo + QBLK - 1 && KBASE(t) + KVBLK - 1 >= qlo - W + 1)
#define MASKT(P0_, P1_, t) do { const int kb_ = KBASE(t); if ((!SK || ACT(t)) && (kb_ + KVBLK - 1 > qlo || kb_ <= qlo + QBLK - 1 - W)) mask_tile(P0_, P1_, qm - kb_, (unsigned)W); } while (0)
    constexpr int NQL = F32 ? 16 : 8;
    constexpr bool SK = WSKIP && !F32;
#define SEAM_K0() do { VMWN(NQL); if constexpr (F32) { SWRITE_KF(0); SBAR(); SLOAD_F((const float*)nxt.V, kbn); } else { SWRITE_HK(0); } SBAR(); } while (0)
    f32x16 pA0, pA1, pB0, pB1; float mnA, mnB, alA, alB; bf16x8 pa0, pa1, pa2, pa3;
    if constexpr (F32) { VMW(); SWRITE_VF(0); SBAR(); } else { SWRITE_HV(0); SBAR(); }
    if (NT > 1) { if constexpr (F32) SLOAD_F((const float*)Kh, KBASE(1)); else SLOAD_H(Kh, Vh, Fh, KBASE(1), 1); }
    SBAR(); qkt<0, SK>(pA0, pA1, K_lds, r32, hi, S.qr, ACT(0));
    if constexpr (F32) { if (NT > 1) { VMW(); SWRITE_KF(1); SBAR(); SLOAD_F((const float*)Vh, KBASE(1)); } }
    MASKT(pA0, pA1, 0); partialSM(pA0, pA1, m_reg, mnA, alA);
    if (NT > 1) { VMW(); if constexpr (F32) { SWRITE_VF(1); SBAR(); if (NT > 2) SLOAD_F((const float*)Kh, KBASE(2)); } else SWRITE_H(1); }
    __syncthreads();
#define HALF_STEP(PX0, PX1, mnX, alX, PY0, PY1, alY, t, KB, VB, SB) do {                                                      \
        SBAR(); qkt<KB, SK>(PX0, PX1, K_lds, r32, hi, S.qr, ACT(t));                                             \
        finishSM(PY0, PY1, alY, l_reg, pa0, pa1, pa2, pa3); SBAR();                                                           \
        if ((t) + 1 < NT) { if constexpr (F32) { VMW(); SWRITE_KF(SB); SBAR(); SLOAD_F((const float*)Vh, KBASE((t) + 1)); }  \
                            else { SLOAD_H(Kh, Vh, Fh, KBASE((t) + 1), SB); } SBAR(); }                                       \
        pv_tile<VB, SK>(o, vb0, pa0, pa1, pa2, pa3, ACT((t) - 1)); MASKT(PX0, PX1, (t)); partialSM(PX0, PX1, m_reg, mnX, alX);                                        \
        __syncthreads();                                                                                                      \
        if ((t) + 1 < NT) { VMW(); if constexpr (F32) { SWRITE_VF(SB); SBAR(); if ((t) + 2 < NT) SLOAD_F((const float*)Kh, KBASE((t) + 2)); } \
                            else { SWRITE_H(SB); } }                                                                          \
        RESC(alX); __syncthreads(); } while (0)
    for (int t = 1; t + 1 < NT; t += 2) {
        HALF_STEP(pB0, pB1, mnB, alB, pA0, pA1, alA, t, 1, 0, 0);
        HALF_STEP(pA0, pA1, mnA, alA, pB0, pB1, alB, t + 1, 0, 1, 1);
    }
    const bool even = (NT & 1) == 0;
    if (even) { SBAR(); qkt<1, SK>(pB0, pB1, K_lds, r32, hi, S.qr, ACT(NT - 1)); SBAR(); }
#define QROW(e) (nxt.Q + (size_t)(wid * QBLK + r32) * D + ((e) >> 1) * 16 + hi * 8 + ((e) & 1) * 4)
    if constexpr (F32) { SLOAD_F((const float*)nxt.K, kbn); SBAR();
#pragma unroll
        for (int e = 0; e < 8; ++e) S.tq[e] = *(const f32x4*)QROW(e); }
    else { SLOAD_H(nxt.K, nxt.V, nxt.F, kbn, 0); SBAR();
#pragma unroll
        for (int d0 = 0; d0 < 8; ++d0) S.qr[d0] = load8<TIn>(nxt.Q + (size_t)(wid * QBLK + r32) * D + d0 * 16 + hi * 8); }
    SBAR();
    finishSM(pA0, pA1, alA, l_reg, pa0, pa1, pa2, pa3); SBAR();
    if constexpr (F32) {
#pragma unroll
        for (int e = 8; e < 16; ++e) S.tq[e] = *(const f32x4*)QROW(e); SBAR(); }
#undef QROW
    pv_tile<0, SK>(o, vb0, pa0, pa1, pa2, pa3, ACT(even ? NT - 2 : NT - 1));
    if (even) { MASKT(pB0, pB1, NT - 1); partialSM(pB0, pB1, m_reg, mnB, alB); __syncthreads(); RESC(alB);
        finishSM(pB0, pB1, alB, l_reg, pa0, pa1, pa2, pa3); SBAR(); pv_tile<1, SK>(o, vb0, pa0, pa1, pa2, pa3, ACT(NT - 1)); }
    SBAR(); SEAM_K0();
    if (hi == 0) li_l[r32] = l_reg; asm volatile("s_waitcnt lgkmcnt(0)" ::: "memory");
    {
        typedef __attribute__((address_space(3))) float lasf;
        lasf* ssq_l = (lasf*)(__attribute__((address_space(3))) unsigned char*)lds + (LDS_BIAS - NW * 64 * 4) / 4 + wid * 64 + 32;
        float rli[16];
#pragma unroll
        for (int r = 0; r < 16; ++r) rli[r] = __builtin_amdgcn_rcpf(li_l[crow(r, hi)]);
        if (hi == 0) al_l[r32] = 0.f;
        asm volatile("s_waitcnt lgkmcnt(0)" ::: "memory");
#pragma unroll
        for (int r = 0; r < 16; ++r) { float ss_ = 0.f;
#pragma unroll
            for (int d0 = 0; d0 < 4; ++d0) { const float v = o[d0][r] * rli[r]; ss_ += v * v; }
            (void)__hip_atomic_fetch_add(ssq_l + crow(r, hi), ss_, __ATOMIC_RELAXED, __HIP_MEMORY_SCOPE_WORKGROUP); }
        asm volatile("s_waitcnt lgkmcnt(0)" ::: "memory");
#pragma unroll
        for (int r = 0; r < 16; ++r) rli[r] *= __builtin_amdgcn_rsqf(al_l[crow(r, hi)] * (1.0f / 128.0f) + 1e-6f);
        float wn_[4];
#pragma unroll
        for (int d0 = 0; d0 < 4; ++d0) wn_[d0] = cur.NW_[d0 * 32 + r32];
        TOut* Ow = cur.O + (size_t)(wid * QBLK) * OPITCH;
#pragma unroll
        for (int r = 0; r < 16; ++r) { const int orow = crow(r, hi);
#pragma unroll
            for (int d0 = 0; d0 < 4; ++d0) { const float v = o[d0][r] * rli[r] * wn_[d0];
                const float vn = __shfl_xor(v, 1);
                if ((r32 & 1) == 0) *(unsigned*)(Ow + (size_t)orow * OPITCH + d0 * 32 + r32) = cvtpk(v, vn); } }
    }
    if constexpr (F32) {
#pragma unroll
        for (int d0 = 0; d0 < 8; ++d0) S.qr[d0] = pack8(S.tq[2 * d0], S.tq[2 * d0 + 1]); }
    __syncthreads();
#undef RESC
#undef KBASE
#undef ACT
#undef MASKT
#undef SEAM_K0
#undef HALF_STEP
}
#undef ROW
#undef VMW
#undef VMWN
#undef SLOAD_H
#undef SWRITE_HK
#undef SWRITE_HV
#undef SWRITE_H
#undef SLOAD_F
#undef SWRITE_KF
#undef SWRITE_VF
}
constexpr int NWAVES = 8;
constexpr int NTHR = NWAVES * 64;
#ifndef MK_N_LAUNCHES
#define MK_N_LAUNCHES 1
#endif
constexpr int NPHASE = 8;
constexpr int BATCH = 2, SEQ = 16384, DM = 2048, T = BATCH * SEQ;
constexpr int NZ = 6400;
constexpr int NCH = SEQ / 128;
constexpr float NORM_EPS = 1e-6f;
constexpr size_t MiB = 1u << 20;
constexpr size_t WS_CTL = 0, CTL_ZERO_BYTES = 64 * 1024;
constexpr size_t WS_WINT = 1 * MiB;
constexpr size_t WS_WOUTT = 26 * MiB;
constexpr size_t WS_WQT = 34 * MiB;
constexpr size_t WS_KEYS = 42 * MiB;
constexpr size_t WS_FCUM = 43 * MiB;
constexpr size_t WS_MSM = 44 * MiB;
constexpr size_t WS_GATES = 46 * MiB;
constexpr size_t WS_UB = 48 * MiB;
constexpr size_t WS_VB = 112 * MiB;
constexpr size_t WS_H = 176 * MiB;
constexpr size_t WS_FQ = 304 * MiB, WS_FK = 368 * MiB, WS_FV = 432 * MiB;
constexpr size_t WS_MQ = 496 * MiB, WS_MK = 528 * MiB;
constexpr size_t WS_MV = 560 * MiB, WS_MO = 624 * MiB;
constexpr size_t WS_PQ = 304 * MiB;
constexpr size_t WS_CPREV = 688 * MiB;
constexpr size_t WS_MIXED = 752 * MiB;
constexpr size_t WS_END = 880 * MiB;
constexpr int MS_MLOC = 0, MS_BLAST = 1024, MS_MPREV = 2048, MS_NLOC = 4096, MS_NPREV = 4096 + 131072;
constexpr int CW_BAR = 4096;

constexpr int LDS_BYTES = 160 * 1024;
constexpr int MISC_OFF = LDS_BYTES - 256;
constexpr int SCR_BYTES = MISC_OFF;

#define GAS __attribute__((address_space(1)))
#define LAS __attribute__((address_space(3)))
typedef unsigned short bf16;
typedef unsigned v4u __attribute__((ext_vector_type(4)));
typedef unsigned v2u __attribute__((ext_vector_type(2)));
typedef float f32x4 __attribute__((ext_vector_type(4)));
typedef float f32x2 __attribute__((ext_vector_type(2)));
typedef float f32x16 __attribute__((ext_vector_type(16)));
typedef short bf16x8 __attribute__((ext_vector_type(8)));
typedef GAS unsigned gu32;
#define RLX_AGENT __ATOMIC_RELAXED, __HIP_MEMORY_SCOPE_AGENT
#define LDS_WAIT() asm volatile("s_waitcnt lgkmcnt(0)" ::: "memory")
#define VM_WAIT() asm volatile("s_waitcnt vmcnt(0)" ::: "memory")
__device__ __forceinline__ unsigned cvtpk(float lo, float hi) { unsigned r; asm volatile("v_cvt_pk_bf16_f32 %0, %1, %2" : "=v"(r) : "v"(lo), "v"(hi)); return r; }
__device__ __forceinline__ float bflo(unsigned w) { return __uint_as_float(w << 16); }
__device__ __forceinline__ float bfhi(unsigned w) { return __uint_as_float(w & 0xffff0000u); }
__device__ __forceinline__ float logsig(float x) { return fminf(x, 0.f) - log1pf(__expf(-fabsf(x))); }
__device__ __forceinline__ float wave_sum(float v) {
#pragma unroll
    for (int o = 1; o < 64; o <<= 1) v += __shfl_xor(v, o);
    return v;
}
__device__ __forceinline__ float wave_max(float v) {
#pragma unroll
    for (int o = 1; o < 64; o <<= 1) v = fmaxf(v, __shfl_xor(v, o));
    return v;
}
#define XB_TMO      128
#define XB_XCNT(j)  (256  + 64 * (j))
#define XB_XSUB(j)  (1280 + 64 * (j))
#define XB_XGEN(j)  (2304 + 64 * (j))
#define XB_TOP      3328
#define XB_TOPGEN   3392
#define XCD_BAR_WORDS 3456
#define XB_SPIN_CAP (1u << 18)

__device__ __forceinline__ unsigned xb_ld(unsigned* p)              { return __hip_atomic_load(p, __ATOMIC_RELAXED, __HIP_MEMORY_SCOPE_AGENT); }
__device__ __forceinline__ unsigned xb_add(unsigned* p, unsigned v) { return __hip_atomic_fetch_add(p, v, __ATOMIC_RELAXED, __HIP_MEMORY_SCOPE_AGENT); }
__device__ __forceinline__ unsigned xb_xcc_id() { return (unsigned)__builtin_amdgcn_s_getreg((3 << 11) | 20) & 0xFu; }
#define XB_SPIN(cond, bar) do { unsigned _sp = 0; while (cond) { __builtin_amdgcn_s_sleep(1); \
    if ((++_sp & 255u) == 0u) { if (xb_ld(&(bar)[XB_TMO])) break; if (_sp > XB_SPIN_CAP) { atomicAdd(&(bar)[XB_TMO], 1u); break; } } } } while (0)

struct XcdBarrier {
    unsigned* bar; unsigned x;
    volatile LAS unsigned* st;
};

__device__ __forceinline__ XcdBarrier xcd_barrier_post(unsigned* bar, volatile LAS unsigned* st) {
    XcdBarrier b; b.bar = bar; b.x = xb_xcc_id(); b.st = st;
    if (threadIdx.x == 0) (void)xb_add(&bar[XB_XCNT(b.x)], 1u);
    return b;
}
__device__ __forceinline__ void xcd_barrier_complete(unsigned* bar, unsigned x, unsigned& nloc, unsigned& nx) {
    const unsigned G = gridDim.x * gridDim.y * gridDim.z;
    unsigned sum, cnt, mine, sp = 0u;
    for (;;) {
        sum = 0u; cnt = 0u; mine = 0u;
#pragma unroll
        for (unsigned j = 0; j < 16; ++j) { const unsigned c = xb_ld(&bar[XB_XCNT(j)]); sum += c; cnt += (c > 0u) ? 1u : 0u; mine = (j == x) ? c : mine; }
        if (sum == G) break;
        __builtin_amdgcn_s_sleep(1);
        if ((++sp & 255u) == 0u) { if (xb_ld(&bar[XB_TMO])) break; if (sp > XB_SPIN_CAP) { atomicAdd(&bar[XB_TMO], 1u); break; } }
    }
    nloc = mine > 0u ? mine : 1u; nx = cnt > 0u ? cnt : 1u;
}

__device__ __forceinline__ void xcd_barrier(const XcdBarrier& b) {
    asm volatile("s_waitcnt vmcnt(0)" ::: "memory");
    __syncthreads();
    if (threadIdx.x == 0) {
        unsigned* bar = b.bar;
        __builtin_amdgcn_s_waitcnt(0);
        unsigned nloc = b.st[0], nx = b.st[1];
        if (nloc == 0u) { xcd_barrier_complete(bar, b.x, nloc, nx); b.st[0] = nloc; b.st[1] = nx; }
        const unsigned old = xb_add(&bar[XB_XSUB(b.x)], 1u);
        const unsigned gen = old / nloc;
        if (old + 1u == (gen + 1u) * nloc) {
            __builtin_amdgcn_fence(__ATOMIC_RELEASE, "agent");
            asm volatile("s_waitcnt vmcnt(0)" ::: "memory");
            const unsigned og = xb_add(&bar[XB_TOP], 1u);
            const unsigned tg = og / nx;
            if (og + 1u == (tg + 1u) * nx) xb_add(&bar[XB_TOPGEN], 1u);
            else XB_SPIN(xb_ld(&bar[XB_TOPGEN]) == tg, bar);
            __builtin_amdgcn_fence(__ATOMIC_ACQUIRE, "agent");
            xb_add(&bar[XB_XGEN(b.x)], 1u);
            asm volatile("s_waitcnt vmcnt(0)" ::: "memory");
        } else {
            XB_SPIN(xb_ld(&bar[XB_XGEN(b.x)]) == gen, bar);
            __builtin_amdgcn_fence(__ATOMIC_ACQUIRE, "agent");
            asm volatile("s_waitcnt vmcnt(0)" ::: "memory");
        }
    }
    __syncthreads();
}

struct Args {
    const float* x; const float* norm1_w; const float* w_in; const float* fox_f_bias; const float* conv_w; const float* conv_b;
    const float* i_bias; const float* f_bias; const float* fox_nw; const float* ml_nw; const float* w_out; const float* norm2_w;
    const float* w_q; const float* keys; const float* pu; const float* pv; const float* final_w;
    float* out; unsigned char* ws; int ph_lo, ph_hi, li, pad;
};
typedef const __attribute__((address_space(4))) Args* KA;
typedef __bf16 bf2_t __attribute__((ext_vector_type(2)));
__device__ __forceinline__ float dot2bf(unsigned a, unsigned b, float c) { return __builtin_amdgcn_fdot2_f32_bf16(__builtin_bit_cast(bf2_t, a), __builtin_bit_cast(bf2_t, b), c, false); }
#define MFMA16(a, b, c) __builtin_amdgcn_mfma_f32_16x16x32_bf16((a), (b), (c), 0, 0, 0)
#define MFMA32(a, b, c) __builtin_amdgcn_mfma_f32_32x32x16_bf16((a), (b), (c), 0, 0, 0)

__device__ __forceinline__ void p0_transpose_item(const float* W, int ldw, int src_col, bf16* WT, int dst_row, int Kp, int k0, LAS float* scr, int lane) {
#pragma unroll 8
    for (int i = 0; i < 32; ++i) { const int kk = 2 * i + (lane >> 5); scr[kk * 33 + (lane & 31)] = W[(size_t)(k0 + kk) * ldw + src_col + (lane & 31)]; }
    LDS_WAIT(); asm volatile("" ::: "memory");
    const int c = lane & 7;
#pragma unroll
    for (int j = 0; j < 4; ++j) { const int n = (lane >> 3) + 8 * j; const LAS float* s = scr + (8 * c) * 33 + n;
        v4u o; o.x = cvtpk(s[0 * 33], s[1 * 33]); o.y = cvtpk(s[2 * 33], s[3 * 33]); o.z = cvtpk(s[4 * 33], s[5 * 33]); o.w = cvtpk(s[6 * 33], s[7 * 33]);
        *(GAS v4u*)(WT + (size_t)(dst_row + n) * Kp + k0 + 8 * c) = o; }
    LDS_WAIT(); asm volatile("" ::: "memory");
}
__device__ __forceinline__ void rms_row_to_bf16(const float* xrow, const f32x4 (&w)[8], bf16* orow, int lane) {
    const GAS f32x4* xr = (const GAS f32x4*)xrow + lane;
    f32x4 v[8]; float s = 0.f;
#pragma unroll
    for (int j = 0; j < 8; ++j) { v[j] = xr[64 * j]; s += (v[j].x * v[j].x + v[j].y * v[j].y) + (v[j].z * v[j].z + v[j].w * v[j].w); }
    const float rn = __builtin_amdgcn_rsqf(wave_sum(s) * (1.f / DM) + NORM_EPS);
    GAS v2u* o8 = (GAS v2u*)orow + lane;
#pragma unroll
    for (int j = 0; j < 8; ++j) { v2u o; o.x = cvtpk(v[j].x * rn * w[j].x, v[j].y * rn * w[j].y); o.y = cvtpk(v[j].z * rn * w[j].z, v[j].w * rn * w[j].w); o8[64 * j] = o; }
}
__device__ __forceinline__ void rms_phase(const float* X, const float* wv, bf16* O, int gw, int NGW, int lane) {
    f32x4 w[8];
#pragma unroll
    for (int j = 0; j < 8; ++j) w[j] = ((const f32x4*)wv)[64 * j + lane];
    for (int m = gw; m < T; m += NGW) rms_row_to_bf16(X + (size_t)m * DM, w, O + (size_t)m * DM, lane);
}
__device__ __forceinline__ void cvt_stream(const float* src, bf16* dst, size_t ngroups8, size_t gid, size_t nthr) {
    for (size_t g = gid; g < ngroups8; g += nthr) { const f32x4 a = ((const f32x4*)src)[2 * g], b = ((const f32x4*)src)[2 * g + 1];
        v4u o; o.x = cvtpk(a.x, a.y); o.y = cvtpk(a.z, a.w); o.z = cvtpk(b.x, b.y); o.w = cvtpk(b.z, b.w); ((v4u*)dst)[g] = o; }
}
__device__ __forceinline__ void p0_prologue(KA a, LAS unsigned char* lds, int tid, int lane, int wave, int vcu, int G) {
    unsigned char* ws = a->ws;
    bf16* WINT = (bf16*)(ws + WS_WINT); bf16* WOUTT = (bf16*)(ws + WS_WOUTT); bf16* WQT = (bf16*)(ws + WS_WQT);
    LAS float* scr = (LAS float*)(lds + wave * 16384);
    const int gw = vcu * NWAVES + wave, NGW = G * NWAVES;
    constexpr int I_IN = 32 * 192, I_SQ = 32 * 64;
    for (int it = gw; it < I_IN + 2 * I_SQ; it += NGW) {
        int r = it;
        if (r < I_IN) { const int kb = r / 192, nb = r % 192, n0 = nb * 32; const int src = n0 < 3072 ? n0 : (n0 < 5120 ? n0 + 8 : n0 + 16);
            p0_transpose_item(a->w_in, 6160, src, WINT, n0, DM, kb * 64, scr, lane); continue; }
        r -= I_IN;
        if (r < I_SQ) { p0_transpose_item(a->w_out, DM, (r % 64) * 32, WOUTT, (r % 64) * 32, DM, (r / 64) * 64, scr, lane); continue; }
        r -= I_SQ;
        p0_transpose_item(a->w_q, DM, (r % 64) * 32, WQT, (r % 64) * 32, DM, (r / 64) * 64, scr, lane);
    }
    const size_t gid = (size_t)vcu * NTHR + tid, nthr = (size_t)G * NTHR;
    for (size_t g = gid; g < 256 * 256; g += nthr) { const int i = (int)(g >> 8), k0 = (int)(g & 255) * 8;
        const int src = i < 8 ? 3072 + i : (i < 12 ? 5128 + (i - 8) : 5132 + (i - 12));
        float v[8];
#pragma unroll
        for (int j = 0; j < 8; ++j) v[j] = i < 16 ? a->w_in[(size_t)(k0 + j) * 6160 + src] : 0.f;
        v4u o; o.x = cvtpk(v[0], v[1]); o.y = cvtpk(v[2], v[3]); o.z = cvtpk(v[4], v[5]); o.w = cvtpk(v[6], v[7]);
        *(v4u*)(WINT + (size_t)(6144 + i) * DM + k0) = o; }
    cvt_stream(a->keys, (bf16*)(ws + WS_KEYS), 2 * 128 * 128 / 8, gid, nthr);
    cvt_stream(a->pu, (bf16*)(ws + WS_UB), (size_t)16384 * 2048 / 8, gid, nthr);
    cvt_stream(a->pv, (bf16*)(ws + WS_VB), (size_t)16384 * 2048 / 8, gid, nthr);
    rms_phase(a->x, a->norm1_w, (bf16*)(ws + WS_H), gw, NGW, lane);
}

__device__ __forceinline__ void fox_cumsum(KA a, LAS unsigned char* lds, int bh, int tid, int lane, int wave) {
    const float* GATES = (const float*)(a->ws + WS_GATES); float* F = (float*)(a->ws + WS_FCUM) + (size_t)bh * SEQ;
    const int b = bh >> 3, h = bh & 7; const float bias = a->fox_f_bias[h];
    LAS float* wt = (LAS float*)lds;
    float v[32]; float run = 0.f;
#pragma unroll
    for (int i = 0; i < 32; ++i) { run += logsig(GATES[((size_t)b * SEQ + tid * 32 + i) * 16 + h] + bias); v[i] = run; }
    float sc = run;
#pragma unroll
    for (int o = 1; o < 64; o <<= 1) { const float n = __shfl_up(sc, o); if (lane >= o) sc += n; }
    if (lane == 63) wt[wave] = sc;
    __syncthreads();
    float off = sc - run;
    for (int w = 0; w < wave; ++w) off += wt[w];
#pragma unroll
    for (int i = 0; i < 32; i += 4) *(f32x4*)(F + tid * 32 + i) = (f32x4){v[i] + off, v[i + 1] + off, v[i + 2] + off, v[i + 3] + off} * (-11.313708498984761f);
    __syncthreads();
}

constexpr int LP = 136;
__device__ __forceinline__ float silu(float x) { return x / (1.f + __expf(-x)); }
__device__ __forceinline__ void chunk_gates(KA a, int t0, int h, int lane, float& b0, float& b1, float& i0, float& i1) {
    const float* GATES = (const float*)(a->ws + WS_GATES);
    const float* g0 = GATES + (size_t)(t0 + 2 * lane) * 16; const float ib = a->i_bias[h], fb = a->f_bias[h];
    i0 = g0[8 + h] + ib; i1 = g0[16 + 8 + h] + ib;
    const float l0 = logsig(g0[12 + h] + fb), l1 = logsig(g0[16 + 12 + h] + fb);
    float sc = l0 + l1;
#pragma unroll
    for (int o = 1; o < 64; o <<= 1) { const float n = __shfl_up(sc, o); if (lane >= o) sc += n; }
    b1 = sc; b0 = sc - l1;
}
__device__ __forceinline__ void stage_vt_chunk(const bf16* MV, int t0, int col, LAS bf16* VT, int erow, int lane) {
    const bf16* p = MV + (size_t)(t0 + 2 * lane) * 1024 + col;
    const v4u r0 = *(const v4u*)p, r1 = *(const v4u*)(p + 1024);
#pragma unroll
    for (int j = 0; j < 8; ++j) { const unsigned lo = (j & 1) ? (r0[j >> 1] >> 16) : (r0[j >> 1] & 0xffffu), hi = (j & 1) ? (r1[j >> 1] >> 16) : (r1[j >> 1] & 0xffffu);
        *(LAS unsigned*)(VT + (erow + j) * LP + 2 * lane) = lo | (hi << 16); }
}

__device__ __forceinline__ void mlstm_a_unit(KA a, LAS unsigned char* lds, int u, int tid, int lane, int wave) {
    const int bh = u >> 7, c = u & 127, b = bh >> 2, h = bh & 3, t0 = b * SEQ + c * 128;
    unsigned char* ws = a->ws; float* MSM = (float*)(ws + WS_MSM);
    LAS bf16* VT = (LAS bf16*)lds;
    LAS bf16* AKT = (LAS bf16*)(lds + 256 * LP * 2);
    LAS float* AE = (LAS float*)(lds + 384 * LP * 2);
    if (wave == 0) {
        float b0, b1, i0, i1; chunk_gates(a, t0, h, lane, b0, b1, i0, i1);
        const float bl = __shfl(b1, 63);
        const float w0 = bl - b0 + i0, w1 = bl - b1 + i1;
        const float ml = wave_max(fmaxf(w0, w1));
        AE[2 * lane] = __expf(w0 - ml); AE[2 * lane + 1] = __expf(w1 - ml);
        if (lane == 0) { MSM[MS_MLOC + u] = ml; MSM[MS_BLAST + u] = bl; }
    }
    __syncthreads();
    const bf16* MV = (const bf16*)(ws + WS_MV); const bf16* MK = (const bf16*)(ws + WS_MK);
#pragma unroll
    for (int i = 0; i < 4; ++i) { const int e0 = 8 * (4 * wave + i); stage_vt_chunk(MV, t0, h * 256 + e0, VT, e0, lane); }
    const float a0 = AE[2 * lane], a1 = AE[2 * lane + 1];
#pragma unroll
    for (int i = 0; i < 2; ++i) {
        const int d0 = 8 * (2 * wave + i), ch = 512 + h * 128 + d0;
        const bf16* p = MK + (size_t)(t0 + 2 * lane - 3) * 512 + h * 128 + d0;
        v4u rr[5];
#pragma unroll
        for (int r = 0; r < 5; ++r) { if (c * 128 + 2 * lane - 3 + r >= 0) rr[r] = *(const v4u*)(p + r * 512); else rr[r] = (v4u){0u, 0u, 0u, 0u}; }
#pragma unroll
        for (int jj = 0; jj < 8; ++jj) {
            float xv[5];
#pragma unroll
            for (int r = 0; r < 5; ++r) xv[r] = (jj & 1) ? bfhi(rr[r][jj >> 1]) : bflo(rr[r][jj >> 1]);
            const float cw0 = a->conv_w[ch + jj], cw1 = a->conv_w[1024 + ch + jj], cw2 = a->conv_w[2048 + ch + jj], cw3 = a->conv_w[3072 + ch + jj], cb = a->conv_b[ch + jj];
            const float y0 = cb + cw0 * xv[0] + cw1 * xv[1] + cw2 * xv[2] + cw3 * xv[3];
            const float y1 = cb + cw0 * xv[1] + cw1 * xv[2] + cw2 * xv[3] + cw3 * xv[4];
            const float k0 = silu(y0) * 0.08838834764831845f * a0, k1 = silu(y1) * 0.08838834764831845f * a1;
            *(LAS unsigned*)(AKT + (d0 + jj) * LP + 2 * lane) = cvtpk(k0, k1);
            const float ns = wave_sum(k0 + k1);
            if (lane == 0) MSM[MS_NLOC + u * 128 + d0 + jj] = ns;
        }
    }
    __syncthreads();
    f32x4 acc[2][8];
#pragma unroll
    for (int mi = 0; mi < 2; ++mi)
#pragma unroll
        for (int ni = 0; ni < 8; ++ni) acc[mi][ni] = (f32x4){0.f, 0.f, 0.f, 0.f};
    const int fr = lane & 15, fq = lane >> 4;
#pragma unroll
    for (int ks = 0; ks < 4; ++ks) {
        bf16x8 af[2], bf_[8];
#pragma unroll
        for (int mi = 0; mi < 2; ++mi) af[mi] = *(const LAS bf16x8*)(VT + (32 * wave + 16 * mi + fr) * LP + 32 * ks + 8 * fq);
#pragma unroll
        for (int ni = 0; ni < 8; ++ni) bf_[ni] = *(const LAS bf16x8*)(AKT + (16 * ni + fr) * LP + 32 * ks + 8 * fq);
#pragma unroll
        for (int mi = 0; mi < 2; ++mi)
#pragma unroll
            for (int ni = 0; ni < 8; ++ni) acc[mi][ni] = MFMA16(af[mi], bf_[ni], acc[mi][ni]);
    }
    float* Cout = (float*)(ws + WS_MIXED) + (size_t)u * 32768;
#pragma unroll
    for (int mi = 0; mi < 2; ++mi)
#pragma unroll
        for (int ni = 0; ni < 8; ++ni)
#pragma unroll
            for (int r = 0; r < 4; ++r) Cout[(32 * wave + 16 * mi + 4 * fq + r) * 128 + 16 * ni + fr] = acc[mi][ni][r];
    __syncthreads();
}

__device__ __forceinline__ void mlstm_scan(KA a, int vcu, int G, int tid) {
    unsigned char* ws = a->ws; float* MSM = (float*)(ws + WS_MSM);
    const float* CL = (const float*)(ws + WS_MIXED); unsigned* CP = (unsigned*)(ws + WS_CPREV);
    const int gid = vcu * NTHR + tid, nthr = G * NTHR;
    for (int pi = gid; pi < 8 * 16384; pi += nthr) {
        const int bh = pi >> 14, i2 = pi & 16383;
        float c0 = 0.f, c1 = 0.f, m = 0.f;
#pragma unroll 8
        for (int c = 0; c < NCH; ++c) {
            const float ml = MSM[MS_MLOC + bh * 128 + c], bl = MSM[MS_BLAST + bh * 128 + c];
            const size_t o = (size_t)(bh * 128 + c) * 16384 + i2;
            const f32x2 cl = ((const f32x2*)CL)[o];
            CP[o] = cvtpk(c0, c1);
            if (i2 == 0) MSM[MS_MPREV + bh * 128 + c] = m;
            const float mn = fmaxf(bl + m, ml), ap = __expf(bl + m - mn), al = __expf(ml - mn);
            c0 = ap * c0 + al * cl.x; c1 = ap * c1 + al * cl.y; m = mn;
        }
    }
    if (gid < 1024) {
        const int bh = gid >> 7, d = gid & 127; float n = 0.f, m = 0.f;
        for (int c = 0; c < NCH; ++c) {
            const float ml = MSM[MS_MLOC + bh * 128 + c], bl = MSM[MS_BLAST + bh * 128 + c];
            const float nl = MSM[MS_NLOC + (bh * 128 + c) * 128 + d];
            MSM[MS_NPREV + (bh * 128 + c) * 128 + d] = n;
            const float mn = fmaxf(bl + m, ml), ap = __expf(bl + m - mn), al = __expf(ml - mn);
            n = ap * n + al * nl; m = mn;
        }
    }
}

__device__ __forceinline__ void stage_conv_rows(KA a, const bf16* src, int chbase, float scale, int t0, int c, int h, LAS bf16* dst, int tid) {
    const int d0 = (tid & 15) * 8, ch = chbase + h * 128 + d0;
    float cw[4][8], cb[8];
#pragma unroll
    for (int j = 0; j < 4; ++j) { const f32x4 w0 = *(const f32x4*)(a->conv_w + j * 1024 + ch), w1 = *(const f32x4*)(a->conv_w + j * 1024 + ch + 4);
        cw[j][0] = w0.x; cw[j][1] = w0.y; cw[j][2] = w0.z; cw[j][3] = w0.w; cw[j][4] = w1.x; cw[j][5] = w1.y; cw[j][6] = w1.z; cw[j][7] = w1.w; }
    { const f32x4 w0 = *(const f32x4*)(a->conv_b + ch), w1 = *(const f32x4*)(a->conv_b + ch + 4);
      cb[0] = w0.x; cb[1] = w0.y; cb[2] = w0.z; cb[3] = w0.w; cb[4] = w1.x; cb[5] = w1.y; cb[6] = w1.z; cb[7] = w1.w; }
#pragma unroll
    for (int it = 0; it < 4; ++it) {
        const int l = (it * 512 + tid) >> 4;
        const bf16* p = src + (size_t)(t0 + l - 3) * 512 + h * 128 + d0;
        v4u rr[4];
#pragma unroll
        for (int r = 0; r < 4; ++r) { if (c * 128 + l - 3 + r >= 0) rr[r] = *(const v4u*)(p + r * 512); else rr[r] = (v4u){0u, 0u, 0u, 0u}; }
        float y[8];
#pragma unroll
        for (int jj = 0; jj < 8; ++jj) { float s = cb[jj];
#pragma unroll
            for (int r = 0; r < 4; ++r) s += cw[r][jj] * ((jj & 1) ? bfhi(rr[r][jj >> 1]) : bflo(rr[r][jj >> 1]));
            y[jj] = silu(s) * scale; }
        v4u o; o.x = cvtpk(y[0], y[1]); o.y = cvtpk(y[2], y[3]); o.z = cvtpk(y[4], y[5]); o.w = cvtpk(y[6], y[7]);
        *(LAS v4u*)(dst + l * LP + d0) = o;
    }
}
__device__ __forceinline__ void mlstm_c_unit(KA a, LAS unsigned char* lds, int u, int tid, int lane, int wave) {
    const int bh = u >> 7, c = u & 127, b = bh >> 2, h = bh & 3, t0 = b * SEQ + c * 128;
    unsigned char* ws = a->ws; const float* MSM = (const float*)(ws + WS_MSM);
    LAS bf16* QL = (LAS bf16*)lds;
    LAS bf16* KL = (LAS bf16*)(lds + 128 * LP * 2);
    LAS bf16* VTH = (LAS bf16*)(lds + 256 * LP * 2);
    LAS bf16* CTH = (LAS bf16*)(lds + 384 * LP * 2);
    LAS float* AR = (LAS float*)(lds + 512 * LP * 2);
    if (wave == 0) {
        float b0, b1, i0, i1; chunk_gates(a, t0, h, lane, b0, b1, i0, i1);
        const float c0 = i0 - b0, c1 = i1 - b1, pmx = fmaxf(c0, c1);
        float sc = pmx;
#pragma unroll
        for (int o = 1; o < 64; o <<= 1) { const float n = __shfl_up(sc, o); if (lane >= o) sc = fmaxf(sc, n); }
        float ex = __shfl_up(sc, 1); if (lane == 0) ex = -__builtin_inff();
        const float pm0 = fmaxf(ex, c0), pm1 = sc;
        const float mp = MSM[MS_MPREV + u];
        const float g0 = b0 + mp, g1 = b1 + mp, mt0 = fmaxf(g0, b0 + pm0), mt1 = fmaxf(g1, b1 + pm1);
        AR[2 * lane] = b0 - mt0; AR[2 * lane + 1] = b1 - mt1;
        AR[128 + 2 * lane] = c0; AR[128 + 2 * lane + 1] = c1;
        AR[256 + 2 * lane] = __expf(g0 - mt0); AR[256 + 2 * lane + 1] = __expf(g1 - mt1);
        AR[384 + 2 * lane] = __expf(-mt0); AR[384 + 2 * lane + 1] = __expf(-mt1);
    }
    if (tid >= 64 && tid < 192) AR[512 + tid - 64] = MSM[MS_NPREV + u * 128 + tid - 64];
    stage_conv_rows(a, (const bf16*)(ws + WS_MQ), 0, 1.0f, t0, c, h, QL, tid);
    stage_conv_rows(a, (const bf16*)(ws + WS_MK), 512, 0.08838834764831845f, t0, c, h, KL, tid);
    __syncthreads();
    const int fr = lane & 15, fq = lane >> 4, t = 16 * wave + fr;
    f32x4 st[8];
#pragma unroll
    for (int ni = 0; ni < 8; ++ni) st[ni] = (f32x4){0.f, 0.f, 0.f, 0.f};
    bf16x8 qf[4];
#pragma unroll
    for (int ks = 0; ks < 4; ++ks) qf[ks] = *(const LAS bf16x8*)(QL + t * LP + 32 * ks + 8 * fq);
#pragma unroll
    for (int ks = 0; ks < 4; ++ks)
#pragma unroll
        for (int ni = 0; ni < 8; ++ni) { const bf16x8 kf = *(const LAS bf16x8*)(KL + (16 * ni + fr) * LP + 32 * ks + 8 * fq); st[ni] = MFMA16(kf, qf[ks], st[ni]); }
    float qn = 0.f;
#pragma unroll
    for (int j = 0; j < 4; ++j) { const v4u qq = *(const LAS v4u*)(QL + t * LP + 32 * fq + 8 * j);
#pragma unroll
        for (int w = 0; w < 4; ++w) { qn += bflo(qq[w]) * AR[512 + 32 * fq + 8 * j + 2 * w] + bfhi(qq[w]) * AR[512 + 32 * fq + 8 * j + 2 * w + 1]; } }
    qn += __shfl_xor(qn, 16); qn += __shfl_xor(qn, 32);
    const float rc = AR[t], inter = AR[256 + t], emt = AR[384 + t];
    float rs = 0.f;
#pragma unroll
    for (int ni = 0; ni < 8; ++ni) { const f32x4 cc = *(const LAS f32x4*)(AR + 128 + 16 * ni + 4 * fq);
#pragma unroll
        for (int r = 0; r < 4; ++r) { const int s = 16 * ni + 4 * fq + r; const float wgt = (s <= t) ? __expf(rc + cc[r]) : 0.f; const float v = st[ni][r] * wgt; st[ni][r] = v; rs += v; } }
    rs += __shfl_xor(rs, 16); rs += __shfl_xor(rs, 32);
    const float den = rs + inter * qn, inv = 1.0f / fmaxf(fabsf(den), emt);
    __syncthreads();
#pragma unroll
    for (int ni = 0; ni < 8; ++ni) { v2u o; o.x = cvtpk(st[ni][0], st[ni][1]); o.y = cvtpk(st[ni][2], st[ni][3]); *(LAS v2u*)(KL + t * LP + 16 * ni + 4 * fq) = o; }
    const bf16* MV = (const bf16*)(ws + WS_MV); const bf16* CP = (const bf16*)(ws + WS_CPREV) + (size_t)u * 32768;
    f32x4 hv[2][8];
#pragma unroll
    for (int hf = 0; hf < 2; ++hf) {
#pragma unroll
        for (int i = 0; i < 2; ++i) { const int e0 = 8 * (2 * wave + i); stage_vt_chunk(MV, t0, h * 256 + 128 * hf + e0, VTH, e0, lane); }
#pragma unroll
        for (int it = 0; it < 4; ++it) { const int q = it * 512 + tid, e = q >> 4, d0 = (q & 15) * 8;
            *(LAS v4u*)(CTH + e * LP + d0) = *(const v4u*)(CP + (size_t)(128 * hf + e) * 128 + d0); }
        __syncthreads();
        f32x4 a1[8], a2[8];
#pragma unroll
        for (int ni = 0; ni < 8; ++ni) { a1[ni] = (f32x4){0.f, 0.f, 0.f, 0.f}; a2[ni] = (f32x4){0.f, 0.f, 0.f, 0.f}; }
#pragma unroll
        for (int ks = 0; ks < 4; ++ks) {
            const bf16x8 sf = *(const LAS bf16x8*)(KL + t * LP + 32 * ks + 8 * fq);
#pragma unroll
            for (int ni = 0; ni < 8; ++ni) { const bf16x8 vf = *(const LAS bf16x8*)(VTH + (16 * ni + fr) * LP + 32 * ks + 8 * fq); a1[ni] = MFMA16(vf, sf, a1[ni]);
                const bf16x8 cf = *(const LAS bf16x8*)(CTH + (16 * ni + fr) * LP + 32 * ks + 8 * fq); a2[ni] = MFMA16(cf, qf[ks], a2[ni]); }
        }
#pragma unroll
        for (int ni = 0; ni < 8; ++ni) hv[hf][ni] = (a1[ni] + a2[ni] * inter) * inv;
        __syncthreads();
    }
    const bf16* MO = (const bf16*)(ws + WS_MO) + (size_t)(t0 + t) * 1024 + h * 256;
    float ss = 0.f;
#pragma unroll
    for (int hf = 0; hf < 2; ++hf)
#pragma unroll
        for (int ni = 0; ni < 8; ++ni) { const v2u g = *(const v2u*)(MO + 128 * hf + 16 * ni + 4 * fq);
            const float g0 = bflo(g.x), g1 = bfhi(g.x), g2 = bflo(g.y), g3 = bfhi(g.y);
            f32x4 v = hv[hf][ni]; v[0] *= 1.f / (1.f + __expf(-g0)); v[1] *= 1.f / (1.f + __expf(-g1)); v[2] *= 1.f / (1.f + __expf(-g2)); v[3] *= 1.f / (1.f + __expf(-g3));
            hv[hf][ni] = v; ss += (v[0] * v[0] + v[1] * v[1]) + (v[2] * v[2] + v[3] * v[3]); }
    ss += __shfl_xor(ss, 16); ss += __shfl_xor(ss, 32);
    const float rn = __builtin_amdgcn_rsqf(ss * (1.f / 256.f) + NORM_EPS);
    bf16* MX = (bf16*)(ws + WS_MIXED) + (size_t)(t0 + t) * DM + 1024 + h * 256;
#pragma unroll
    for (int hf = 0; hf < 2; ++hf)
#pragma unroll
        for (int ni = 0; ni < 8; ++ni) { const int e = 128 * hf + 16 * ni + 4 * fq; const f32x4 w = *(const f32x4*)(a->ml_nw + h * 256 + e); const f32x4 v = hv[hf][ni];
            v2u o; o.x = cvtpk(v[0] * rn * w[0], v[1] * rn * w[1]); o.y = cvtpk(v[2] * rn * w[2], v[3] * rn * w[3]); *(v2u*)(MX + e) = o; }
}
__device__ __forceinline__ int sord(float f) { const int b = __float_as_int(f); return b ^ ((b >> 31) & 0x7fffffff); }
__device__ __forceinline__ float sdec(int v) { return __int_as_float(v ^ ((v >> 31) & 0x7fffffff)); }
#define PEER_INS(L, xin) do { int x_ = (xin); _Pragma("unroll") for (int i_ = 0; i_ < 16; ++i_) { const int hi_ = max(L[i_], x_); x_ = min(L[i_], x_); L[i_] = hi_; } } while (0)
__device__ __forceinline__ float gelu_erf(float v) { return 0.5f * v * (1.f + erff(v * 0.70710678118654752f)); }

__device__ __forceinline__ void peer_select(KA a, LAS unsigned char* lds, int t0, int lane, int wave) {
    const bf16* PQ = (const bf16*)(a->ws + WS_PQ); const bf16* KEYS = (const bf16*)(a->ws + WS_KEYS);
    const int c = lane & 31, hh = lane >> 5;
    int AB[2][16];
#pragma unroll
    for (int p = 0; p < 2; ++p) {
        bf16x8 qf[8];
#pragma unroll
        for (int ks = 0; ks < 8; ++ks) qf[ks] = *(const bf16x8*)(PQ + (size_t)(t0 + c) * DM + wave * 256 + p * 128 + 16 * ks + 8 * hh);
        int L[16];
#pragma unroll
        for (int i = 0; i < 16; ++i) L[i] = (int)0x80000000;
#pragma unroll 1
        for (int nt = 0; nt < 4; ++nt) {
            f32x16 acc;
#pragma unroll
            for (int r = 0; r < 16; ++r) acc[r] = 0.f;
#pragma unroll
            for (int ks = 0; ks < 8; ++ks) { const bf16x8 kf = *(const bf16x8*)(KEYS + (size_t)(p * 128 + 32 * nt + c) * 128 + 16 * ks + 8 * hh); acc = MFMA32(kf, qf[ks], acc); }
#pragma unroll
            for (int r = 0; r < 16; ++r) { const int n = 32 * nt + (r & 3) + 8 * (r >> 2); const int key = (sord(acc[r]) & ~127) | n | (4 * hh); PEER_INS(L, key); }
        }
        int M[16];
#pragma unroll
        for (int i = 0; i < 16; ++i) { const int o = __shfl_xor(L[15 - i], 32); M[i] = max(L[i], o); }
#pragma unroll
        for (int dist = 8; dist >= 1; dist >>= 1)
#pragma unroll
            for (int i = 0; i < 16; ++i) if ((i & dist) == 0) { const int hi_ = max(M[i], M[i + dist]), lo_ = min(M[i], M[i + dist]); M[i] = hi_; M[i + dist] = lo_; }
#pragma unroll
        for (int i = 0; i < 16; ++i) AB[p][i] = M[i];
    }
    float va[16], vb[16];
#pragma unroll
    for (int i = 0; i < 16; ++i) { va[i] = sdec(AB[0][i] & ~127); vb[i] = sdec(AB[1][i] & ~127); }
    int L[16];
#pragma unroll
    for (int j = 0; j < 16; ++j) L[j] = (sord(va[0] + vb[j]) & ~255) | j;
#pragma unroll
    for (int i = 1; i < 16; ++i)
#pragma unroll
        for (int j = 0; j < 16; ++j) if ((i + 1) * (j + 1) <= 16) { const int key = (sord(va[i] + vb[j]) & ~255) | (i * 16 + j); PEER_INS(L, key); }
    float sv[16]; float mx = -__builtin_inff();
#pragma unroll
    for (int k = 0; k < 16; ++k) { sv[k] = sdec(L[k] & ~255); mx = fmaxf(mx, sv[k]); }
    float den = 0.f;
#pragma unroll
    for (int k = 0; k < 16; ++k) { sv[k] = __expf(sv[k] - mx); den += sv[k]; }
    const float rden = 1.f / den;
    LAS int* PEI = (LAS int*)lds; LAS float* PEG = (LAS float*)(lds + 16384);
#pragma unroll
    for (int k = 0; k < 16; ++k) {
        const int id = L[k] & 255, ii = id >> 4, jj = id & 15;
        int ka = 0, kb = 0;
#pragma unroll
        for (int i = 0; i < 16; ++i) { ka = (ii == i) ? AB[0][i] : ka; kb = (jj == i) ? AB[1][i] : kb; }
        const int e = (ka & 127) * 128 + (kb & 127);
        if (hh == 0) PEI[c * 128 + wave * 16 + k] = e; else PEG[c * 128 + wave * 16 + k] = sv[k] * rden;
    }
}
__device__ __forceinline__ void peer_gather(KA a, LAS unsigned char* lds, int t0, int lane, int wave) {
    const bf16* XN = (const bf16*)(a->ws + WS_H); const bf16* UB = (const bf16*)(a->ws + WS_UB); const bf16* VB = (const bf16*)(a->ws + WS_VB);
    const LAS int* PEI = (const LAS int*)lds; const LAS float* PEG = (const LAS float*)(lds + 16384);
    for (int ci = 0; ci < 4; ++ci) {
        const int c = wave + 8 * ci; const size_t tok = (size_t)(t0 + c);
        v4u xr[4];
#pragma unroll
        for (int j = 0; j < 4; ++j) xr[j] = *(const v4u*)(XN + tok * DM + 512 * j + 8 * lane);
        float y[32];
#pragma unroll
        for (int i = 0; i < 32; ++i) y[i] = 0.f;
        for (int k0 = 0; k0 < 128; k0 += 4) {
            int e[4]; float g[4];
#pragma unroll
            for (int q = 0; q < 4; ++q) { e[q] = __builtin_amdgcn_readfirstlane(PEI[c * 128 + k0 + q]); g[q] = PEG[c * 128 + k0 + q]; }
            v4u ur[4][4];
#pragma unroll
            for (int q = 0; q < 4; ++q)
#pragma unroll
                for (int j = 0; j < 4; ++j) ur[q][j] = *(const v4u*)(UB + (size_t)e[q] * DM + 512 * j + 8 * lane);
            float act[4];
#pragma unroll
            for (int q = 0; q < 4; ++q) { float d = 0.f;
#pragma unroll
                for (int j = 0; j < 4; ++j)
#pragma unroll
                    for (int w = 0; w < 4; ++w) d = dot2bf(ur[q][j][w], xr[j][w], d);
                d = wave_sum(d); act[q] = gelu_erf(d) * g[q]; }
#pragma unroll
            for (int q = 0; q < 4; ++q)
#pragma unroll
                for (int j = 0; j < 4; ++j) { const v4u vv = *(const v4u*)(VB + (size_t)e[q] * DM + 512 * j + 8 * lane);
#pragma unroll
                    for (int w = 0; w < 4; ++w) { y[8 * j + 2 * w] += act[q] * bflo(vv[w]); y[8 * j + 2 * w + 1] += act[q] * bfhi(vv[w]); } }
        }
        float* orow = a->out + tok * DM; float ss = 0.f;
#pragma unroll
        for (int j = 0; j < 4; ++j) { const f32x4 x0 = *(const f32x4*)(orow + 512 * j + 8 * lane), x1 = *(const f32x4*)(orow + 512 * j + 8 * lane + 4);
            y[8 * j + 0] += x0.x; y[8 * j + 1] += x0.y; y[8 * j + 2] += x0.z; y[8 * j + 3] += x0.w; y[8 * j + 4] += x1.x; y[8 * j + 5] += x1.y; y[8 * j + 6] += x1.z; y[8 * j + 7] += x1.w; }
#pragma unroll
        for (int i = 0; i < 32; ++i) ss += y[i] * y[i];
        const float rn = __builtin_amdgcn_rsqf(wave_sum(ss) * (1.f / DM) + NORM_EPS);
#pragma unroll
        for (int j = 0; j < 4; ++j) { const f32x4 w0 = *(const f32x4*)(a->final_w + 512 * j + 8 * lane), w1 = *(const f32x4*)(a->final_w + 512 * j + 8 * lane + 4);
            *(f32x4*)(orow + 512 * j + 8 * lane) = (f32x4){y[8 * j] * rn * w0.x, y[8 * j + 1] * rn * w0.y, y[8 * j + 2] * rn * w0.z, y[8 * j + 3] * rn * w0.w};
            *(f32x4*)(orow + 512 * j + 8 * lane + 4) = (f32x4){y[8 * j + 4] * rn * w1.x, y[8 * j + 5] * rn * w1.y, y[8 * j + 6] * rn * w1.z, y[8 * j + 7] * rn * w1.w}; }
    }
}

__global__ void __launch_bounds__(NTHR, 2) fwd_kernel(Args args) {
    extern __shared__ __attribute__((aligned(16))) unsigned char lds_raw[];
    LAS unsigned char* lds = (LAS unsigned char*)lds_raw;
    volatile LAS unsigned* MISC = (volatile LAS unsigned*)(lds + MISC_OFF);
    const int tid = threadIdx.x, lane = tid & 63, wave = __builtin_amdgcn_readfirstlane(tid >> 6);
    const int G = gridDim.x; const int bx = blockIdx.x; const int vcu = (G % 8 == 0) ? (bx % 8) * (G / 8) + bx / 8 : bx;
    KA ka = (KA)__builtin_amdgcn_kernarg_segment_ptr();
#define KARGS(name) KA name = ka; asm volatile("" : "+s"(name))
    gu32* ctl; { KARGS(a_); ctl = (gu32*)(a_->ws + WS_CTL); }
    if (tid < 64) MISC[tid] = 0u;
    __syncthreads();
    XcdBarrier bar = xcd_barrier_post((unsigned*)ctl + CW_BAR + args.li * XCD_BAR_WORDS, MISC + 8);
    const int lo = args.ph_lo, hi = args.ph_hi;
#ifndef PH_MASK
#define PH_MASK 0x1ff
#endif
#define IN(k) (((PH_MASK >> (k)) & 1) && lo <= (k) && (k) < hi)
#define BOTH(k) (IN(k) && IN((k) + 1))
#define GRID_BAR() xcd_barrier(bar)

    if (IN(0)) { KARGS(a_); p0_prologue(a_, lds, tid, lane, wave, vcu, G); if (BOTH(0)) GRID_BAR(); }

    if (IN(1)) {
        KARGS(a_); unsigned char* ws = a_->ws;
        pg8::Gemm g{(const pg8::bf16_t*)(ws + WS_H), (const pg8::bf16_t*)(ws + WS_WINT), T, NZ, DM}; pg8::StaticOrder S; S.init(T, NZ, G, bx);
        static_assert(WS_FK - WS_FQ == (1u << 26) && WS_FV - WS_FK == (1u << 26) && WS_MK - WS_MQ == (1u << 25) && WS_MO - WS_MV == (1u << 26), "EpiZ strides");
        pg8::EpiZ E{ws, WS_FQ, WS_MQ, WS_MV, WS_GATES};
        pg8::gemm_phase<pg8::EpiZ, pg8::StaticOrder, true, true>(lds, g, S, E);
        if (BOTH(1)) GRID_BAR();
    }

    if (IN(2)) {
        KARGS(a_);
        for (int s = bx; s < 16; s += G) fox_cumsum(a_, lds, s, tid, lane, wave);
        for (int u = vcu; u < 8 * NCH; u += G) mlstm_a_unit(a_, lds, u, tid, lane, wave);
        if (BOTH(2)) GRID_BAR();
    }

    if (IN(3)) { KARGS(a_); mlstm_scan(a_, vcu, G, tid); if (BOTH(3)) GRID_BAR(); }

    if (IN(4)) {
#ifndef NO_ATT
        {
            using namespace fox;
            typedef __hip_bfloat16 hb;
            KARGS(a_); unsigned char* ws = a_->ws; const float* fox_nw = a_->fox_nw;
            const hb* Q = (const hb*)(ws + WS_FQ); const hb* K = (const hb*)(ws + WS_FK); const hb* V = (const hb*)(ws + WS_FV); hb* O = (hb*)(ws + WS_MIXED);
            const float* F = (const float*)(ws + WS_FCUM);
            constexpr int NQB = SEQ / QB, NX = NQB / 2, TOTAL = NX * 16;
#define FOX_REF(r, Lx, pass) do { const int bh_ = (Lx) / NX, x_ = (Lx) % NX, qb_ = (pass) ? NQB - 1 - x_ : x_, b_ = bh_ >> 3, h_ = bh_ & 7;     \
                (r).Q = Q + ((size_t)bh_ * SEQ + (size_t)qb_ * QB) * 128; (r).K = K + (size_t)bh_ * SEQ * 128; (r).V = V + (size_t)bh_ * SEQ * 128;      \
                (r).O = O + ((size_t)b_ * SEQ + (size_t)qb_ * QB) * DM + h_ * 128; (r).P0 = qb_ * QB; (r).F = F + (size_t)bh_ * SEQ;                    \
                (r).NW_ = fox_nw + h_ * 128; } while (0)
            int L = bx;
            if (L < TOTAL) {
                int pass = 0;
                BlockRef<hb, hb> cur; FOX_REF(cur, L, 0);
                Seam<hb> Sm;
                causal_swa_prime<hb, hb>(cur, SEQ, (char*)lds_raw, Sm);
                for (;;) {
                    const bool more_pass = pass == 0, more_item = L + G < TOTAL, last = !more_pass && !more_item;
                    int passn = pass + 1, Ln = L;
                    if (!more_pass) { passn = 0; Ln = more_item ? L + G : L; }
                    BlockRef<hb, hb> nxt; if (last) nxt = cur; else FOX_REF(nxt, Ln, passn);
                    causal_swa_block<hb, hb>(cur, nxt, SEQ, SEQ, (char*)lds_raw, Sm);
                    if (last) break;
                    cur = nxt; pass = passn; L = Ln;
                }
            }
#undef FOX_REF
        }
#endif
        VM_WAIT(); __syncthreads();
#ifndef NO_MLC
        { KARGS(a_); for (int u = vcu; u < 8 * NCH; u += G) mlstm_c_unit(a_, lds, u, tid, lane, wave); }
#endif
        if (BOTH(4)) GRID_BAR();
    }

    if (IN(5)) {
        KARGS(a_); unsigned char* ws = a_->ws;
        pg8::Gemm g{(const pg8::bf16_t*)(ws + WS_MIXED), (const pg8::bf16_t*)(ws + WS_WOUTT), T, DM, DM}; pg8::StaticOrder S; S.init(T, DM, G, bx);
        pg8::EpiRes E{a_->x, a_->out, DM};
        pg8::gemm_phase<pg8::EpiRes, pg8::StaticOrder, true, true>(lds, g, S, E);
        if (BOTH(5)) GRID_BAR();
    }

    if (IN(6)) { KARGS(a_); rms_phase(a_->out, a_->norm2_w, (bf16*)(a_->ws + WS_H), vcu * NWAVES + wave, G * NWAVES, lane); if (BOTH(6)) GRID_BAR(); }

    if (IN(7)) {
        KARGS(a_); unsigned char* ws = a_->ws;
        pg8::Gemm g{(const pg8::bf16_t*)(ws + WS_H), (const pg8::bf16_t*)(ws + WS_WQT), T, DM, DM}; pg8::StaticOrder S; S.init(T, DM, G, bx);
        pg8::EpiBf16<0> E{(pg8::bf16_t*)(ws + WS_PQ), DM, nullptr, 0, 0, 1.f};
        pg8::gemm_phase<pg8::EpiBf16<0>, pg8::StaticOrder, true, true>(lds, g, S, E);
        if (BOTH(7)) GRID_BAR();
    }

    if (IN(8)) {
        KARGS(a_);
        for (int tile = vcu; tile < T / 32; tile += G) {
#ifndef NO_SEL
            peer_select(a_, lds, tile * 32, lane, wave);
#endif
            __syncthreads();
#ifndef NO_GAT
            peer_gather(a_, lds, tile * 32, lane, wave);
#endif
            __syncthreads();
        }
    }
#undef IN
#undef BOTH
#undef GRID_BAR
}

extern "C" void kernel_launch(void* const* d_in, const int* in_sizes, int n_in, void* d_out, int out_size, void* d_ws, size_t ws_size, hipStream_t stream) {
    static int grid = 0;
    constexpr int NPH = 9;
    if (grid == 0) {
        if (n_in != 17 || in_sizes[0] != T * DM || out_size != T * DM || ws_size < WS_END) { fprintf(stderr, "kernel_launch: shape/workspace mismatch (n_in %d, in0 %d, out %d, ws %zu)\n", n_in, n_in > 0 ? in_sizes[0] : -1, out_size, ws_size); grid = -1; return; }
        int dev = 0, cus = 0, per_cu = 0;
        if (hipGetDevice(&dev) != hipSuccess || hipDeviceGetAttribute(&cus, hipDeviceAttributeMultiprocessorCount, dev) != hipSuccess) { grid = -1; return; }
        if (hipFuncSetAttribute((const void*)fwd_kernel, hipFuncAttributeMaxDynamicSharedMemorySize, LDS_BYTES) != hipSuccess) { fprintf(stderr, "kernel_launch: hipFuncSetAttribute failed\n"); grid = -1; return; }
        if (hipOccupancyMaxActiveBlocksPerMultiprocessor(&per_cu, (const void*)fwd_kernel, NTHR, LDS_BYTES) != hipSuccess || per_cu < 1) { fprintf(stderr, "kernel_launch: occupancy query says %d blocks per CU\n", per_cu); (void)hipGetLastError(); grid = -1; return; }
        grid = cus;
    }
    if (grid < 0) return;
    if (hipMemsetAsync((char*)d_ws + WS_CTL, 0, CTL_ZERO_BYTES, stream) != hipSuccess) return;
    Args a{};
    a.x = (const float*)d_in[0]; a.norm1_w = (const float*)d_in[1]; a.w_in = (const float*)d_in[2]; a.fox_f_bias = (const float*)d_in[3];
    a.conv_w = (const float*)d_in[4]; a.conv_b = (const float*)d_in[5]; a.i_bias = (const float*)d_in[6]; a.f_bias = (const float*)d_in[7];
    a.fox_nw = (const float*)d_in[8]; a.ml_nw = (const float*)d_in[9]; a.w_out = (const float*)d_in[10]; a.norm2_w = (const float*)d_in[11];
    a.w_q = (const float*)d_in[12]; a.keys = (const float*)d_in[13]; a.pu = (const float*)d_in[14]; a.pv = (const float*)d_in[15]; a.final_w = (const float*)d_in[16];
    a.out = (float*)d_out; a.ws = (unsigned char*)d_ws;
#if MK_N_LAUNCHES == 1
    a.ph_lo = 0; a.ph_hi = NPH; a.li = 0; a.pad = 0;
    hipLaunchKernelGGL(fwd_kernel, dim3(grid), dim3(NTHR), LDS_BYTES, stream, a);
#else
    for (int p = 0; p < NPH; ++p) { a.ph_lo = p; a.ph_hi = p + 1; a.li = 0; a.pad = 0; hipLaunchKernelGGL(fwd_kernel, dim3(grid), dim3(NTHR), LDS_BYTES, stream, a); }
#endif
}
```

```cpp
#include <hip/hip_runtime.h>
#include <hip/hip_bf16.h>
#include <cstdio>
#include <cstdint>
namespace pg8 {
#define PG8_LAS __attribute__((address_space(3)))
typedef unsigned short bf16_t;
typedef short bf16x8 __attribute__((ext_vector_type(8)));
typedef float f32x4 __attribute__((ext_vector_type(4)));
typedef unsigned u32x4 __attribute__((ext_vector_type(4)));
constexpr int BM = 256, BK = 64, HALF = 128, HTB = HALF * BK * 2  , STAGE_BYTES = 8 * HTB, NXCD = 8, WGM = 8;

__host__ __device__ __forceinline__ int lds_byte(int r, int c) { const int st = (r >> 4) * 2 + (c >> 5), rr = r & 15, cc = c & 31, ob = rr * 64 + cc * 2; return st * 1024 + (ob ^ (((ob >> 9) & 1) << 5)); }
__host__ __device__ __forceinline__ void stage_rc(int b, int& R, int& C) { const int st = b / 1024, sb = b % 1024, swz = sb ^ (((sb >> 9) & 1) << 5); R = (st >> 1) * 16 + swz / 64; C = (st & 1) * 32 + (swz % 64) / 2; }
__host__ __device__ __forceinline__ int perm32(int rho) { const int n = rho >> 4, i = rho & 15; return 8 * (i >> 2) + 4 * n + (i & 3); }

struct Unit { int pm, pn; };
struct Gemm { const bf16_t* A; const bf16_t* Bt; int M, N, K; };

struct StaticOrder {
    int nM, nN, nwg, G, c;
    __host__ __device__ void init(int M, int N, int G_, int c_) { nM = M / BM; nN = N / BM; nwg = nM * nN; G = G_; c = c_; }
    __host__ __device__ bool next(int i, Unit& u) const {
        const long L = (long)i * G + c; if (L >= nwg) return false;
        int wgid = (int)L; { const int q = nwg / NXCD, r = nwg % NXCD, xcd = wgid % NXCD, off = wgid / NXCD; wgid = (xcd < r ? xcd * (q + 1) : r * (q + 1) + (xcd - r) * q) + off; }
        const int nig = WGM * nN, gid = wgid / nig, fm = gid * WGM, gsz = (nM - fm) < WGM ? (nM - fm) : WGM;
        u.pm = fm + ((wgid % nig) % gsz); u.pn = (wgid % nig) / gsz; return true;
    }
    __device__ __forceinline__ void a_ready(const Unit&) const {}
    __device__ __forceinline__ void done(const Unit&) const {}
};

__device__ __forceinline__ unsigned cvt_pk_bf16(float lo, float hi) { unsigned r; asm volatile("v_cvt_pk_bf16_f32 %0, %1, %2" : "=v"(r) : "v"(lo), "v"(hi)); return r; }
typedef float f32x2 __attribute__((ext_vector_type(2)));
__device__ __forceinline__ f32x2 gelu_pk(f32x2 v) {
    const f32x2 av = __builtin_elementwise_abs(v), d = av * 0.2316418882f + 1.0f;
    f32x2 t; t.x = __builtin_amdgcn_rcpf(d.x); t.y = __builtin_amdgcn_rcpf(d.y);
    f32x2 q = t * 0.5307027145f + (-0.7265760135f); q = q * t + 0.7107068705f; q = q * t + (-0.142248368f); q = q * t + 0.127414796f; q = q * t;
    const f32x2 s = (v * v) * (-0.72134752044f);
    f32x2 e; e.x = __builtin_amdgcn_exp2f(s.x); e.y = __builtin_amdgcn_exp2f(s.y);
    const f32x2 m = v * (q * e), r = v - m;
    f32x2 o; o.x = v.x < 0.f ? m.x : r.x; o.y = v.y < 0.f ? m.y : r.y; return o;
}

template <int ACT  > struct EpiBf16 {
    static constexpr bool PERM = true, AFTER_DRAIN = false; static_assert(ACT == 0 || ACT == 1, "EpiBf16: ACT is 0 (none) or 1 (gelu_pk)");
    bf16_t* O; int ldc; const float* bias; int split_cols; size_t split_stride; float scale0;
    __device__ __forceinline__ void operator()(const f32x4 (&acc)[2][2][4][2], const Unit& u, int wr, int wc, int fr, int fq) const {
        const int row0 = u.pm * BM + wr * 64 + fr; int colt = u.pn * BM; bf16_t* base = O;
        float sc = 1.f; if (split_cols) { const int t = colt / split_cols; base += (size_t)t * split_stride; colt -= t * split_cols; if (t == 0) sc = scale0; }
        const int col0 = colt + wc * 32 + 8 * fq, bcol0 = u.pn * BM + wc * 32 + 8 * fq;
        f32x4 bv[2][2];
#pragma unroll
        for (int bj = 0; bj < 2; ++bj)
#pragma unroll
            for (int n = 0; n < 2; ++n) bv[bj][n] = bias ? *(const f32x4*)(bias + bcol0 + bj * HALF + 4 * n) : (f32x4){0.f, 0.f, 0.f, 0.f};
#pragma unroll
        for (int ai = 0; ai < 2; ++ai)
#pragma unroll
            for (int m = 0; m < 4; ++m) { bf16_t* rowp = base + (size_t)(row0 + ai * HALF + m * 16) * ldc + col0;
#pragma unroll
                for (int bj = 0; bj < 2; ++bj) { f32x4 v0 = acc[ai][bj][m][0] + bv[bj][0], v1 = acc[ai][bj][m][1] + bv[bj][1];
                    if (ACT == 1) { f32x2 a = gelu_pk((f32x2){v0[0], v0[1]}), b = gelu_pk((f32x2){v0[2], v0[3]}), c = gelu_pk((f32x2){v1[0], v1[1]}), d = gelu_pk((f32x2){v1[2], v1[3]});
                        v0 = (f32x4){a.x, a.y, b.x, b.y}; v1 = (f32x4){c.x, c.y, d.x, d.y}; }
                    v0 = v0 * sc; v1 = v1 * sc; u32x4 w; w.x = cvt_pk_bf16(v0[0], v0[1]); w.y = cvt_pk_bf16(v0[2], v0[3]); w.z = cvt_pk_bf16(v1[0], v1[1]); w.w = cvt_pk_bf16(v1[2], v1[3]);
                    *(u32x4*)(rowp + bj * HALF) = w; } }
    }
};

struct EpiZ {
    static constexpr bool PERM = true, AFTER_DRAIN = false;
    unsigned char* ws; size_t off_fq, off_mq, off_mv, off_gates;
    __device__ __forceinline__ void operator()(const f32x4 (&acc)[2][2][4][2], const Unit& u, int wr, int wc, int fr, int fq) const {
        const int pn = u.pn, row0 = u.pm * BM + wr * 64 + fr;
        if (pn < 12) {
            bf16_t* base = (bf16_t*)(ws + off_fq + ((size_t)(pn >> 2) << 26)); const int hp = (pn & 3) * 2, d = wc * 32 + 8 * fq;
#pragma unroll
            for (int ai = 0; ai < 2; ++ai)
#pragma unroll
                for (int m = 0; m < 4; ++m) { const int row = row0 + ai * HALF + m * 16, b = row >> 14, s = row & 16383;
#pragma unroll
                    for (int bj = 0; bj < 2; ++bj) { const f32x4 v0 = acc[ai][bj][m][0], v1 = acc[ai][bj][m][1];
                        u32x4 w; w.x = cvt_pk_bf16(v0[0], v0[1]); w.y = cvt_pk_bf16(v0[2], v0[3]); w.z = cvt_pk_bf16(v1[0], v1[1]); w.w = cvt_pk_bf16(v1[2], v1[3]);
                        *(u32x4*)(base + ((size_t)(b * 8 + hp + bj) * 16384 + s) * 128 + d) = w; } }
        } else if (pn < 24) {
            const bool isqk = pn < 16;
            const size_t boff = isqk ? off_mq + ((size_t)((pn - 12) >> 1) << 25) : off_mv + ((size_t)((pn - 16) >> 2) << 26);
            bf16_t* base = (bf16_t*)(ws + boff); const int ld = isqk ? 512 : 1024, cb = isqk ? ((pn - 12) & 1) * 256 : ((pn - 16) & 3) * 256;
            const int col0 = cb + wc * 32 + 8 * fq;
#pragma unroll
            for (int ai = 0; ai < 2; ++ai)
#pragma unroll
                for (int m = 0; m < 4; ++m) { bf16_t* rowp = base + (size_t)(row0 + ai * HALF + m * 16) * ld + col0;
#pragma unroll
                    for (int bj = 0; bj < 2; ++bj) { const f32x4 v0 = acc[ai][bj][m][0], v1 = acc[ai][bj][m][1];
                        u32x4 w; w.x = cvt_pk_bf16(v0[0], v0[1]); w.y = cvt_pk_bf16(v0[2], v0[3]); w.z = cvt_pk_bf16(v1[0], v1[1]); w.w = cvt_pk_bf16(v1[2], v1[3]);
                        *(u32x4*)(rowp + bj * HALF) = w; } }
        } else {
            if (wc == 0 && fq < 2) {
#pragma unroll
                for (int ai = 0; ai < 2; ++ai)
#pragma unroll
                    for (int m = 0; m < 4; ++m) { float* rowp = (float*)(ws + off_gates) + (size_t)(row0 + ai * HALF + m * 16) * 16 + 8 * fq;
                        *(f32x4*)rowp = acc[ai][0][m][0]; *(f32x4*)(rowp + 4) = acc[ai][0][m][1]; }
            }
        }
    }
};
struct EpiRes {
    static constexpr bool PERM = true, AFTER_DRAIN = false;
    const float* res; float* O; int ldc;
    __device__ __forceinline__ void operator()(const f32x4 (&acc)[2][2][4][2], const Unit& u, int wr, int wc, int fr, int fq) const {
        const int row0 = u.pm * BM + wr * 64 + fr, col0 = u.pn * BM + wc * 32 + 8 * fq;
#pragma unroll
        for (int ai = 0; ai < 2; ++ai)
#pragma unroll
            for (int m = 0; m < 4; ++m) { const size_t off = (size_t)(row0 + ai * HALF + m * 16) * ldc + col0;
#pragma unroll
                for (int bj = 0; bj < 2; ++bj) { const f32x4 r0 = *(const f32x4*)(res + off + bj * HALF), r1 = *(const f32x4*)(res + off + bj * HALF + 4);
                    *(f32x4*)(O + off + bj * HALF) = acc[ai][bj][m][0] + r0; *(f32x4*)(O + off + bj * HALF + 4) = acc[ai][bj][m][1] + r1; } }
    }
};
template <class Epi, class Sched, bool ALIGN_EPI = false, bool SP2 = false>
__device__ __forceinline__ void gemm_phase(PG8_LAS unsigned char* lds, const Gemm g, const Sched& S, const Epi& E) {
    const int tid = threadIdx.x, wid = __builtin_amdgcn_readfirstlane(tid >> 6), lane = tid & 63, wr = wid >> 2, wc = wid & 3, fr = lane & 15, fq = lane >> 4;
    const int K = g.K, nt = K / BK;
    unsigned voffA[2], voffB[2];
#pragma unroll
    for (int i = 0; i < 2; ++i) { int R, C; stage_rc(tid * 16 + i * 8192, R, C); const int Rb = Epi::PERM ? ((R & ~31) + perm32(R & 31)) : R;
        voffA[i] = (unsigned)(R * K + C) * 2u; voffB[i] = (unsigned)(Rb * K + C) * 2u; }
    const size_t kstep = (size_t)(BK * 2);
    const size_t hstep = (size_t)HALF * K * 2;
    const size_t tstep = 2 * hstep;
    const unsigned ldsw = (unsigned)wid * 1024u;
    const int aoff = lds_byte(wr * 64 + fr, fq * 8), boff = lds_byte(wc * 32 + fr, fq * 8);
#define PG8_SA(b, h) (((b) * 2 + (h)) * HTB)
#define PG8_SB(b, h) ((4 + (b) * 2 + (h)) * HTB)
#define PG8_STAGE(bufoff, gbase, voff) do { _Pragma("unroll") for (int _i = 0; _i < 2; ++_i) \
        __builtin_amdgcn_global_load_lds((const unsigned*)((const char*)(gbase) + (voff)[_i]), (PG8_LAS unsigned*)(lds + (bufoff) + ldsw + _i * 8192), 16, 0, 0); } while (0)
#define PG8_LDA(dst, b, h) do { _Pragma("unroll") for (int m = 0; m < 4; ++m) _Pragma("unroll") for (int k = 0; k < 2; ++k) dst[m][k] = *(const PG8_LAS bf16x8*)(lds + PG8_SA(b, h) + aoff + m * 2048 + k * 1024); } while (0)
#define PG8_LDB(dst, b, h) do { _Pragma("unroll") for (int n = 0; n < 2; ++n) _Pragma("unroll") for (int k = 0; k < 2; ++k) dst[n][k] = *(const PG8_LAS bf16x8*)(lds + PG8_SB(b, h) + boff + n * 2048 + k * 1024); } while (0)
#define PG8_MMA(ai, bj, At, Bt) do { __builtin_amdgcn_s_setprio(1); _Pragma("unroll") for (int m = 0; m < 4; ++m) _Pragma("unroll") for (int n = 0; n < 2; ++n) _Pragma("unroll") for (int k = 0; k < 2; ++k) \
        acc[ai][bj][m][n] = __builtin_amdgcn_mfma_f32_16x16x32_bf16(Bt[n][k], At[m][k], acc[ai][bj][m][n], 0, 0, 0); __builtin_amdgcn_s_setprio(0); } while (0)
#define PG8_WAIT_V(n) asm volatile("s_waitcnt vmcnt(" #n ")" ::: "memory")
#define PG8_WAIT_L(n) asm volatile("s_waitcnt lgkmcnt(" #n ")" ::: "memory")
#define PG8_BAR __builtin_amdgcn_s_barrier()
#define PG8_SCHED __builtin_amdgcn_sched_barrier(0)
    Unit cur, nxt; int ui = 0;
    if (!S.next(0, cur)) return;
    f32x4 acc[2][2][4][2];
#pragma unroll
    for (int a = 0; a < 2; ++a)
#pragma unroll
        for (int b = 0; b < 2; ++b)
#pragma unroll
            for (int m = 0; m < 4; ++m)
#pragma unroll
                for (int n = 0; n < 2; ++n) acc[a][b][m][n] = (f32x4){0.f, 0.f, 0.f, 0.f};
    bf16x8 At[4][2], B0[2][2], B1[2][2];
    const char* cA = (const char*)g.A + (size_t)cur.pm * tstep; const char* cB = (const char*)g.Bt + (size_t)cur.pn * tstep;
    S.a_ready(cur);
    if constexpr (SP2) {
        PG8_STAGE(PG8_SB(0, 0), cB, voffB); PG8_STAGE(PG8_SB(0, 1), cB + hstep, voffB); PG8_STAGE(PG8_SA(0, 0), cA, voffA); PG8_STAGE(PG8_SA(0, 1), cA + hstep, voffA);
        if (wr == 1) PG8_BAR;
        PG8_WAIT_V(2); PG8_BAR;
        PG8_STAGE(PG8_SB(1, 0), cB + kstep, voffB); PG8_STAGE(PG8_SA(1, 0), cA + kstep, voffA); PG8_STAGE(PG8_SB(1, 1), cB + hstep + kstep, voffB);
        PG8_WAIT_V(6); PG8_BAR;
    } else {
        PG8_STAGE(PG8_SB(0, 0), cB, voffB); PG8_STAGE(PG8_SA(0, 0), cA, voffA); PG8_STAGE(PG8_SB(0, 1), cB + hstep, voffB); PG8_STAGE(PG8_SA(0, 1), cA + hstep, voffA);
        if (wr == 1) PG8_BAR;
        PG8_WAIT_V(4); PG8_BAR;
        PG8_STAGE(PG8_SB(1, 0), cB + kstep, voffB); PG8_STAGE(PG8_SA(1, 0), cA + kstep, voffA); PG8_STAGE(PG8_SB(1, 1), cB + hstep + kstep, voffB);
        PG8_WAIT_V(6); PG8_BAR;
    }
    for (;;) {
        const bool has_next = S.next(ui + 1, nxt);
        const char* nA = has_next ? (const char*)g.A + (size_t)nxt.pm * tstep : cA; const char* nB = has_next ? (const char*)g.Bt + (size_t)nxt.pn * tstep : cB;
        for (int t = 0; t < nt; t += 2) {
            const bool last = (t == nt - 2);
            const char* a1 = cA + (size_t)(t + 1) * kstep;
            const char* a2 = last ? nA : cA + (size_t)(t + 2) * kstep; const char* b2 = last ? nB : cB + (size_t)(t + 2) * kstep;
            const char* a3 = a2 + kstep; const char* b3 = b2 + kstep;
            if (last && has_next) S.a_ready(nxt);
            if constexpr (SP2) {
            PG8_LDB(B0, 0, 0); PG8_LDB(B1, 0, 1); PG8_SCHED; PG8_LDA(At, 0, 0); PG8_STAGE(PG8_SA(1, 1), a1 + hstep, voffA);
            PG8_WAIT_V(8); PG8_WAIT_L(0); PG8_BAR; PG8_MMA(0, 0, At, B0); PG8_MMA(0, 1, At, B1); PG8_BAR; PG8_SCHED;
            PG8_LDA(At, 0, 1); PG8_STAGE(PG8_SB(0, 0), b2, voffB); PG8_STAGE(PG8_SB(0, 1), b2 + hstep, voffB); PG8_STAGE(PG8_SA(0, 0), a2, voffA);
            PG8_WAIT_V(8); PG8_WAIT_L(0); PG8_BAR; PG8_MMA(1, 0, At, B0); PG8_MMA(1, 1, At, B1); PG8_BAR; PG8_SCHED;
            PG8_LDB(B0, 1, 0); PG8_LDB(B1, 1, 1); PG8_SCHED; PG8_LDA(At, 1, 0); PG8_STAGE(PG8_SA(0, 1), a2 + hstep, voffA);
            PG8_WAIT_V(8); PG8_WAIT_L(0); PG8_BAR; PG8_MMA(0, 0, At, B0); PG8_MMA(0, 1, At, B1); PG8_BAR; PG8_SCHED;
            PG8_LDA(At, 1, 1); PG8_STAGE(PG8_SB(1, 0), b3, voffB); PG8_STAGE(PG8_SB(1, 1), b3 + hstep, voffB); PG8_STAGE(PG8_SA(1, 0), a3, voffA);
            PG8_WAIT_V(8); PG8_WAIT_L(0); PG8_BAR; PG8_MMA(1, 0, At, B0); PG8_MMA(1, 1, At, B1); PG8_BAR; PG8_SCHED;
            } else {
            PG8_LDB(B0, 0, 0); PG8_SCHED; PG8_LDA(At, 0, 0); PG8_STAGE(PG8_SA(1, 1), a1 + hstep, voffA);
            PG8_WAIT_L(8); PG8_BAR; PG8_WAIT_L(0); PG8_MMA(0, 0, At, B0); PG8_BAR; PG8_SCHED;
            PG8_LDB(B1, 0, 1); PG8_STAGE(PG8_SB(0, 0), b2, voffB);
            PG8_BAR; PG8_WAIT_L(0); PG8_MMA(0, 1, At, B1); PG8_BAR;
            PG8_LDA(At, 0, 1); PG8_STAGE(PG8_SA(0, 0), a2, voffA);
            PG8_BAR; PG8_WAIT_L(0); PG8_MMA(1, 0, At, B0); PG8_BAR; PG8_SCHED;
            PG8_STAGE(PG8_SB(0, 1), b2 + hstep, voffB);
            PG8_WAIT_V(6); PG8_BAR; PG8_MMA(1, 1, At, B1); PG8_BAR;
            PG8_LDB(B0, 1, 0); PG8_SCHED; PG8_LDA(At, 1, 0); PG8_STAGE(PG8_SA(0, 1), a2 + hstep, voffA);
            PG8_WAIT_L(8); PG8_BAR; PG8_WAIT_L(0); PG8_MMA(0, 0, At, B0); PG8_BAR; PG8_SCHED;
            PG8_LDB(B1, 1, 1); PG8_STAGE(PG8_SB(1, 0), b3, voffB);
            PG8_BAR; PG8_WAIT_L(0); PG8_MMA(0, 1, At, B1); PG8_BAR;
            PG8_LDA(At, 1, 1); PG8_STAGE(PG8_SA(1, 0), a3, voffA);
            PG8_BAR; PG8_WAIT_L(0); PG8_MMA(1, 0, At, B0); PG8_BAR; PG8_SCHED;
            PG8_STAGE(PG8_SB(1, 1), b3 + hstep, voffB);
            PG8_WAIT_V(6); PG8_BAR; PG8_MMA(1, 1, At, B1); PG8_BAR;
            }
        }
        if constexpr (ALIGN_EPI) { if (wr == 0) PG8_BAR; }
        if constexpr (!Epi::AFTER_DRAIN) { E(acc, cur, wr, wc, fr, fq); S.done(cur); }
        if (!has_next) break;
#pragma unroll
        for (int a = 0; a < 2; ++a)
#pragma unroll
            for (int b = 0; b < 2; ++b)
#pragma unroll
                for (int m = 0; m < 4; ++m)
#pragma unroll
                    for (int n = 0; n < 2; ++n) acc[a][b][m][n] = (f32x4){0.f, 0.f, 0.f, 0.f};
        cur = nxt; cA = nA; cB = nB; ++ui;
        if constexpr (ALIGN_EPI) { if (wr == 1) PG8_BAR; }
    }
    PG8_WAIT_V(0);
    if constexpr (!ALIGN_EPI) { if (wr == 0) PG8_BAR; }
    PG8_BAR;
    if constexpr (Epi::AFTER_DRAIN) { E.fused(acc, cur, wr, wc, fr, fq, lds, wid, lane); S.done(cur); }
#undef PG8_SA
#undef PG8_SB
#undef PG8_STAGE
#undef PG8_LDA
#undef PG8_LDB
#undef PG8_MMA
#undef PG8_WAIT_V
#undef PG8_WAIT_L
#undef PG8_BAR
#undef PG8_SCHED
}
}
namespace fox {
constexpr int D = 128, OPITCH = 2048;
constexpr bool WSKIP = false;
constexpr float THR = 8.f;
constexpr float SCALE = 0.08838834764831845f;
constexpr float INV_SCALE = 11.313708498984761f;
constexpr int NW = 8, QBLK = 32, KVBLK = 64, QB = NW * QBLK;
constexpr int SHM_V = KVBLK * D * 2, SHM_K = KVBLK * D * 2;
constexpr int LDS_BIAS = 2 * SHM_V + 2 * SHM_K + NW * 64 * 4;
constexpr int LDS_BYTES = LDS_BIAS + 2 * 64 * 4;

using bf16 = __hip_bfloat16;
typedef short bf16x8 __attribute__((ext_vector_type(8)));
typedef short s16x4 __attribute__((ext_vector_type(4)));
typedef float f32x16 __attribute__((ext_vector_type(16)));
typedef float f32x4 __attribute__((ext_vector_type(4)));
typedef unsigned u32x4 __attribute__((ext_vector_type(4)));
template <class A, class Bt> struct same_t { static constexpr bool v = false; };
template <class A> struct same_t<A, A> { static constexpr bool v = true; };

#define KSWZ(row, colB) ((row) * 256 + ((colB) ^ (((row) & 7) << 4)))
#define SBAR() __builtin_amdgcn_sched_barrier(0)
__device__ __forceinline__ int v_st(int k, int c) { const int kk = (k & ~0xC) | ((k & 4) << 1) | ((k & 8) >> 1); return ((kk >> 3) * 4 + (c >> 5)) * 512 + ((kk & 7) * 32 + (c & 31)) * 2; }
__device__ __forceinline__ int v_rd_base(int lane) { return ((lane & 3) << 3) | (((lane >> 2) & 3) << 6) | (((lane >> 4) & 1) << 5) | (((lane >> 5) & 1) << 8); }
constexpr int v_rd_off(int d0, int ks, int half) { return d0 * 512 + ks * 4096 + half * 2048; }
__device__ __forceinline__ int crow(int r, int hi) { return (r & 3) + 8 * (r >> 2) + 4 * hi; }
__device__ __forceinline__ unsigned cvtpk(float lo, float hi) {
    unsigned r; asm volatile("v_cvt_pk_bf16_f32 %0, %1, %2" : "=v"(r) : "v"(lo), "v"(hi)); return r;
}
__device__ __forceinline__ bf16x8 pack8(f32x4 a, f32x4 b) {
    u32x4 w = {cvtpk(a[0], a[1]), cvtpk(a[2], a[3]), cvtpk(b[0], b[1]), cvtpk(b[2], b[3])};
    return *reinterpret_cast<bf16x8*>(&w);
}
template <class T> __device__ __forceinline__ bf16x8 load8(const T* p) {
    if constexpr (same_t<T, float>::v) { return pack8(*(const f32x4*)p, *(const f32x4*)(p + 4)); }
    else { return *reinterpret_cast<const bf16x8*>(p); }
}
__device__ __forceinline__ void mask_tile(f32x16& p0, f32x16& p1, int dq, unsigned W) {
    const float NEG = -__builtin_inff();
#pragma unroll
    for (int r = 0; r < 16; ++r) {
        const int c = (r & 3) + 8 * (r >> 2);
        if ((unsigned)(dq - c) >= W) p0[r] = NEG;
        if ((unsigned)(dq - c - 32) >= W) p1[r] = NEG;
    }
}
__device__ __forceinline__ void partialSM(f32x16& p0, f32x16& p1, float& m_reg, float& mn, float& alpha) {
    float pmax = p0[0]; for (int r = 1; r < 16; ++r) pmax = fmaxf(pmax, p0[r]); for (int r = 0; r < 16; ++r) pmax = fmaxf(pmax, p1[r]);
    { auto rr = __builtin_amdgcn_permlane32_swap(__float_as_uint(pmax), __float_as_uint(pmax), false, false);
      pmax = fmaxf(__uint_as_float(rr[0]), __uint_as_float(rr[1])); }
    constexpr float C2 = 1.4426950408889634f * SCALE;
    if (__builtin_expect(__all((pmax - m_reg) * SCALE <= THR), 1)) { mn = m_reg; alpha = 1.f; }
    else { mn = fmaxf(m_reg, pmax); alpha = __builtin_amdgcn_exp2f((m_reg - mn) * C2); m_reg = mn; }
    const float mnL = -mn * C2;
    for (int r = 0; r < 16; ++r) p0[r] = fmaf(p0[r], C2, mnL); for (int r = 0; r < 16; ++r) p1[r] = fmaf(p1[r], C2, mnL);
    for (int r = 0; r < 16; ++r) p0[r] = __builtin_amdgcn_exp2f(p0[r]);
}
__device__ __forceinline__ void finishSM(f32x16& p0, f32x16& p1, float alpha, float& l_reg, bf16x8& pa0, bf16x8& pa1, bf16x8& pa2, bf16x8& pa3) {
    for (int r = 0; r < 16; ++r) p1[r] = __builtin_amdgcn_exp2f(p1[r]);
    float ps = 0; for (int r = 0; r < 16; ++r) ps += p0[r]; for (int r = 0; r < 16; ++r) ps += p1[r];
    { auto rr = __builtin_amdgcn_permlane32_swap(__float_as_uint(ps), __float_as_uint(ps), false, false);
      ps = __uint_as_float(rr[0]) + __uint_as_float(rr[1]); }
    l_reg = l_reg * alpha + ps;
#define PK4(P, B_, OUT) do { unsigned a0 = cvtpk(P[B_+0], P[B_+1]), a1 = cvtpk(P[B_+2], P[B_+3]);                          \
        unsigned b0 = cvtpk(P[B_+4], P[B_+5]), b1 = cvtpk(P[B_+6], P[B_+7]);                                             \
        auto r0 = __builtin_amdgcn_permlane32_swap(a0, b0, false, false); auto r1 = __builtin_amdgcn_permlane32_swap(a1, b1, false, false); \
        u32x4 w = {r0[0], r1[0], r0[1], r1[1]}; OUT = *reinterpret_cast<bf16x8*>(&w); } while (0)
    PK4(p0, 0, pa0); PK4(p0, 8, pa1); PK4(p1, 0, pa2); PK4(p1, 8, pa3);
#undef PK4
}
template <int KB, bool SK>
__device__ __forceinline__ void qkt(f32x16& p0, f32x16& p1, const char* K_lds, int r32, int hi, const bf16x8* qr, bool act) {
    const float* bl_ = (const float*)(K_lds + 2 * SHM_K + NW * 64 * 4) + KB * 64 + 4 * hi;
    if (SK && !act) { const float NEG = -__builtin_inff();
#pragma unroll
        for (int r = 0; r < 16; ++r) { p0[r] = NEG; p1[r] = NEG; } return; }
#pragma unroll
    for (int g = 0; g < 4; ++g) { const f32x4 v0_ = *(const f32x4*)(bl_ + 8 * g), v1_ = *(const f32x4*)(bl_ + 32 + 8 * g);
        p0[4 * g] = v0_[0]; p0[4 * g + 1] = v0_[1]; p0[4 * g + 2] = v0_[2]; p0[4 * g + 3] = v0_[3];
        p1[4 * g] = v1_[0]; p1[4 * g + 1] = v1_[1]; p1[4 * g + 2] = v1_[2]; p1[4 * g + 3] = v1_[3]; }
    const char* kb[4];
#pragma unroll
    for (int dd = 0; dd < 4; ++dd) kb[dd] = K_lds + KB * SHM_K + KSWZ(r32, (dd * 16 + hi * 8) * 2);
#pragma unroll
    for (int d0 = 0; d0 < 8; ++d0) { const char* a = kb[d0 & 3] + (d0 >> 2) * 128;
        bf16x8 b0 = *reinterpret_cast<const bf16x8*>(a);
        bf16x8 b1 = *reinterpret_cast<const bf16x8*>(a + 32 * 256);
        p0 = __builtin_amdgcn_mfma_f32_32x32x16_bf16(b0, qr[d0], p0, 0, 0, 0);
        p1 = __builtin_amdgcn_mfma_f32_32x32x16_bf16(b1, qr[d0], p1, 0, 0, 0); }
}
template <int VB, bool SK>
__device__ __forceinline__ void pv_tile(f32x16* o, int vb0, bf16x8 pa0, bf16x8 pa1, bf16x8 pa2, bf16x8 pa3, bool act) {
    if (SK && !act) return;
#define TRRD(dst, off) asm volatile("ds_read_b64_tr_b16 %0, %1 offset:%2" : "=&v"(dst) : "v"(vb0), "i"(off) : "memory")
#define PV_D0(d0) do { s16x4 l0, l1, l2, l3, h0, h1, h2, h3; constexpr int b_ = VB * SHM_V + v_rd_off(d0, 0, 0);     \
        TRRD(l0, b_); TRRD(h0, b_ + 2048); TRRD(l1, b_ + 4096); TRRD(h1, b_ + 6144); TRRD(l2, b_ + 8192); TRRD(h2, b_ + 10240); TRRD(l3, b_ + 12288); TRRD(h3, b_ + 14336); \
        asm volatile("s_waitcnt lgkmcnt(0)" ::: "memory"); SBAR();                 \
        o[d0] = __builtin_amdgcn_mfma_f32_32x32x16_bf16(pa0, (bf16x8){l0[0], l0[1], l0[2], l0[3], h0[0], h0[1], h0[2], h0[3]}, o[d0], 0, 0, 0);   \
        o[d0] = __builtin_amdgcn_mfma_f32_32x32x16_bf16(pa1, (bf16x8){l1[0], l1[1], l1[2], l1[3], h1[0], h1[1], h1[2], h1[3]}, o[d0], 0, 0, 0);   \
        o[d0] = __builtin_amdgcn_mfma_f32_32x32x16_bf16(pa2, (bf16x8){l2[0], l2[1], l2[2], l2[3], h2[0], h2[1], h2[2], h2[3]}, o[d0], 0, 0, 0);   \
        o[d0] = __builtin_amdgcn_mfma_f32_32x32x16_bf16(pa3, (bf16x8){l3[0], l3[1], l3[2], l3[3], h3[0], h3[1], h3[2], h3[3]}, o[d0], 0, 0, 0); } while (0)
    PV_D0(0); PV_D0(1); PV_D0(2); PV_D0(3);
#undef PV_D0
#undef TRRD
}

template <class TIn, class TOut> struct BlockRef { const TIn* Q; const TIn* K; const TIn* V; TOut* O; int P0; const float* F; const float* NW_; };
template <class TIn> struct Seam {
    bf16x8 qr[8];
    bf16x8 st_v0, st_v1, st_k0, st_k1; f32x4 sf0, sf1, sf2, sf3;
    f32x4 tq[16];
};
__device__ __forceinline__ int swa_jlo(int P0, int W) { const int lowk = P0 - W + 1; return lowk > 0 ? lowk / KVBLK : 0; }
#define ROW(p, k0, rr) ((p) + (size_t)((k0) + (rr)) * D + sc)
#define VMW() asm volatile("s_waitcnt vmcnt(0)" ::: "memory")
#define VMWN(n) asm volatile("s_waitcnt vmcnt(%0)" :: "i"(n) : "memory")
#define SLOAD_H(Kp, Vp, Fp, k0, bfb) do { S.st_v0 = load8<TIn>(ROW(Vp, k0, sr)); S.st_v1 = load8<TIn>(ROW(Vp, k0, 32 + sr));              \
                         S.st_k0 = load8<TIn>(ROW(Kp, k0, sr)); S.st_k1 = load8<TIn>(ROW(Kp, k0, 32 + sr));                         \
                         if (wid == 0) __builtin_amdgcn_global_load_lds((const unsigned*)((Fp) + (k0) + lane),                          \
                             (__attribute__((address_space(3))) unsigned*)(bias_las + (bfb) * 256), 4, 0, 0); } while (0)
#define SWRITE_HK(bf) do { *(bf16x8*)(K_lds + (bf) * SHM_K + kws) = S.st_k0; *(bf16x8*)(K_lds + (bf) * SHM_K + kws + 32 * 256) = S.st_k1; } while (0)
#define SWRITE_HV(bf) do { *(bf16x8*)(V_lds + (bf) * SHM_V + vst0) = S.st_v0; *(bf16x8*)(V_lds + (bf) * SHM_V + vst1) = S.st_v1; } while (0)
#define SWRITE_H(bf) do { SWRITE_HV(bf); SWRITE_HK(bf); } while (0)
#define SLOAD_F(p, k0) do { S.sf0 = *(const f32x4*)ROW(p, k0, sr); S.sf1 = *(const f32x4*)(ROW(p, k0, sr) + 4);                \
                            S.sf2 = *(const f32x4*)ROW(p, k0, 32 + sr); S.sf3 = *(const f32x4*)(ROW(p, k0, 32 + sr) + 4); } while (0)
#define SWRITE_KF(bf) do { *(bf16x8*)(K_lds + (bf) * SHM_K + kws) = pack8(S.sf0, S.sf1); *(bf16x8*)(K_lds + (bf) * SHM_K + kws + 32 * 256) = pack8(S.sf2, S.sf3); } while (0)
#define SWRITE_VF(bf) do { *(bf16x8*)(V_lds + (bf) * SHM_V + vst0) = pack8(S.sf0, S.sf1); *(bf16x8*)(V_lds + (bf) * SHM_V + vst1) = pack8(S.sf2, S.sf3); } while (0)
template <class TIn, class TOut>
__device__ __forceinline__ void causal_swa_prime(const BlockRef<TIn, TOut>& cur, int W, char* lds, Seam<TIn>& S) {
    constexpr bool F32 = same_t<TIn, float>::v;
    const int tid = threadIdx.x, wid = __builtin_amdgcn_readfirstlane(tid >> 6), lane = tid & 63, r32 = lane & 31, hi = lane >> 5;
    const int sr = tid >> 4, sc = (tid & 15) * 8, kws = KSWZ(sr, sc * 2); char* K_lds = lds + 2 * SHM_V;
    __attribute__((address_space(3))) unsigned char* bias_las = (__attribute__((address_space(3))) unsigned char*)lds + LDS_BIAS;
    const int kb0 = swa_jlo(cur.P0, W) * KVBLK;
    for (int d0 = 0; d0 < 8; ++d0) S.qr[d0] = load8<TIn>(cur.Q + (size_t)(wid * QBLK + r32) * D + d0 * 16 + hi * 8);
    if constexpr (F32) { SLOAD_F((const float*)cur.K, kb0); VMW(); SWRITE_KF(0); SBAR(); SLOAD_F((const float*)cur.V, kb0); }
    else { SLOAD_H(cur.K, cur.V, cur.F, kb0, 0); VMW(); SWRITE_HK(0); }
    __syncthreads();
}
template <class TIn, class TOut>
__device__ __forceinline__ void causal_swa_block(const BlockRef<TIn, TOut>& cur, const BlockRef<TIn, TOut>& nxt, int skv, int W, char* lds, Seam<TIn>& S) {
    constexpr bool F32 = same_t<TIn, float>::v;
    const int tid = threadIdx.x, wid = __builtin_amdgcn_readfirstlane(tid >> 6), lane = tid & 63, r32 = lane & 31, hi = lane >> 5;
    const int j_lo = swa_jlo(cur.P0, W);
    int j_hi = (cur.P0 + QB - 1) / KVBLK + 1; if (j_hi > skv / KVBLK) j_hi = skv / KVBLK;
    const int NT = j_hi - j_lo;
    const int kbn = swa_jlo(nxt.P0, W) * KVBLK;
    const int qlo = cur.P0 + wid * QBLK, qm = qlo + r32 - 4 * hi;
    char* V_lds = lds; char* K_lds = lds + 2 * SHM_V;
    __attribute__((address_space(3))) unsigned char* bias_las = (__attribute__((address_space(3))) unsigned char*)lds + LDS_BIAS;
    float* ws = (float*)(lds + 2 * SHM_V + 2 * SHM_K) + wid * 64; float* li_l = ws, * al_l = ws + 32;
    float m_reg = -1e30f, l_reg = 0; f32x16 o[4] = {};
    const int sr = tid >> 4, sc = (tid & 15) * 8, vst0 = v_st(sr, sc), vst1 = v_st(32 + sr, sc), kws = KSWZ(sr, sc * 2);
    const int vb0 = (int)(uintptr_t)V_lds + v_rd_base(lane);
    const TIn* Kh = cur.K; const TIn* Vh = cur.V; const float* Fh = cur.F;
#define RESC(a) do { if (__any((a) < 1.f)) { if (hi == 0) al_l[r32] = (a); asm volatile("s_waitcnt lgkmcnt(0)" ::: "memory");              \
                     for (int d_ = 0; d_ < 4; ++d_) for (int r = 0; r < 16; ++r) o[d_][r] *= al_l[crow(r, hi)]; } } while (0)
#define KBASE(t) ((j_lo + (t)) * KVBLK)
#define ACT(t) (KBASE(t) <= qlo + QBLK - 1 && KBASE(t) + KVBLK - 1 >= qlo - W + 1)
#define MASKT(P0_, P1_, t) do { const int kb_ = KBASE(t); if ((!SK || ACT(t)) && (kb_ + KVBLK - 1 > qlo || kb_ <= qlo + QBLK - 1 - W)) mask_tile(P0_, P1_, qm - kb_, (unsigned)W); } while (0)
    constexpr int NQL = F32 ? 16 : 8;
    constexpr bool SK = WSKIP && !F32;
#define SEAM_K0() do { VMWN(NQL); if constexpr (F32) { SWRITE_KF(0); SBAR(); SLOAD_F((const float*)nxt.V, kbn); } else { SWRITE_HK(0); } SBAR(); } while (0)
    f32x16 pA0, pA1, pB0, pB1; float mnA, mnB, alA, alB; bf16x8 pa0, pa1, pa2, pa3;
    if constexpr (F32) { VMW(); SWRITE_VF(0); SBAR(); } else { SWRITE_HV(0); SBAR(); }
    if (NT > 1) { if constexpr (F32) SLOAD_F((const float*)Kh, KBASE(1)); else SLOAD_H(Kh, Vh, Fh, KBASE(1), 1); }
    SBAR(); qkt<0, SK>(pA0, pA1, K_lds, r32, hi, S.qr, ACT(0));
    if constexpr (F32) { if (NT > 1) { VMW(); SWRITE_KF(1); SBAR(); SLOAD_F((const float*)Vh, KBASE(1)); } }
    MASKT(pA0, pA1, 0); partialSM(pA0, pA1, m_reg, mnA, alA);
    if (NT > 1) { VMW(); if constexpr (F32) { SWRITE_VF(1); SBAR(); if (NT > 2) SLOAD_F((const float*)Kh, KBASE(2)); } else SWRITE_H(1); }
    __syncthreads();
#define HALF_STEP(PX0, PX1, mnX, alX, PY0, PY1, alY, t, KB, VB, SB) do {                                                      \
        SBAR(); qkt<KB, SK>(PX0, PX1, K_lds, r32, hi, S.qr, ACT(t));                                             \
        finishSM(PY0, PY1, alY, l_reg, pa0, pa1, pa2, pa3); SBAR();                                                           \
        if ((t) + 1 < NT) { if constexpr (F32) { VMW(); SWRITE_KF(SB); SBAR(); SLOAD_F((const float*)Vh, KBASE((t) + 1)); }  \
                            else { SLOAD_H(Kh, Vh, Fh, KBASE((t) + 1), SB); } SBAR(); }                                       \
        pv_tile<VB, SK>(o, vb0, pa0, pa1, pa2, pa3, ACT((t) - 1)); MASKT(PX0, PX1, (t)); partialSM(PX0, PX1, m_reg, mnX, alX);                                        \
        __syncthreads();                                                                                                      \
        if ((t) + 1 < NT) { VMW(); if constexpr (F32) { SWRITE_VF(SB); SBAR(); if ((t) + 2 < NT) SLOAD_F((const float*)Kh, KBASE((t) + 2)); } \
                            else { SWRITE_H(SB); } }                                                                          \
        RESC(alX); __syncthreads(); } while (0)
    for (int t = 1; t + 1 < NT; t += 2) {
        HALF_STEP(pB0, pB1, mnB, alB, pA0, pA1, alA, t, 1, 0, 0);
        HALF_STEP(pA0, pA1, mnA, alA, pB0, pB1, alB, t + 1, 0, 1, 1);
    }
    const bool even = (NT & 1) == 0;
    if (even) { SBAR(); qkt<1, SK>(pB0, pB1, K_lds, r32, hi, S.qr, ACT(NT - 1)); SBAR(); }
#define QROW(e) (nxt.Q + (size_t)(wid * QBLK + r32) * D + ((e) >> 1) * 16 + hi * 8 + ((e) & 1) * 4)
    if constexpr (F32) { SLOAD_F((const float*)nxt.K, kbn); SBAR();
#pragma unroll
        for (int e = 0; e < 8; ++e) S.tq[e] = *(const f32x4*)QROW(e); }
    else { SLOAD_H(nxt.K, nxt.V, nxt.F, kbn, 0); SBAR();
#pragma unroll
        for (int d0 = 0; d0 < 8; ++d0) S.qr[d0] = load8<TIn>(nxt.Q + (size_t)(wid * QBLK + r32) * D + d0 * 16 + hi * 8); }
    SBAR();
    finishSM(pA0, pA1, alA, l_reg, pa0, pa1, pa2, pa3); SBAR();
    if constexpr (F32) {
#pragma unroll
        for (int e = 8; e < 16; ++e) S.tq[e] = *(const f32x4*)QROW(e); SBAR(); }
#undef QROW
    pv_tile<0, SK>(o, vb0, pa0, pa1, pa2, pa3, ACT(even ? NT - 2 : NT - 1));
    if (even) { MASKT(pB0, pB1, NT - 1); partialSM(pB0, pB1, m_reg, mnB, alB); __syncthreads(); RESC(alB);
        finishSM(pB0, pB1, alB, l_reg, pa0, pa1, pa2, pa3); SBAR(); pv_tile<1, SK>(o, vb0, pa0, pa1, pa2, pa3, ACT(NT - 1)); }
    SBAR(); SEAM_K0();
    if (hi == 0) li_l[r32] = l_reg; asm volatile("s_waitcnt lgkmcnt(0)" ::: "memory");
    {
        typedef __attribute__((address_space(3))) float lasf;
        lasf* ssq_l = (lasf*)(__attribute__((address_space(3))) unsigned char*)lds + (LDS_BIAS - NW * 64 * 4) / 4 + wid * 64 + 32;
        float rli[16];
#pragma unroll
        for (int r = 0; r < 16; ++r) rli[r] = __builtin_amdgcn_rcpf(li_l[crow(r, hi)]);
        if (hi == 0) al_l[r32] = 0.f;
        asm volatile("s_waitcnt lgkmcnt(0)" ::: "memory");
#pragma unroll
        for (int r = 0; r < 16; ++r) { float ss_ = 0.f;
#pragma unroll
            for (int d0 = 0; d0 < 4; ++d0) { const float v = o[d0][r] * rli[r]; ss_ += v * v; }
            (void)__hip_atomic_fetch_add(ssq_l + crow(r, hi), ss_, __ATOMIC_RELAXED, __HIP_MEMORY_SCOPE_WORKGROUP); }
        asm volatile("s_waitcnt lgkmcnt(0)" ::: "memory");
#pragma unroll
        for (int r = 0; r < 16; ++r) rli[r] *= __builtin_amdgcn_rsqf(al_l[crow(r, hi)] * (1.0f / 128.0f) + 1e-6f);
        float wn_[4];
#pragma unroll
        for (int d0 = 0; d0 < 4; ++d0) wn_[d0] = cur.NW_[d0 * 32 + r32];
        TOut* Ow = cur.O + (size_t)(wid * QBLK) * OPITCH;
#pragma unroll
        for (int r = 0; r < 16; ++r) { const int orow = crow(r, hi);
#pragma unroll
            for (int d0 = 0; d0 < 4; ++d0) { const float v = o[d0][r] * rli[r] * wn_[d0];
                const float vn = __shfl_xor(v, 1);
                if ((r32 & 1) == 0) *(unsigned*)(Ow + (size_t)orow * OPITCH + d0 * 32 + r32) = cvtpk(v, vn); } }
    }
    if constexpr (F32) {
#pragma unroll
        for (int d0 = 0; d0 < 8; ++d0) S.qr[d0] = pack8(S.tq[2 * d0], S.tq[2 * d0 + 1]); }
    __syncthreads();
#undef RESC
#undef KBASE
#undef ACT
#undef MASKT
#undef SEAM_K0
#undef HALF_STEP
}
#undef ROW
#undef VMW
#undef VMWN
#undef SLOAD_H
#undef SWRITE_HK
#undef SWRITE_HV
#undef SWRITE_H
#undef SLOAD_F
#undef SWRITE_KF
#undef SWRITE_VF
}
constexpr int NWAVES = 8;
constexpr int NTHR = NWAVES * 64;
#ifndef MK_N_LAUNCHES
#define MK_N_LAUNCHES 1
#endif
constexpr int NPHASE = 8;
constexpr int BATCH = 2, SEQ = 16384, DM = 2048, T = BATCH * SEQ;
constexpr int NZ = 6400;
constexpr int NCH = SEQ / 128;
constexpr float NORM_EPS = 1e-6f;
constexpr size_t MiB = 1u << 20;
constexpr size_t WS_CTL = 0, CTL_ZERO_BYTES = 64 * 1024;
constexpr size_t WS_WINT = 1 * MiB;
constexpr size_t WS_WOUTT = 26 * MiB;
constexpr size_t WS_WQT = 34 * MiB;
constexpr size_t WS_KEYS = 42 * MiB;
constexpr size_t WS_FCUM = 43 * MiB;
constexpr size_t WS_MSM = 44 * MiB;
constexpr size_t WS_GATES = 46 * MiB;
constexpr size_t WS_UB = 48 * MiB;
constexpr size_t WS_VB = 80 * MiB;
constexpr size_t WS_PEI = 432 * MiB;
constexpr size_t WS_PEG = 448 * MiB;
constexpr size_t WS_H = 176 * MiB;
constexpr size_t WS_FQ = 304 * MiB, WS_FK = 368 * MiB, WS_FV = 432 * MiB;
constexpr size_t WS_MQ = 496 * MiB, WS_MK = 528 * MiB;
constexpr size_t WS_MV = 560 * MiB, WS_MO = 624 * MiB;
constexpr size_t WS_PQ = 304 * MiB;
constexpr size_t WS_CPREV = 688 * MiB;
constexpr size_t WS_MIXED = 752 * MiB;
constexpr size_t WS_END = 880 * MiB;
constexpr int MS_MLOC = 0, MS_BLAST = 1024, MS_MPREV = 2048, MS_NLOC = 4096, MS_NPREV = 4096 + 131072;
constexpr int MS_USC = 300000, MS_VSC = 320000;
constexpr int CW_BAR = 4096;

constexpr int LDS_BYTES = 160 * 1024;
constexpr int MISC_OFF = LDS_BYTES - 256;
constexpr int SCR_BYTES = MISC_OFF;

#define GAS __attribute__((address_space(1)))
#define LAS __attribute__((address_space(3)))
typedef unsigned short bf16;
typedef unsigned v4u __attribute__((ext_vector_type(4)));
typedef unsigned v2u __attribute__((ext_vector_type(2)));
typedef float f32x4 __attribute__((ext_vector_type(4)));
typedef float f32x2 __attribute__((ext_vector_type(2)));
typedef float f32x16 __attribute__((ext_vector_type(16)));
typedef short bf16x8 __attribute__((ext_vector_type(8)));
typedef GAS unsigned gu32;
#define RLX_AGENT __ATOMIC_RELAXED, __HIP_MEMORY_SCOPE_AGENT
#define LDS_WAIT() asm volatile("s_waitcnt lgkmcnt(0)" ::: "memory")
#define VM_WAIT() asm volatile("s_waitcnt vmcnt(0)" ::: "memory")
__device__ __forceinline__ unsigned cvtpk(float lo, float hi) { unsigned r; asm volatile("v_cvt_pk_bf16_f32 %0, %1, %2" : "=v"(r) : "v"(lo), "v"(hi)); return r; }
__device__ __forceinline__ float bflo(unsigned w) { return __uint_as_float(w << 16); }
__device__ __forceinline__ float bfhi(unsigned w) { return __uint_as_float(w & 0xffff0000u); }
__device__ __forceinline__ float logsig(float x) { return fminf(x, 0.f) - log1pf(__expf(-fabsf(x))); }
__device__ __forceinline__ float wave_sum(float v) {
#pragma unroll
    for (int o = 1; o < 64; o <<= 1) v += __shfl_xor(v, o);
    return v;
}
__device__ __forceinline__ float wave_max(float v) {
#pragma unroll
    for (int o = 1; o < 64; o <<= 1) v = fmaxf(v, __shfl_xor(v, o));
    return v;
}
#define XB_TMO      128
#define XB_XCNT(j)  (256  + 64 * (j))
#define XB_XSUB(j)  (1280 + 64 * (j))
#define XB_XGEN(j)  (2304 + 64 * (j))
#define XB_TOP      3328
#define XB_TOPGEN   3392
#define XCD_BAR_WORDS 3456
#define XB_SPIN_CAP (1u << 18)

__device__ __forceinline__ unsigned xb_ld(unsigned* p)              { return __hip_atomic_load(p, __ATOMIC_RELAXED, __HIP_MEMORY_SCOPE_AGENT); }
__device__ __forceinline__ unsigned xb_add(unsigned* p, unsigned v) { return __hip_atomic_fetch_add(p, v, __ATOMIC_RELAXED, __HIP_MEMORY_SCOPE_AGENT); }
__device__ __forceinline__ unsigned xb_xcc_id() { return (unsigned)__builtin_amdgcn_s_getreg((3 << 11) | 20) & 0xFu; }
#define XB_SPIN(cond, bar) do { unsigned _sp = 0; while (cond) { __builtin_amdgcn_s_sleep(1); \
    if ((++_sp & 255u) == 0u) { if (xb_ld(&(bar)[XB_TMO])) break; if (_sp > XB_SPIN_CAP) { atomicAdd(&(bar)[XB_TMO], 1u); break; } } } } while (0)

struct XcdBarrier {
    unsigned* bar; unsigned x;
    volatile LAS unsigned* st;
};

__device__ __forceinline__ XcdBarrier xcd_barrier_post(unsigned* bar, volatile LAS unsigned* st) {
    XcdBarrier b; b.bar = bar; b.x = xb_xcc_id(); b.st = st;
    if (threadIdx.x == 0) (void)xb_add(&bar[XB_XCNT(b.x)], 1u);
    return b;
}
__device__ __forceinline__ void xcd_barrier_complete(unsigned* bar, unsigned x, unsigned& nloc, unsigned& nx) {
    const unsigned G = gridDim.x * gridDim.y * gridDim.z;
    unsigned sum, cnt, mine, sp = 0u;
    for (;;) {
        sum = 0u; cnt = 0u; mine = 0u;
#pragma unroll
        for (unsigned j = 0; j < 16; ++j) { const unsigned c = xb_ld(&bar[XB_XCNT(j)]); sum += c; cnt += (c > 0u) ? 1u : 0u; mine = (j == x) ? c : mine; }
        if (sum == G) break;
        __builtin_amdgcn_s_sleep(1);
        if ((++sp & 255u) == 0u) { if (xb_ld(&bar[XB_TMO])) break; if (sp > XB_SPIN_CAP) { atomicAdd(&bar[XB_TMO], 1u); break; } }
    }
    nloc = mine > 0u ? mine : 1u; nx = cnt > 0u ? cnt : 1u;
}

__device__ __forceinline__ void xcd_barrier(const XcdBarrier& b) {
    asm volatile("s_waitcnt vmcnt(0)" ::: "memory");
    __syncthreads();
    if (threadIdx.x == 0) {
        unsigned* bar = b.bar;
        __builtin_amdgcn_s_waitcnt(0);
        unsigned nloc = b.st[0], nx = b.st[1];
        if (nloc == 0u) { xcd_barrier_complete(bar, b.x, nloc, nx); b.st[0] = nloc; b.st[1] = nx; }
        const unsigned old = xb_add(&bar[XB_XSUB(b.x)], 1u);
        const unsigned gen = old / nloc;
        if (old + 1u == (gen + 1u) * nloc) {
            __builtin_amdgcn_fence(__ATOMIC_RELEASE, "agent");
            asm volatile("s_waitcnt vmcnt(0)" ::: "memory");
            const unsigned og = xb_add(&bar[XB_TOP], 1u);
            const unsigned tg = og / nx;
            if (og + 1u == (tg + 1u) * nx) xb_add(&bar[XB_TOPGEN], 1u);
            else XB_SPIN(xb_ld(&bar[XB_TOPGEN]) == tg, bar);
            __builtin_amdgcn_fence(__ATOMIC_ACQUIRE, "agent");
            xb_add(&bar[XB_XGEN(b.x)], 1u);
            asm volatile("s_waitcnt vmcnt(0)" ::: "memory");
        } else {
            XB_SPIN(xb_ld(&bar[XB_XGEN(b.x)]) == gen, bar);
            __builtin_amdgcn_fence(__ATOMIC_ACQUIRE, "agent");
            asm volatile("s_waitcnt vmcnt(0)" ::: "memory");
        }
    }
    __syncthreads();
}

struct Args {
    const float* x; const float* norm1_w; const float* w_in; const float* fox_f_bias; const float* conv_w; const float* conv_b;
    const float* i_bias; const float* f_bias; const float* fox_nw; const float* ml_nw; const float* w_out; const float* norm2_w;
    const float* w_q; const float* keys; const float* pu; const float* pv; const float* final_w;
    float* out; unsigned char* ws; int ph_lo, ph_hi, li, pad;
};
typedef const __attribute__((address_space(4))) Args* KA;
typedef __bf16 bf2_t __attribute__((ext_vector_type(2)));
__device__ __forceinline__ float dot2bf(unsigned a, unsigned b, float c) { return __builtin_amdgcn_fdot2_f32_bf16(__builtin_bit_cast(bf2_t, a), __builtin_bit_cast(bf2_t, b), c, false); }
#define MFMA16(a, b, c) __builtin_amdgcn_mfma_f32_16x16x32_bf16((a), (b), (c), 0, 0, 0)
#define MFMA32(a, b, c) __builtin_amdgcn_mfma_f32_32x32x16_bf16((a), (b), (c), 0, 0, 0)

__device__ __forceinline__ void p0_transpose_item(const float* W, int ldw, int src_col, bf16* WT, int dst_row, int Kp, int k0, LAS float* scr, int lane) {
#pragma unroll 8
    for (int i = 0; i < 32; ++i) { const int kk = 2 * i + (lane >> 5); scr[kk * 33 + (lane & 31)] = W[(size_t)(k0 + kk) * ldw + src_col + (lane & 31)]; }
    LDS_WAIT(); asm volatile("" ::: "memory");
    const int c = lane & 7;
#pragma unroll
    for (int j = 0; j < 4; ++j) { const int n = (lane >> 3) + 8 * j; const LAS float* s = scr + (8 * c) * 33 + n;
        v4u o; o.x = cvtpk(s[0 * 33], s[1 * 33]); o.y = cvtpk(s[2 * 33], s[3 * 33]); o.z = cvtpk(s[4 * 33], s[5 * 33]); o.w = cvtpk(s[6 * 33], s[7 * 33]);
        *(GAS v4u*)(WT + (size_t)(dst_row + n) * Kp + k0 + 8 * c) = o; }
    LDS_WAIT(); asm volatile("" ::: "memory");
}
__device__ __forceinline__ void rms_row_to_bf16(const float* xrow, const f32x4 (&w)[8], bf16* orow, int lane) {
    const GAS f32x4* xr = (const GAS f32x4*)xrow + lane;
    f32x4 v[8]; float s = 0.f;
#pragma unroll
    for (int j = 0; j < 8; ++j) { v[j] = xr[64 * j]; s += (v[j].x * v[j].x + v[j].y * v[j].y) + (v[j].z * v[j].z + v[j].w * v[j].w); }
    const float rn = __builtin_amdgcn_rsqf(wave_sum(s) * (1.f / DM) + NORM_EPS);
    GAS v2u* o8 = (GAS v2u*)orow + lane;
#pragma unroll
    for (int j = 0; j < 8; ++j) { v2u o; o.x = cvtpk(v[j].x * rn * w[j].x, v[j].y * rn * w[j].y); o.y = cvtpk(v[j].z * rn * w[j].z, v[j].w * rn * w[j].w); o8[64 * j] = o; }
}
__device__ __forceinline__ void rms_phase(const float* X, const float* wv, bf16* O, int gw, int NGW, int lane) {
    f32x4 w[8];
#pragma unroll
    for (int j = 0; j < 8; ++j) w[j] = ((const f32x4*)wv)[64 * j + lane];
    for (int m = gw; m < T; m += NGW) rms_row_to_bf16(X + (size_t)m * DM, w, O + (size_t)m * DM, lane);
}
__device__ __forceinline__ void cvt_stream(const float* src, bf16* dst, size_t ngroups8, size_t gid, size_t nthr) {
    for (size_t g = gid; g < ngroups8; g += nthr) { const f32x4 a = ((const f32x4*)src)[2 * g], b = ((const f32x4*)src)[2 * g + 1];
        v4u o; o.x = cvtpk(a.x, a.y); o.y = cvtpk(a.z, a.w); o.z = cvtpk(b.x, b.y); o.w = cvtpk(b.z, b.w); ((v4u*)dst)[g] = o; }
}
__device__ __forceinline__ void quant_row_fp8(const float* src, unsigned char* dst, float* sc_out, int lane) {
    f32x4 v[2][4]; float am = 0.f;
#pragma unroll
    for (int j = 0; j < 2; ++j)
#pragma unroll
        for (int i = 0; i < 4; ++i) { v[j][i] = *(const f32x4*)(src + 1024 * j + 16 * lane + 4 * i);
            am = fmaxf(am, fmaxf(fmaxf(fabsf(v[j][i].x), fabsf(v[j][i].y)), fmaxf(fabsf(v[j][i].z), fabsf(v[j][i].w)))); }
    am = wave_max(am);
    const float s = am > 0.f ? 224.f / am : 1.f;
#pragma unroll
    for (int j = 0; j < 2; ++j) { v4u o;
#pragma unroll
        for (int i = 0; i < 4; ++i) { int p = __builtin_amdgcn_cvt_pk_fp8_f32(v[j][i].x * s, v[j][i].y * s, 0, false); p = __builtin_amdgcn_cvt_pk_fp8_f32(v[j][i].z * s, v[j][i].w * s, p, true); o[i] = (unsigned)p; }
        *(v4u*)(dst + 1024 * j + 16 * lane) = o; }
    if (lane == 0) *sc_out = am > 0.f ? am * (1.f / 224.f) : 1.f;
}
__device__ __forceinline__ void p0_prologue(KA a, LAS unsigned char* lds, int tid, int lane, int wave, int vcu, int G) {
    unsigned char* ws = a->ws;
    bf16* WINT = (bf16*)(ws + WS_WINT); bf16* WOUTT = (bf16*)(ws + WS_WOUTT); bf16* WQT = (bf16*)(ws + WS_WQT);
    LAS float* scr = (LAS float*)(lds + wave * 16384);
    const int gw = vcu * NWAVES + wave, NGW = G * NWAVES;
    constexpr int I_IN = 32 * 192, I_SQ = 32 * 64;
    for (int it = gw; it < I_IN + 2 * I_SQ; it += NGW) {
        int r = it;
        if (r < I_IN) { const int kb = r / 192, nb = r % 192, n0 = nb * 32; const int src = n0 < 3072 ? n0 : (n0 < 5120 ? n0 + 8 : n0 + 16);
            p0_transpose_item(a->w_in, 6160, src, WINT, n0, DM, kb * 64, scr, lane); continue; }
        r -= I_IN;
        if (r < I_SQ) { p0_transpose_item(a->w_out, DM, (r % 64) * 32, WOUTT, (r % 64) * 32, DM, (r / 64) * 64, scr, lane); continue; }
        r -= I_SQ;
        p0_transpose_item(a->w_q, DM, (r % 64) * 32, WQT, (r % 64) * 32, DM, (r / 64) * 64, scr, lane);
    }
    const size_t gid = (size_t)vcu * NTHR + tid, nthr = (size_t)G * NTHR;
    for (size_t g = gid; g < 256 * 256; g += nthr) { const int i = (int)(g >> 8), k0 = (int)(g & 255) * 8;
        const int src = i < 8 ? 3072 + i : (i < 12 ? 5128 + (i - 8) : 5132 + (i - 12));
        float v[8];
#pragma unroll
        for (int j = 0; j < 8; ++j) v[j] = i < 16 ? a->w_in[(size_t)(k0 + j) * 6160 + src] : 0.f;
        v4u o; o.x = cvtpk(v[0], v[1]); o.y = cvtpk(v[2], v[3]); o.z = cvtpk(v[4], v[5]); o.w = cvtpk(v[6], v[7]);
        *(v4u*)(WINT + (size_t)(6144 + i) * DM + k0) = o; }
    cvt_stream(a->keys, (bf16*)(ws + WS_KEYS), 2 * 128 * 128 / 8, gid, nthr);
    { float* MSM = (float*)(ws + WS_MSM);
      for (int r = gw; r < 2 * 16384; r += NGW) { const int t = r >> 14, row = r & 16383;
          quant_row_fp8((t ? a->pv : a->pu) + (size_t)row * DM, ws + (t ? WS_VB : WS_UB) + (size_t)row * DM, MSM + (t ? MS_VSC : MS_USC) + row, lane); } }
    rms_phase(a->x, a->norm1_w, (bf16*)(ws + WS_H), gw, NGW, lane);
}

__device__ __forceinline__ void fox_cumsum(KA a, LAS unsigned char* lds, int bh, int tid, int lane, int wave) {
    const float* GATES = (const float*)(a->ws + WS_GATES); float* F = (float*)(a->ws + WS_FCUM) + (size_t)bh * SEQ;
    const int b = bh >> 3, h = bh & 7; const float bias = a->fox_f_bias[h];
    LAS float* wt = (LAS float*)lds;
    float v[32]; float run = 0.f;
#pragma unroll
    for (int i = 0; i < 32; ++i) { run += logsig(GATES[((size_t)b * SEQ + tid * 32 + i) * 16 + h] + bias); v[i] = run; }
    float sc = run;
#pragma unroll
    for (int o = 1; o < 64; o <<= 1) { const float n = __shfl_up(sc, o); if (lane >= o) sc += n; }
    if (lane == 63) wt[wave] = sc;
    __syncthreads();
    float off = sc - run;
    for (int w = 0; w < wave; ++w) off += wt[w];
#pragma unroll
    for (int i = 0; i < 32; i += 4) *(f32x4*)(F + tid * 32 + i) = (f32x4){v[i] + off, v[i + 1] + off, v[i + 2] + off, v[i + 3] + off} * (-11.313708498984761f);
    __syncthreads();
}

constexpr int LP = 136;
__device__ __forceinline__ float silu(float x) { return x / (1.f + __expf(-x)); }
__device__ __forceinline__ void chunk_gates(KA a, int t0, int h, int lane, float& b0, float& b1, float& i0, float& i1) {
    const float* GATES = (const float*)(a->ws + WS_GATES);
    const float* g0 = GATES + (size_t)(t0 + 2 * lane) * 16; const float ib = a->i_bias[h], fb = a->f_bias[h];
    i0 = g0[8 + h] + ib; i1 = g0[16 + 8 + h] + ib;
    const float l0 = logsig(g0[12 + h] + fb), l1 = logsig(g0[16 + 12 + h] + fb);
    float sc = l0 + l1;
#pragma unroll
    for (int o = 1; o < 64; o <<= 1) { const float n = __shfl_up(sc, o); if (lane >= o) sc += n; }
    b1 = sc; b0 = sc - l1;
}
__device__ __forceinline__ void stage_vt_chunk(const bf16* MV, int t0, int col, LAS bf16* VT, int erow, int lane) {
    const bf16* p = MV + (size_t)(t0 + 2 * lane) * 1024 + col;
    const v4u r0 = *(const v4u*)p, r1 = *(const v4u*)(p + 1024);
#pragma unroll
    for (int j = 0; j < 8; ++j) { const unsigned lo = (j & 1) ? (r0[j >> 1] >> 16) : (r0[j >> 1] & 0xffffu), hi = (j & 1) ? (r1[j >> 1] >> 16) : (r1[j >> 1] & 0xffffu);
        *(LAS unsigned*)(VT + (erow + j) * LP + 2 * lane) = lo | (hi << 16); }
}

__device__ __forceinline__ void mlstm_a_unit(KA a, LAS unsigned char* lds, int u, int tid, int lane, int wave) {
    const int bh = u >> 7, c = u & 127, b = bh >> 2, h = bh & 3, t0 = b * SEQ + c * 128;
    unsigned char* ws = a->ws; float* MSM = (float*)(ws + WS_MSM);
    LAS bf16* VT = (LAS bf16*)lds;
    LAS bf16* AKT = (LAS bf16*)(lds + 256 * LP * 2);
    LAS float* AE = (LAS float*)(lds + 384 * LP * 2);
    if (wave == 0) {
        float b0, b1, i0, i1; chunk_gates(a, t0, h, lane, b0, b1, i0, i1);
        const float bl = __shfl(b1, 63);
        const float w0 = bl - b0 + i0, w1 = bl - b1 + i1;
        const float ml = wave_max(fmaxf(w0, w1));
        AE[2 * lane] = __expf(w0 - ml); AE[2 * lane + 1] = __expf(w1 - ml);
        if (lane == 0) { MSM[MS_MLOC + u] = ml; MSM[MS_BLAST + u] = bl; }
    }
    __syncthreads();
    const bf16* MV = (const bf16*)(ws + WS_MV); const bf16* MK = (const bf16*)(ws + WS_MK);
#pragma unroll
    for (int i = 0; i < 4; ++i) { const int e0 = 8 * (4 * wave + i); stage_vt_chunk(MV, t0, h * 256 + e0, VT, e0, lane); }
    const float a0 = AE[2 * lane], a1 = AE[2 * lane + 1];
#pragma unroll
    for (int i = 0; i < 2; ++i) {
        const int d0 = 8 * (2 * wave + i), ch = 512 + h * 128 + d0;
        const bf16* p = MK + (size_t)(t0 + 2 * lane - 3) * 512 + h * 128 + d0;
        v4u rr[5];
#pragma unroll
        for (int r = 0; r < 5; ++r) { if (c * 128 + 2 * lane - 3 + r >= 0) rr[r] = *(const v4u*)(p + r * 512); else rr[r] = (v4u){0u, 0u, 0u, 0u}; }
#pragma unroll
        for (int jj = 0; jj < 8; ++jj) {
            float xv[5];
#pragma unroll
            for (int r = 0; r < 5; ++r) xv[r] = (jj & 1) ? bfhi(rr[r][jj >> 1]) : bflo(rr[r][jj >> 1]);
            const float cw0 = a->conv_w[ch + jj], cw1 = a->conv_w[1024 + ch + jj], cw2 = a->conv_w[2048 + ch + jj], cw3 = a->conv_w[3072 + ch + jj], cb = a->conv_b[ch + jj];
            const float y0 = cb + cw0 * xv[0] + cw1 * xv[1] + cw2 * xv[2] + cw3 * xv[3];
            const float y1 = cb + cw0 * xv[1] + cw1 * xv[2] + cw2 * xv[3] + cw3 * xv[4];
            const float k0 = silu(y0) * 0.08838834764831845f * a0, k1 = silu(y1) * 0.08838834764831845f * a1;
            *(LAS unsigned*)(AKT + (d0 + jj) * LP + 2 * lane) = cvtpk(k0, k1);
            const float ns = wave_sum(k0 + k1);
            if (lane == 0) MSM[MS_NLOC + u * 128 + d0 + jj] = ns;
        }
    }
    __syncthreads();
    f32x4 acc[2][8];
#pragma unroll
    for (int mi = 0; mi < 2; ++mi)
#pragma unroll
        for (int ni = 0; ni < 8; ++ni) acc[mi][ni] = (f32x4){0.f, 0.f, 0.f, 0.f};
    const int fr = lane & 15, fq = lane >> 4;
#pragma unroll
    for (int ks = 0; ks < 4; ++ks) {
        bf16x8 af[2], bf_[8];
#pragma unroll
        for (int mi = 0; mi < 2; ++mi) af[mi] = *(const LAS bf16x8*)(VT + (32 * wave + 16 * mi + fr) * LP + 32 * ks + 8 * fq);
#pragma unroll
        for (int ni = 0; ni < 8; ++ni) bf_[ni] = *(const LAS bf16x8*)(AKT + (16 * ni + fr) * LP + 32 * ks + 8 * fq);
#pragma unroll
        for (int mi = 0; mi < 2; ++mi)
#pragma unroll
            for (int ni = 0; ni < 8; ++ni) acc[mi][ni] = MFMA16(af[mi], bf_[ni], acc[mi][ni]);
    }
    float* Cout = (float*)(ws + WS_MIXED) + (size_t)u * 32768;
#pragma unroll
    for (int mi = 0; mi < 2; ++mi)
#pragma unroll
        for (int ni = 0; ni < 8; ++ni)
#pragma unroll
            for (int r = 0; r < 4; ++r) Cout[(32 * wave + 16 * mi + 4 * fq + r) * 128 + 16 * ni + fr] = acc[mi][ni][r];
    __syncthreads();
}

__device__ __forceinline__ void mlstm_scan(KA a, int vcu, int G, int tid) {
    unsigned char* ws = a->ws; float* MSM = (float*)(ws + WS_MSM);
    const float* CL = (const float*)(ws + WS_MIXED); unsigned* CP = (unsigned*)(ws + WS_CPREV);
    const int gid = vcu * NTHR + tid, nthr = G * NTHR;
    for (int pi = gid; pi < 8 * 16384; pi += nthr) {
        const int bh = pi >> 14, i2 = pi & 16383;
        float c0 = 0.f, c1 = 0.f, m = 0.f;
#pragma unroll 8
        for (int c = 0; c < NCH; ++c) {
            const float ml = MSM[MS_MLOC + bh * 128 + c], bl = MSM[MS_BLAST + bh * 128 + c];
            const size_t o = (size_t)(bh * 128 + c) * 16384 + i2;
            const f32x2 cl = ((const f32x2*)CL)[o];
            CP[o] = cvtpk(c0, c1);
            if (i2 == 0) MSM[MS_MPREV + bh * 128 + c] = m;
            const float mn = fmaxf(bl + m, ml), ap = __expf(bl + m - mn), al = __expf(ml - mn);
            c0 = ap * c0 + al * cl.x; c1 = ap * c1 + al * cl.y; m = mn;
        }
    }
    if (gid < 1024) {
        const int bh = gid >> 7, d = gid & 127; float n = 0.f, m = 0.f;
        for (int c = 0; c < NCH; ++c) {
            const float ml = MSM[MS_MLOC + bh * 128 + c], bl = MSM[MS_BLAST + bh * 128 + c];
            const float nl = MSM[MS_NLOC + (bh * 128 + c) * 128 + d];
            MSM[MS_NPREV + (bh * 128 + c) * 128 + d] = n;
            const float mn = fmaxf(bl + m, ml), ap = __expf(bl + m - mn), al = __expf(ml - mn);
            n = ap * n + al * nl; m = mn;
        }
    }
}

__device__ __forceinline__ void stage_conv_rows(KA a, const bf16* src, int chbase, float scale, int t0, int c, int h, LAS bf16* dst, int tid) {
    const int d0 = (tid & 15) * 8, ch = chbase + h * 128 + d0;
    float cw[4][8], cb[8];
#pragma unroll
    for (int j = 0; j < 4; ++j) { const f32x4 w0 = *(const f32x4*)(a->conv_w + j * 1024 + ch), w1 = *(const f32x4*)(a->conv_w + j * 1024 + ch + 4);
        cw[j][0] = w0.x; cw[j][1] = w0.y; cw[j][2] = w0.z; cw[j][3] = w0.w; cw[j][4] = w1.x; cw[j][5] = w1.y; cw[j][6] = w1.z; cw[j][7] = w1.w; }
    { const f32x4 w0 = *(const f32x4*)(a->conv_b + ch), w1 = *(const f32x4*)(a->conv_b + ch + 4);
      cb[0] = w0.x; cb[1] = w0.y; cb[2] = w0.z; cb[3] = w0.w; cb[4] = w1.x; cb[5] = w1.y; cb[6] = w1.z; cb[7] = w1.w; }
#pragma unroll
    for (int it = 0; it < 4; ++it) {
        const int l = (it * 512 + tid) >> 4;
        const bf16* p = src + (size_t)(t0 + l - 3) * 512 + h * 128 + d0;
        v4u rr[4];
#pragma unroll
        for (int r = 0; r < 4; ++r) { if (c * 128 + l - 3 + r >= 0) rr[r] = *(const v4u*)(p + r * 512); else rr[r] = (v4u){0u, 0u, 0u, 0u}; }
        float y[8];
#pragma unroll
        for (int jj = 0; jj < 8; ++jj) { float s = cb[jj];
#pragma unroll
            for (int r = 0; r < 4; ++r) s += cw[r][jj] * ((jj & 1) ? bfhi(rr[r][jj >> 1]) : bflo(rr[r][jj >> 1]));
            y[jj] = silu(s) * scale; }
        v4u o; o.x = cvtpk(y[0], y[1]); o.y = cvtpk(y[2], y[3]); o.z = cvtpk(y[4], y[5]); o.w = cvtpk(y[6], y[7]);
        *(LAS v4u*)(dst + l * LP + d0) = o;
    }
}
__device__ __forceinline__ void mlstm_c_unit(KA a, LAS unsigned char* lds, int u, int tid, int lane, int wave) {
    const int bh = u >> 7, c = u & 127, b = bh >> 2, h = bh & 3, t0 = b * SEQ + c * 128;
    unsigned char* ws = a->ws; const float* MSM = (const float*)(ws + WS_MSM);
    LAS bf16* QL = (LAS bf16*)lds;
    LAS bf16* KL = (LAS bf16*)(lds + 128 * LP * 2);
    LAS bf16* VTH = (LAS bf16*)(lds + 256 * LP * 2);
    LAS bf16* CTH = (LAS bf16*)(lds + 384 * LP * 2);
    LAS float* AR = (LAS float*)(lds + 512 * LP * 2);
    if (wave == 0) {
        float b0, b1, i0, i1; chunk_gates(a, t0, h, lane, b0, b1, i0, i1);
        const float c0 = i0 - b0, c1 = i1 - b1, pmx = fmaxf(c0, c1);
        float sc = pmx;
#pragma unroll
        for (int o = 1; o < 64; o <<= 1) { const float n = __shfl_up(sc, o); if (lane >= o) sc = fmaxf(sc, n); }
        float ex = __shfl_up(sc, 1); if (lane == 0) ex = -__builtin_inff();
        const float pm0 = fmaxf(ex, c0), pm1 = sc;
        const float mp = MSM[MS_MPREV + u];
        const float g0 = b0 + mp, g1 = b1 + mp, mt0 = fmaxf(g0, b0 + pm0), mt1 = fmaxf(g1, b1 + pm1);
        AR[2 * lane] = b0 - mt0; AR[2 * lane + 1] = b1 - mt1;
        AR[128 + 2 * lane] = c0; AR[128 + 2 * lane + 1] = c1;
        AR[256 + 2 * lane] = __expf(g0 - mt0); AR[256 + 2 * lane + 1] = __expf(g1 - mt1);
        AR[384 + 2 * lane] = __expf(-mt0); AR[384 + 2 * lane + 1] = __expf(-mt1);
    }
    if (tid >= 64 && tid < 192) AR[512 + tid - 64] = MSM[MS_NPREV + u * 128 + tid - 64];
    stage_conv_rows(a, (const bf16*)(ws + WS_MQ), 0, 1.0f, t0, c, h, QL, tid);
    stage_conv_rows(a, (const bf16*)(ws + WS_MK), 512, 0.08838834764831845f, t0, c, h, KL, tid);
    __syncthreads();
    const int fr = lane & 15, fq = lane >> 4, t = 16 * wave + fr;
    f32x4 st[8];
#pragma unroll
    for (int ni = 0; ni < 8; ++ni) st[ni] = (f32x4){0.f, 0.f, 0.f, 0.f};
    bf16x8 qf[4];
#pragma unroll
    for (int ks = 0; ks < 4; ++ks) qf[ks] = *(const LAS bf16x8*)(QL + t * LP + 32 * ks + 8 * fq);
#pragma unroll
    for (int ks = 0; ks < 4; ++ks)
#pragma unroll
        for (int ni = 0; ni < 8; ++ni) { const bf16x8 kf = *(const LAS bf16x8*)(KL + (16 * ni + fr) * LP + 32 * ks + 8 * fq); st[ni] = MFMA16(kf, qf[ks], st[ni]); }
    float qn = 0.f;
#pragma unroll
    for (int j = 0; j < 4; ++j) { const v4u qq = *(const LAS v4u*)(QL + t * LP + 32 * fq + 8 * j);
#pragma unroll
        for (int w = 0; w < 4; ++w) { qn += bflo(qq[w]) * AR[512 + 32 * fq + 8 * j + 2 * w] + bfhi(qq[w]) * AR[512 + 32 * fq + 8 * j + 2 * w + 1]; } }
    qn += __shfl_xor(qn, 16); qn += __shfl_xor(qn, 32);
    const float rc = AR[t], inter = AR[256 + t], emt = AR[384 + t];
    float rs = 0.f;
#pragma unroll
    for (int ni = 0; ni < 8; ++ni) { const f32x4 cc = *(const LAS f32x4*)(AR + 128 + 16 * ni + 4 * fq);
#pragma unroll
        for (int r = 0; r < 4; ++r) { const int s = 16 * ni + 4 * fq + r; const float wgt = (s <= t) ? __expf(rc + cc[r]) : 0.f; const float v = st[ni][r] * wgt; st[ni][r] = v; rs += v; } }
    rs += __shfl_xor(rs, 16); rs += __shfl_xor(rs, 32);
    const float den = rs + inter * qn, inv = 1.0f / fmaxf(fabsf(den), emt);
    __syncthreads();
#pragma unroll
    for (int ni = 0; ni < 8; ++ni) { v2u o; o.x = cvtpk(st[ni][0], st[ni][1]); o.y = cvtpk(st[ni][2], st[ni][3]); *(LAS v2u*)(KL + t * LP + 16 * ni + 4 * fq) = o; }
    const bf16* MV = (const bf16*)(ws + WS_MV); const bf16* CP = (const bf16*)(ws + WS_CPREV) + (size_t)u * 32768;
    f32x4 hv[2][8];
#pragma unroll
    for (int hf = 0; hf < 2; ++hf) {
#pragma unroll
        for (int i = 0; i < 2; ++i) { const int e0 = 8 * (2 * wave + i); stage_vt_chunk(MV, t0, h * 256 + 128 * hf + e0, VTH, e0, lane); }
#pragma unroll
        for (int it = 0; it < 4; ++it) { const int q = it * 512 + tid, e = q >> 4, d0 = (q & 15) * 8;
            *(LAS v4u*)(CTH + e * LP + d0) = *(const v4u*)(CP + (size_t)(128 * hf + e) * 128 + d0); }
        __syncthreads();
        f32x4 a1[8], a2[8];
#pragma unroll
        for (int ni = 0; ni < 8; ++ni) { a1[ni] = (f32x4){0.f, 0.f, 0.f, 0.f}; a2[ni] = (f32x4){0.f, 0.f, 0.f, 0.f}; }
#pragma unroll
        for (int ks = 0; ks < 4; ++ks) {
            const bf16x8 sf = *(const LAS bf16x8*)(KL + t * LP + 32 * ks + 8 * fq);
#pragma unroll
            for (int ni = 0; ni < 8; ++ni) { const bf16x8 vf = *(const LAS bf16x8*)(VTH + (16 * ni + fr) * LP + 32 * ks + 8 * fq); a1[ni] = MFMA16(vf, sf, a1[ni]);
                const bf16x8 cf = *(const LAS bf16x8*)(CTH + (16 * ni + fr) * LP + 32 * ks + 8 * fq); a2[ni] = MFMA16(cf, qf[ks], a2[ni]); }
        }
#pragma unroll
        for (int ni = 0; ni < 8; ++ni) hv[hf][ni] = (a1[ni] + a2[ni] * inter) * inv;
        __syncthreads();
    }
    const bf16* MO = (const bf16*)(ws + WS_MO) + (size_t)(t0 + t) * 1024 + h * 256;
    float ss = 0.f;
#pragma unroll
    for (int hf = 0; hf < 2; ++hf)
#pragma unroll
        for (int ni = 0; ni < 8; ++ni) { const v2u g = *(const v2u*)(MO + 128 * hf + 16 * ni + 4 * fq);
            const float g0 = bflo(g.x), g1 = bfhi(g.x), g2 = bflo(g.y), g3 = bfhi(g.y);
            f32x4 v = hv[hf][ni]; v[0] *= 1.f / (1.f + __expf(-g0)); v[1] *= 1.f / (1.f + __expf(-g1)); v[2] *= 1.f / (1.f + __expf(-g2)); v[3] *= 1.f / (1.f + __expf(-g3));
            hv[hf][ni] = v; ss += (v[0] * v[0] + v[1] * v[1]) + (v[2] * v[2] + v[3] * v[3]); }
    ss += __shfl_xor(ss, 16); ss += __shfl_xor(ss, 32);
    const float rn = __builtin_amdgcn_rsqf(ss * (1.f / 256.f) + NORM_EPS);
    bf16* MX = (bf16*)(ws + WS_MIXED) + (size_t)(t0 + t) * DM + 1024 + h * 256;
#pragma unroll
    for (int hf = 0; hf < 2; ++hf)
#pragma unroll
        for (int ni = 0; ni < 8; ++ni) { const int e = 128 * hf + 16 * ni + 4 * fq; const f32x4 w = *(const f32x4*)(a->ml_nw + h * 256 + e); const f32x4 v = hv[hf][ni];
            v2u o; o.x = cvtpk(v[0] * rn * w[0], v[1] * rn * w[1]); o.y = cvtpk(v[2] * rn * w[2], v[3] * rn * w[3]); *(v2u*)(MX + e) = o; }
}
__device__ __forceinline__ int sord(float f) { const int b = __float_as_int(f); return b ^ ((b >> 31) & 0x7fffffff); }
__device__ __forceinline__ float sdec(int v) { return __int_as_float(v ^ ((v >> 31) & 0x7fffffff)); }
#define PEER_INS(L, xin) do { int x_ = (xin); _Pragma("unroll") for (int i_ = 0; i_ < 16; ++i_) { const int hi_ = max(L[i_], x_); x_ = min(L[i_], x_); L[i_] = hi_; } } while (0)
__device__ __forceinline__ float gelu_erf(float v) { return 0.5f * v * (1.f + erff(v * 0.70710678118654752f)); }

__device__ __forceinline__ void peer_select(KA a, int t0, int lane, int wave) {
    const bf16* PQ = (const bf16*)(a->ws + WS_PQ); const bf16* KEYS = (const bf16*)(a->ws + WS_KEYS);
    const int c = lane & 31, hh = lane >> 5;
    int AB[2][16];
#pragma unroll
    for (int p = 0; p < 2; ++p) {
        bf16x8 qf[8];
#pragma unroll
        for (int ks = 0; ks < 8; ++ks) qf[ks] = *(const bf16x8*)(PQ + (size_t)(t0 + c) * DM + wave * 256 + p * 128 + 16 * ks + 8 * hh);
        int L[16];
#pragma unroll
        for (int i = 0; i < 16; ++i) L[i] = (int)0x80000000;
#pragma unroll 1
        for (int nt = 0; nt < 4; ++nt) {
            f32x16 acc;
#pragma unroll
            for (int r = 0; r < 16; ++r) acc[r] = 0.f;
#pragma unroll
            for (int ks = 0; ks < 8; ++ks) { const bf16x8 kf = *(const bf16x8*)(KEYS + (size_t)(p * 128 + 32 * nt + c) * 128 + 16 * ks + 8 * hh); acc = MFMA32(kf, qf[ks], acc); }
#pragma unroll
            for (int r = 0; r < 16; ++r) { const int n = 32 * nt + (r & 3) + 8 * (r >> 2); const int key = (sord(acc[r]) & ~127) | n | (4 * hh); PEER_INS(L, key); }
        }
        int M[16];
#pragma unroll
        for (int i = 0; i < 16; ++i) { const int o = __shfl_xor(L[15 - i], 32); M[i] = max(L[i], o); }
#pragma unroll
        for (int dist = 8; dist >= 1; dist >>= 1)
#pragma unroll
            for (int i = 0; i < 16; ++i) if ((i & dist) == 0) { const int hi_ = max(M[i], M[i + dist]), lo_ = min(M[i], M[i + dist]); M[i] = hi_; M[i + dist] = lo_; }
#pragma unroll
        for (int i = 0; i < 16; ++i) AB[p][i] = M[i];
    }
    float va[16], vb[16];
#pragma unroll
    for (int i = 0; i < 16; ++i) { va[i] = sdec(AB[0][i] & ~127); vb[i] = sdec(AB[1][i] & ~127); }
    int L[16];
#pragma unroll
    for (int j = 0; j < 16; ++j) L[j] = (sord(va[0] + vb[j]) & ~255) | j;
#pragma unroll
    for (int i = 1; i < 16; ++i)
#pragma unroll
        for (int j = 0; j < 16; ++j) if ((i + 1) * (j + 1) <= 16) { const int key = (sord(va[i] + vb[j]) & ~255) | (i * 16 + j); PEER_INS(L, key); }
    float sv[16]; float mx = -__builtin_inff();
#pragma unroll
    for (int k = 0; k < 16; ++k) { sv[k] = sdec(L[k] & ~255); mx = fmaxf(mx, sv[k]); }
    float den = 0.f;
#pragma unroll
    for (int k = 0; k < 16; ++k) { sv[k] = __expf(sv[k] - mx); den += sv[k]; }
    const float rden = 1.f / den;
    int* PEI = (int*)(a->ws + WS_PEI) + (size_t)(t0 + c) * 128 + wave * 16; float* PEG = (float*)(a->ws + WS_PEG) + (size_t)(t0 + c) * 128 + wave * 16;
    int ev[16];
#pragma unroll
    for (int k = 0; k < 16; ++k) {
        const int id = L[k] & 255, ii = id >> 4, jj = id & 15;
        int ka = 0, kb = 0;
#pragma unroll
        for (int i = 0; i < 16; ++i) { ka = (ii == i) ? AB[0][i] : ka; kb = (jj == i) ? AB[1][i] : kb; }
        ev[k] = (ka & 127) * 128 + (kb & 127);
    }
    if (hh == 0) {
#pragma unroll
        for (int k = 0; k < 16; k += 4) *(v4u*)(PEI + k) = (v4u){(unsigned)ev[k], (unsigned)ev[k + 1], (unsigned)ev[k + 2], (unsigned)ev[k + 3]};
    } else {
#pragma unroll
        for (int k = 0; k < 16; k += 4) *(f32x4*)(PEG + k) = (f32x4){sv[k] * rden, sv[k + 1] * rden, sv[k + 2] * rden, sv[k + 3] * rden};
    }
}
__device__ __forceinline__ void peer_gather_token(KA a, size_t tok, int lane) {
    const bf16* XN = (const bf16*)(a->ws + WS_H); const unsigned char* U8 = a->ws + WS_UB; const unsigned char* V8 = a->ws + WS_VB;
    const float* MSM = (const float*)(a->ws + WS_MSM);
    float xr[32];
#pragma unroll
    for (int j = 0; j < 2; ++j) { const v4u p0 = *(const v4u*)(XN + tok * DM + 1024 * j + 16 * lane), p1 = *(const v4u*)(XN + tok * DM + 1024 * j + 16 * lane + 8);
#pragma unroll
        for (int w = 0; w < 4; ++w) { xr[16 * j + 2 * w] = bflo(p0[w]); xr[16 * j + 2 * w + 1] = bfhi(p0[w]); xr[16 * j + 8 + 2 * w] = bflo(p1[w]); xr[16 * j + 8 + 2 * w + 1] = bfhi(p1[w]); } }
    const v2u ei = *(const v2u*)((const int*)(a->ws + WS_PEI) + tok * 128 + 2 * lane);
    const f32x2 gi = *(const f32x2*)((const float*)(a->ws + WS_PEG) + tok * 128 + 2 * lane);
    float y[32];
#pragma unroll
    for (int i = 0; i < 32; ++i) y[i] = 0.f;
    for (int k0 = 0; k0 < 128; k0 += 4) {
        int e[4]; float g[4];
#pragma unroll
        for (int q = 0; q < 4; ++q) { const int src = (k0 + q) >> 1;
            e[q] = __builtin_amdgcn_readlane((q & 1) ? (int)ei.y : (int)ei.x, src); g[q] = __int_as_float(__builtin_amdgcn_readlane(__float_as_int((q & 1) ? gi.y : gi.x), src)); }
        v4u ur[4][2], vr[4][2];
#pragma unroll
        for (int q = 0; q < 4; ++q)
#pragma unroll
            for (int j = 0; j < 2; ++j) ur[q][j] = *(const v4u*)(U8 + (size_t)e[q] * DM + 1024 * j + 16 * lane);
#pragma unroll
        for (int q = 0; q < 4; ++q)
#pragma unroll
            for (int j = 0; j < 2; ++j) vr[q][j] = *(const v4u*)(V8 + (size_t)e[q] * DM + 1024 * j + 16 * lane);
        float act[4];
#pragma unroll
        for (int q = 0; q < 4; ++q) { float d = 0.f;
#pragma unroll
            for (int j = 0; j < 2; ++j)
#pragma unroll
                for (int w = 0; w < 4; ++w) { const f32x2 lo = __builtin_amdgcn_cvt_pk_f32_fp8((int)ur[q][j][w], false), hi = __builtin_amdgcn_cvt_pk_f32_fp8((int)ur[q][j][w], true);
                    d += lo.x * xr[16 * j + 4 * w] + lo.y * xr[16 * j + 4 * w + 1] + hi.x * xr[16 * j + 4 * w + 2] + hi.y * xr[16 * j + 4 * w + 3]; }
            d = wave_sum(d) * MSM[MS_USC + e[q]]; act[q] = gelu_erf(d) * g[q] * MSM[MS_VSC + e[q]]; }
#pragma unroll
        for (int q = 0; q < 4; ++q)
#pragma unroll
            for (int j = 0; j < 2; ++j)
#pragma unroll
                for (int w = 0; w < 4; ++w) { const f32x2 lo = __builtin_amdgcn_cvt_pk_f32_fp8((int)vr[q][j][w], false), hi = __builtin_amdgcn_cvt_pk_f32_fp8((int)vr[q][j][w], true);
                    y[16 * j + 4 * w] += act[q] * lo.x; y[16 * j + 4 * w + 1] += act[q] * lo.y; y[16 * j + 4 * w + 2] += act[q] * hi.x; y[16 * j + 4 * w + 3] += act[q] * hi.y; }
    }
    float* orow = a->out + tok * DM; float ss = 0.f;
#pragma unroll
    for (int j = 0; j < 2; ++j)
#pragma unroll
        for (int i = 0; i < 4; ++i) { const f32x4 x0 = *(const f32x4*)(orow + 1024 * j + 16 * lane + 4 * i);
            y[16 * j + 4 * i] += x0.x; y[16 * j + 4 * i + 1] += x0.y; y[16 * j + 4 * i + 2] += x0.z; y[16 * j + 4 * i + 3] += x0.w; }
#pragma unroll
    for (int i = 0; i < 32; ++i) ss += y[i] * y[i];
    const float rn = __builtin_amdgcn_rsqf(wave_sum(ss) * (1.f / DM) + NORM_EPS);
#pragma unroll
    for (int j = 0; j < 2; ++j)
#pragma unroll
        for (int i = 0; i < 4; ++i) { const f32x4 w0 = *(const f32x4*)(a->final_w + 1024 * j + 16 * lane + 4 * i);
            *(f32x4*)(orow + 1024 * j + 16 * lane + 4 * i) = (f32x4){y[16 * j + 4 * i] * rn * w0.x, y[16 * j + 4 * i + 1] * rn * w0.y, y[16 * j + 4 * i + 2] * rn * w0.z, y[16 * j + 4 * i + 3] * rn * w0.w}; }
}

__global__ void __launch_bounds__(NTHR, 2) fwd_kernel(Args args) {
    extern __shared__ __attribute__((aligned(16))) unsigned char lds_raw[];
    LAS unsigned char* lds = (LAS unsigned char*)lds_raw;
    volatile LAS unsigned* MISC = (volatile LAS unsigned*)(lds + MISC_OFF);
    const int tid = threadIdx.x, lane = tid & 63, wave = __builtin_amdgcn_readfirstlane(tid >> 6);
    const int G = gridDim.x; const int bx = blockIdx.x; const int vcu = (G % 8 == 0) ? (bx % 8) * (G / 8) + bx / 8 : bx;
    KA ka = (KA)__builtin_amdgcn_kernarg_segment_ptr();
#define KARGS(name) KA name = ka; asm volatile("" : "+s"(name))
    gu32* ctl; { KARGS(a_); ctl = (gu32*)(a_->ws + WS_CTL); }
    if (tid < 64) MISC[tid] = 0u;
    __syncthreads();
    XcdBarrier bar = xcd_barrier_post((unsigned*)ctl + CW_BAR + args.li * XCD_BAR_WORDS, MISC + 8);
    const int lo = args.ph_lo, hi = args.ph_hi;
#ifndef PH_MASK
#define PH_MASK 0x3ff
#endif
#define IN(k) (((PH_MASK >> (k)) & 1) && lo <= (k) && (k) < hi)
#define BOTH(k) (IN(k) && IN((k) + 1))
#define GRID_BAR() xcd_barrier(bar)

    if (IN(0)) { KARGS(a_); p0_prologue(a_, lds, tid, lane, wave, vcu, G); if (BOTH(0)) GRID_BAR(); }

    if (IN(1)) {
        KARGS(a_); unsigned char* ws = a_->ws;
        pg8::Gemm g{(const pg8::bf16_t*)(ws + WS_H), (const pg8::bf16_t*)(ws + WS_WINT), T, NZ, DM}; pg8::StaticOrder S; S.init(T, NZ, G, bx);
        static_assert(WS_FK - WS_FQ == (1u << 26) && WS_FV - WS_FK == (1u << 26) && WS_MK - WS_MQ == (1u << 25) && WS_MO - WS_MV == (1u << 26), "EpiZ strides");
        pg8::EpiZ E{ws, WS_FQ, WS_MQ, WS_MV, WS_GATES};
        pg8::gemm_phase<pg8::EpiZ, pg8::StaticOrder, true, true>(lds, g, S, E);
        if (BOTH(1)) GRID_BAR();
    }

    if (IN(2)) {
        KARGS(a_);
        for (int s = bx; s < 16; s += G) fox_cumsum(a_, lds, s, tid, lane, wave);
        for (int u = vcu; u < 8 * NCH; u += G) mlstm_a_unit(a_, lds, u, tid, lane, wave);
        if (BOTH(2)) GRID_BAR();
    }

    if (IN(3)) { KARGS(a_); mlstm_scan(a_, vcu, G, tid); if (BOTH(3)) GRID_BAR(); }

    if (IN(4)) {
#ifndef NO_ATT
        {
            using namespace fox;
            typedef __hip_bfloat16 hb;
            KARGS(a_); unsigned char* ws = a_->ws; const float* fox_nw = a_->fox_nw;
            const hb* Q = (const hb*)(ws + WS_FQ); const hb* K = (const hb*)(ws + WS_FK); const hb* V = (const hb*)(ws + WS_FV); hb* O = (hb*)(ws + WS_MIXED);
            const float* F = (const float*)(ws + WS_FCUM);
            constexpr int NQB = SEQ / QB, NX = NQB / 2, TOTAL = NX * 16;
#define FOX_REF(r, Lx, pass) do { const int bh_ = (Lx) / NX, x_ = (Lx) % NX, qb_ = (pass) ? NQB - 1 - x_ : x_, b_ = bh_ >> 3, h_ = bh_ & 7;     \
                (r).Q = Q + ((size_t)bh_ * SEQ + (size_t)qb_ * QB) * 128; (r).K = K + (size_t)bh_ * SEQ * 128; (r).V = V + (size_t)bh_ * SEQ * 128;      \
                (r).O = O + ((size_t)b_ * SEQ + (size_t)qb_ * QB) * DM + h_ * 128; (r).P0 = qb_ * QB; (r).F = F + (size_t)bh_ * SEQ;                    \
                (r).NW_ = fox_nw + h_ * 128; } while (0)
            int L = bx;
            if (L < TOTAL) {
                int pass = 0;
                BlockRef<hb, hb> cur; FOX_REF(cur, L, 0);
                Seam<hb> Sm;
                causal_swa_prime<hb, hb>(cur, SEQ, (char*)lds_raw, Sm);
                for (;;) {
                    const bool more_pass = pass == 0, more_item = L + G < TOTAL, last = !more_pass && !more_item;
                    int passn = pass + 1, Ln = L;
                    if (!more_pass) { passn = 0; Ln = more_item ? L + G : L; }
                    BlockRef<hb, hb> nxt; if (last) nxt = cur; else FOX_REF(nxt, Ln, passn);
                    causal_swa_block<hb, hb>(cur, nxt, SEQ, SEQ, (char*)lds_raw, Sm);
                    if (last) break;
                    cur = nxt; pass = passn; L = Ln;
                }
            }
#undef FOX_REF
        }
#endif
        VM_WAIT(); __syncthreads();
#ifndef NO_MLC
        { KARGS(a_); for (int u = vcu; u < 8 * NCH; u += G) mlstm_c_unit(a_, lds, u, tid, lane, wave); }
#endif
        if (BOTH(4)) GRID_BAR();
    }

    if (IN(5)) {
        KARGS(a_); unsigned char* ws = a_->ws;
        pg8::Gemm g{(const pg8::bf16_t*)(ws + WS_MIXED), (const pg8::bf16_t*)(ws + WS_WOUTT), T, DM, DM}; pg8::StaticOrder S; S.init(T, DM, G, bx);
        pg8::EpiRes E{a_->x, a_->out, DM};
        pg8::gemm_phase<pg8::EpiRes, pg8::StaticOrder, true, true>(lds, g, S, E);
        if (BOTH(5)) GRID_BAR();
    }

    if (IN(6)) { KARGS(a_); rms_phase(a_->out, a_->norm2_w, (bf16*)(a_->ws + WS_H), vcu * NWAVES + wave, G * NWAVES, lane); if (BOTH(6)) GRID_BAR(); }

    if (IN(7)) {
        KARGS(a_); unsigned char* ws = a_->ws;
        pg8::Gemm g{(const pg8::bf16_t*)(ws + WS_H), (const pg8::bf16_t*)(ws + WS_WQT), T, DM, DM}; pg8::StaticOrder S; S.init(T, DM, G, bx);
        pg8::EpiBf16<0> E{(pg8::bf16_t*)(ws + WS_PQ), DM, nullptr, 0, 0, 1.f};
        pg8::gemm_phase<pg8::EpiBf16<0>, pg8::StaticOrder, true, true>(lds, g, S, E);
        if (BOTH(7)) GRID_BAR();
    }

    if (IN(8)) {
        KARGS(a_);
        for (int tile = vcu; tile < T / 32; tile += G) peer_select(a_, tile * 32, lane, wave);
        if (BOTH(8)) GRID_BAR();
    }

    if (IN(9)) {
        KARGS(a_);
        for (int tok = vcu * NWAVES + wave; tok < T; tok += G * NWAVES) peer_gather_token(a_, (size_t)tok, lane);
    }
#undef IN
#undef BOTH
#undef GRID_BAR
}

extern "C" void kernel_launch(void* const* d_in, const int* in_sizes, int n_in, void* d_out, int out_size, void* d_ws, size_t ws_size, hipStream_t stream) {
    static int grid = 0;
    constexpr int NPH = 10;
    if (grid == 0) {
        if (n_in != 17 || in_sizes[0] != T * DM || out_size != T * DM || ws_size < WS_END) { fprintf(stderr, "kernel_launch: shape/workspace mismatch (n_in %d, in0 %d, out %d, ws %zu)\n", n_in, n_in > 0 ? in_sizes[0] : -1, out_size, ws_size); grid = -1; return; }
        int dev = 0, cus = 0, per_cu = 0;
        if (hipGetDevice(&dev) != hipSuccess || hipDeviceGetAttribute(&cus, hipDeviceAttributeMultiprocessorCount, dev) != hipSuccess) { grid = -1; return; }
        if (hipFuncSetAttribute((const void*)fwd_kernel, hipFuncAttributeMaxDynamicSharedMemorySize, LDS_BYTES) != hipSuccess) { fprintf(stderr, "kernel_launch: hipFuncSetAttribute failed\n"); grid = -1; return; }
        if (hipOccupancyMaxActiveBlocksPerMultiprocessor(&per_cu, (const void*)fwd_kernel, NTHR, LDS_BYTES) != hipSuccess || per_cu < 1) { fprintf(stderr, "kernel_launch: occupancy query says %d blocks per CU\n", per_cu); (void)hipGetLastError(); grid = -1; return; }
        grid = cus;
    }
    if (grid < 0) return;
    if (hipMemsetAsync((char*)d_ws + WS_CTL, 0, CTL_ZERO_BYTES, stream) != hipSuccess) return;
    Args a{};
    a.x = (const float*)d_in[0]; a.norm1_w = (const float*)d_in[1]; a.w_in = (const float*)d_in[2]; a.fox_f_bias = (const float*)d_in[3];
    a.conv_w = (const float*)d_in[4]; a.conv_b = (const float*)d_in[5]; a.i_bias = (const float*)d_in[6]; a.f_bias = (const float*)d_in[7];
    a.fox_nw = (const float*)d_in[8]; a.ml_nw = (const float*)d_in[9]; a.w_out = (const float*)d_in[10]; a.norm2_w = (const float*)d_in[11];
    a.w_q = (const float*)d_in[12]; a.keys = (const float*)d_in[13]; a.pu = (const float*)d_in[14]; a.pv = (const float*)d_in[15]; a.final_w = (const float*)d_in[16];
    a.out = (float*)d_out; a.ws = (unsigned char*)d_ws;
#if MK_N_LAUNCHES == 1
    a.ph_lo = 0; a.ph_hi = NPH; a.li = 0; a.pad = 0;
    hipLaunchKernelGGL(fwd_kernel, dim3(grid), dim3(NTHR), LDS_BYTES, stream, a);
#else
    for (int p = 0; p < NPH; ++p) { a.ph_lo = p; a.ph_hi = p + 1; a.li = 0; a.pad = 0; hipLaunchKernelGGL(fwd_kernel, dim3(grid), dim3(NTHR), LDS_BYTES, stream, a); }
#endif
}
```

```cpp
#include <hip/hip_runtime.h>
#include <hip/hip_bf16.h>
#include <cstdio>
#include <cstdint>
__device__ __forceinline__ int mk_lane_id() { return (int)(__builtin_amdgcn_mbcnt_hi(~0u, __builtin_amdgcn_mbcnt_lo(~0u, 0u)) & 63u); }
namespace pg8 {
#define PG8_LAS __attribute__((address_space(3)))
typedef unsigned short bf16_t;
typedef short bf16x8 __attribute__((ext_vector_type(8)));
typedef float f32x4 __attribute__((ext_vector_type(4)));
typedef unsigned u32x4 __attribute__((ext_vector_type(4)));
constexpr int BM = 256, BK = 64, HALF = 128, HTB = HALF * BK * 2  , STAGE_BYTES = 8 * HTB, NXCD = 8, WGM = 8;

__host__ __device__ __forceinline__ int lds_byte(int r, int c) { const int st = (r >> 4) * 2 + (c >> 5), rr = r & 15, cc = c & 31, ob = rr * 64 + cc * 2; return st * 1024 + (ob ^ (((ob >> 9) & 1) << 5)); }
__host__ __device__ __forceinline__ void stage_rc(int b, int& R, int& C) { const int st = b / 1024, sb = b % 1024, swz = sb ^ (((sb >> 9) & 1) << 5); R = (st >> 1) * 16 + swz / 64; C = (st & 1) * 32 + (swz % 64) / 2; }
__host__ __device__ __forceinline__ int perm32(int rho) { const int n = rho >> 4, i = rho & 15; return 8 * (i >> 2) + 4 * n + (i & 3); }

struct Unit { int pm, pn; };
struct Gemm { const bf16_t* A; const bf16_t* Bt; int M, N, K; };

struct StaticOrder {
    int nM, nN, nwg, G, c;
    __host__ __device__ void init(int M, int N, int G_, int c_) { nM = M / BM; nN = N / BM; nwg = nM * nN; G = G_; c = c_; }
    __host__ __device__ bool next(int i, Unit& u) const {
        const long L = (long)i * G + c; if (L >= nwg) return false;
        int wgid = (int)L; { const int q = nwg / NXCD, r = nwg % NXCD, xcd = wgid % NXCD, off = wgid / NXCD; wgid = (xcd < r ? xcd * (q + 1) : r * (q + 1) + (xcd - r) * q) + off; }
        const int nig = WGM * nN, gid = wgid / nig, fm = gid * WGM, gsz = (nM - fm) < WGM ? (nM - fm) : WGM;
        u.pm = fm + ((wgid % nig) % gsz); u.pn = (wgid % nig) / gsz; return true;
    }
    __device__ __forceinline__ void a_ready(const Unit&) const {}
    __device__ __forceinline__ void done(const Unit&) const {}
};

__device__ __forceinline__ unsigned cvt_pk_bf16(float lo, float hi) { unsigned r; asm volatile("v_cvt_pk_bf16_f32 %0, %1, %2" : "=v"(r) : "v"(lo), "v"(hi)); return r; }
typedef float f32x2 __attribute__((ext_vector_type(2)));
__device__ __forceinline__ f32x2 gelu_pk(f32x2 v) {
    const f32x2 av = __builtin_elementwise_abs(v), d = av * 0.2316418882f + 1.0f;
    f32x2 t; t.x = __builtin_amdgcn_rcpf(d.x); t.y = __builtin_amdgcn_rcpf(d.y);
    f32x2 q = t * 0.5307027145f + (-0.7265760135f); q = q * t + 0.7107068705f; q = q * t + (-0.142248368f); q = q * t + 0.127414796f; q = q * t;
    const f32x2 s = (v * v) * (-0.72134752044f);
    f32x2 e; e.x = __builtin_amdgcn_exp2f(s.x); e.y = __builtin_amdgcn_exp2f(s.y);
    const f32x2 m = v * (q * e), r = v - m;
    f32x2 o; o.x = v.x < 0.f ? m.x : r.x; o.y = v.y < 0.f ? m.y : r.y; return o;
}

template <int ACT  > struct EpiBf16 {
    static constexpr bool PERM = true, AFTER_DRAIN = false; static_assert(ACT == 0 || ACT == 1, "EpiBf16: ACT is 0 (none) or 1 (gelu_pk)");
    bf16_t* O; int ldc; const float* bias; int split_cols; size_t split_stride; float scale0;
    __device__ __forceinline__ void operator()(const f32x4 (&acc)[2][2][4][2], const Unit& u, int wr, int wc, int fr, int fq) const {
        const int row0 = u.pm * BM + wr * 64 + fr; int colt = u.pn * BM; bf16_t* base = O;
        float sc = 1.f; if (split_cols) { const int t = colt / split_cols; base += (size_t)t * split_stride; colt -= t * split_cols; if (t == 0) sc = scale0; }
        const int col0 = colt + wc * 32 + 8 * fq, bcol0 = u.pn * BM + wc * 32 + 8 * fq;
        f32x4 bv[2][2];
#pragma unroll
        for (int bj = 0; bj < 2; ++bj)
#pragma unroll
            for (int n = 0; n < 2; ++n) bv[bj][n] = bias ? *(const f32x4*)(bias + bcol0 + bj * HALF + 4 * n) : (f32x4){0.f, 0.f, 0.f, 0.f};
#pragma unroll
        for (int ai = 0; ai < 2; ++ai)
#pragma unroll
            for (int m = 0; m < 4; ++m) { bf16_t* rowp = base + (size_t)(row0 + ai * HALF + m * 16) * ldc + col0;
#pragma unroll
                for (int bj = 0; bj < 2; ++bj) { f32x4 v0 = acc[ai][bj][m][0] + bv[bj][0], v1 = acc[ai][bj][m][1] + bv[bj][1];
                    if (ACT == 1) { f32x2 a = gelu_pk((f32x2){v0[0], v0[1]}), b = gelu_pk((f32x2){v0[2], v0[3]}), c = gelu_pk((f32x2){v1[0], v1[1]}), d = gelu_pk((f32x2){v1[2], v1[3]});
                        v0 = (f32x4){a.x, a.y, b.x, b.y}; v1 = (f32x4){c.x, c.y, d.x, d.y}; }
                    v0 = v0 * sc; v1 = v1 * sc; u32x4 w; w.x = cvt_pk_bf16(v0[0], v0[1]); w.y = cvt_pk_bf16(v0[2], v0[3]); w.z = cvt_pk_bf16(v1[0], v1[1]); w.w = cvt_pk_bf16(v1[2], v1[3]);
                    *(u32x4*)(rowp + bj * HALF) = w; } }
    }
};

struct EpiZ {
    static constexpr bool PERM = true, AFTER_DRAIN = false;
    unsigned char* ws; size_t off_fq, off_mq, off_mv, off_gates;
    __device__ __forceinline__ void operator()(const f32x4 (&acc)[2][2][4][2], const Unit& u, int wr, int wc, int fr, int fq) const {
        const int pn = u.pn, row0 = u.pm * BM + wr * 64 + fr;
        if (pn < 12) {
            bf16_t* base = (bf16_t*)(ws + off_fq + ((size_t)(pn >> 2) << 26)); const int hp = (pn & 3) * 2, d = wc * 32 + 8 * fq;
#pragma unroll
            for (int ai = 0; ai < 2; ++ai)
#pragma unroll
                for (int m = 0; m < 4; ++m) { const int row = row0 + ai * HALF + m * 16, b = row >> 14, s = row & 16383;
#pragma unroll
                    for (int bj = 0; bj < 2; ++bj) { const f32x4 v0 = acc[ai][bj][m][0], v1 = acc[ai][bj][m][1];
                        u32x4 w; w.x = cvt_pk_bf16(v0[0], v0[1]); w.y = cvt_pk_bf16(v0[2], v0[3]); w.z = cvt_pk_bf16(v1[0], v1[1]); w.w = cvt_pk_bf16(v1[2], v1[3]);
                        *(u32x4*)(base + ((size_t)(b * 8 + hp + bj) * 16384 + s) * 128 + d) = w; } }
        } else if (pn < 24) {
            const bool isqk = pn < 16;
            const size_t boff = isqk ? off_mq + ((size_t)((pn - 12) >> 1) << 25) : off_mv + ((size_t)((pn - 16) >> 2) << 26);
            bf16_t* base = (bf16_t*)(ws + boff); const int ld = isqk ? 512 : 1024, cb = isqk ? ((pn - 12) & 1) * 256 : ((pn - 16) & 3) * 256;
            const int col0 = cb + wc * 32 + 8 * fq;
#pragma unroll
            for (int ai = 0; ai < 2; ++ai)
#pragma unroll
                for (int m = 0; m < 4; ++m) { bf16_t* rowp = base + (size_t)(row0 + ai * HALF + m * 16) * ld + col0;
#pragma unroll
                    for (int bj = 0; bj < 2; ++bj) { const f32x4 v0 = acc[ai][bj][m][0], v1 = acc[ai][bj][m][1];
                        u32x4 w; w.x = cvt_pk_bf16(v0[0], v0[1]); w.y = cvt_pk_bf16(v0[2], v0[3]); w.z = cvt_pk_bf16(v1[0], v1[1]); w.w = cvt_pk_bf16(v1[2], v1[3]);
                        *(u32x4*)(rowp + bj * HALF) = w; } }
        } else {
            if (wc == 0 && fq < 2) {
#pragma unroll
                for (int ai = 0; ai < 2; ++ai)
#pragma unroll
                    for (int m = 0; m < 4; ++m) { float* rowp = (float*)(ws + off_gates) + (size_t)(row0 + ai * HALF + m * 16) * 16 + 8 * fq;
                        *(f32x4*)rowp = acc[ai][0][m][0]; *(f32x4*)(rowp + 4) = acc[ai][0][m][1]; }
            }
        }
    }
};
struct EpiRes {
    static constexpr bool PERM = true, AFTER_DRAIN = false;
    const float* res; float* O; int ldc;
    __device__ __forceinline__ void operator()(const f32x4 (&acc)[2][2][4][2], const Unit& u, int wr, int wc, int fr, int fq) const {
        const int row0 = u.pm * BM + wr * 64 + fr, col0 = u.pn * BM + wc * 32 + 8 * fq;
#pragma unroll
        for (int ai = 0; ai < 2; ++ai)
#pragma unroll
            for (int m = 0; m < 4; ++m) { const size_t off = (size_t)(row0 + ai * HALF + m * 16) * ldc + col0;
#pragma unroll
                for (int bj = 0; bj < 2; ++bj) { const f32x4 r0 = *(const f32x4*)(res + off + bj * HALF), r1 = *(const f32x4*)(res + off + bj * HALF + 4);
                    *(f32x4*)(O + off + bj * HALF) = acc[ai][bj][m][0] + r0; *(f32x4*)(O + off + bj * HALF + 4) = acc[ai][bj][m][1] + r1; } }
    }
};
template <class Epi, class Sched, bool ALIGN_EPI = false, bool SP2 = false>
__device__ __forceinline__ void gemm_phase(PG8_LAS unsigned char* lds, const Gemm g, const Sched& S, const Epi& E, const int wid_in) {
    const int wid = wid_in, lane = mk_lane_id(), tid = wid * 64 + lane, wr = wid >> 2, wc = wid & 3, fr = lane & 15, fq = lane >> 4;
    const int K = g.K, nt = K / BK;
    unsigned voffA[2], voffB[2];
#pragma unroll
    for (int i = 0; i < 2; ++i) { int R, C; stage_rc(tid * 16 + i * 8192, R, C); const int Rb = Epi::PERM ? ((R & ~31) + perm32(R & 31)) : R;
        voffA[i] = (unsigned)(R * K + C) * 2u; voffB[i] = (unsigned)(Rb * K + C) * 2u; }
    const size_t kstep = (size_t)(BK * 2);
    const size_t hstep = (size_t)HALF * K * 2;
    const size_t tstep = 2 * hstep;
    const unsigned ldsw = (unsigned)wid * 1024u;
    const int aoff = lds_byte(wr * 64 + fr, fq * 8), boff = lds_byte(wc * 32 + fr, fq * 8);
#define PG8_SA(b, h) (((b) * 2 + (h)) * HTB)
#define PG8_SB(b, h) ((4 + (b) * 2 + (h)) * HTB)
#define PG8_STAGE(bufoff, gbase, voff) do { _Pragma("unroll") for (int _i = 0; _i < 2; ++_i) \
        __builtin_amdgcn_global_load_lds((const unsigned*)((const char*)(gbase) + (voff)[_i]), (PG8_LAS unsigned*)(lds + (bufoff) + ldsw + _i * 8192), 16, 0, 0); } while (0)
#define PG8_LDA(dst, b, h) do { _Pragma("unroll") for (int m = 0; m < 4; ++m) _Pragma("unroll") for (int k = 0; k < 2; ++k) dst[m][k] = *(const PG8_LAS bf16x8*)(lds + PG8_SA(b, h) + aoff + m * 2048 + k * 1024); } while (0)
#define PG8_LDB(dst, b, h) do { _Pragma("unroll") for (int n = 0; n < 2; ++n) _Pragma("unroll") for (int k = 0; k < 2; ++k) dst[n][k] = *(const PG8_LAS bf16x8*)(lds + PG8_SB(b, h) + boff + n * 2048 + k * 1024); } while (0)
#define PG8_MMA(ai, bj, At, Bt) do { __builtin_amdgcn_s_setprio(1); _Pragma("unroll") for (int m = 0; m < 4; ++m) _Pragma("unroll") for (int n = 0; n < 2; ++n) _Pragma("unroll") for (int k = 0; k < 2; ++k) \
        acc[ai][bj][m][n] = __builtin_amdgcn_mfma_f32_16x16x32_bf16(Bt[n][k], At[m][k], acc[ai][bj][m][n], 0, 0, 0); __builtin_amdgcn_s_setprio(0); } while (0)
#define PG8_WAIT_V(n) asm volatile("s_waitcnt vmcnt(" #n ")" ::: "memory")
#define PG8_WAIT_L(n) asm volatile("s_waitcnt lgkmcnt(" #n ")" ::: "memory")
#define PG8_BAR __builtin_amdgcn_s_barrier()
#define PG8_SCHED __builtin_amdgcn_sched_barrier(0)
    Unit cur, nxt; int ui = 0;
    if (!S.next(0, cur)) return;
    f32x4 acc[2][2][4][2];
#pragma unroll
    for (int a = 0; a < 2; ++a)
#pragma unroll
        for (int b = 0; b < 2; ++b)
#pragma unroll
            for (int m = 0; m < 4; ++m)
#pragma unroll
                for (int n = 0; n < 2; ++n) acc[a][b][m][n] = (f32x4){0.f, 0.f, 0.f, 0.f};
    bf16x8 At[4][2], B0[2][2], B1[2][2];
    const char* cA = (const char*)g.A + (size_t)cur.pm * tstep; const char* cB = (const char*)g.Bt + (size_t)cur.pn * tstep;
    S.a_ready(cur);
    if constexpr (SP2) {
        PG8_STAGE(PG8_SB(0, 0), cB, voffB); PG8_STAGE(PG8_SB(0, 1), cB + hstep, voffB); PG8_STAGE(PG8_SA(0, 0), cA, voffA); PG8_STAGE(PG8_SA(0, 1), cA + hstep, voffA);
        if (wr == 1) PG8_BAR;
        PG8_WAIT_V(2); PG8_BAR;
        PG8_STAGE(PG8_SB(1, 0), cB + kstep, voffB); PG8_STAGE(PG8_SA(1, 0), cA + kstep, voffA); PG8_STAGE(PG8_SB(1, 1), cB + hstep + kstep, voffB);
        PG8_WAIT_V(6); PG8_BAR;
    } else {
        PG8_STAGE(PG8_SB(0, 0), cB, voffB); PG8_STAGE(PG8_SA(0, 0), cA, voffA); PG8_STAGE(PG8_SB(0, 1), cB + hstep, voffB); PG8_STAGE(PG8_SA(0, 1), cA + hstep, voffA);
        if (wr == 1) PG8_BAR;
        PG8_WAIT_V(4); PG8_BAR;
        PG8_STAGE(PG8_SB(1, 0), cB + kstep, voffB); PG8_STAGE(PG8_SA(1, 0), cA + kstep, voffA); PG8_STAGE(PG8_SB(1, 1), cB + hstep + kstep, voffB);
        PG8_WAIT_V(6); PG8_BAR;
    }
    for (;;) {
        const bool has_next = S.next(ui + 1, nxt);
        const char* nA = has_next ? (const char*)g.A + (size_t)nxt.pm * tstep : cA; const char* nB = has_next ? (const char*)g.Bt + (size_t)nxt.pn * tstep : cB;
        for (int t = 0; t < nt; t += 2) {
            const bool last = (t == nt - 2);
            const char* a1 = cA + (size_t)(t + 1) * kstep;
            const char* a2 = last ? nA : cA + (size_t)(t + 2) * kstep; const char* b2 = last ? nB : cB + (size_t)(t + 2) * kstep;
            const char* a3 = a2 + kstep; const char* b3 = b2 + kstep;
            if (last && has_next) S.a_ready(nxt);
            if constexpr (SP2) {
            PG8_LDB(B0, 0, 0); PG8_LDB(B1, 0, 1); PG8_SCHED; PG8_LDA(At, 0, 0); PG8_STAGE(PG8_SA(1, 1), a1 + hstep, voffA);
            PG8_WAIT_V(8); PG8_WAIT_L(0); PG8_BAR; PG8_MMA(0, 0, At, B0); PG8_MMA(0, 1, At, B1); PG8_BAR; PG8_SCHED;
            PG8_LDA(At, 0, 1); PG8_STAGE(PG8_SB(0, 0), b2, voffB); PG8_STAGE(PG8_SB(0, 1), b2 + hstep, voffB); PG8_STAGE(PG8_SA(0, 0), a2, voffA);
            PG8_WAIT_V(8); PG8_WAIT_L(0); PG8_BAR; PG8_MMA(1, 0, At, B0); PG8_MMA(1, 1, At, B1); PG8_BAR; PG8_SCHED;
            PG8_LDB(B0, 1, 0); PG8_LDB(B1, 1, 1); PG8_SCHED; PG8_LDA(At, 1, 0); PG8_STAGE(PG8_SA(0, 1), a2 + hstep, voffA);
            PG8_WAIT_V(8); PG8_WAIT_L(0); PG8_BAR; PG8_MMA(0, 0, At, B0); PG8_MMA(0, 1, At, B1); PG8_BAR; PG8_SCHED;
            PG8_LDA(At, 1, 1); PG8_STAGE(PG8_SB(1, 0), b3, voffB); PG8_STAGE(PG8_SB(1, 1), b3 + hstep, voffB); PG8_STAGE(PG8_SA(1, 0), a3, voffA);
            PG8_WAIT_V(8); PG8_WAIT_L(0); PG8_BAR; PG8_MMA(1, 0, At, B0); PG8_MMA(1, 1, At, B1); PG8_BAR; PG8_SCHED;
            } else {
            PG8_LDB(B0, 0, 0); PG8_SCHED; PG8_LDA(At, 0, 0); PG8_STAGE(PG8_SA(1, 1), a1 + hstep, voffA);
            PG8_WAIT_L(8); PG8_BAR; PG8_WAIT_L(0); PG8_MMA(0, 0, At, B0); PG8_BAR; PG8_SCHED;
            PG8_LDB(B1, 0, 1); PG8_STAGE(PG8_SB(0, 0), b2, voffB);
            PG8_BAR; PG8_WAIT_L(0); PG8_MMA(0, 1, At, B1); PG8_BAR;
            PG8_LDA(At, 0, 1); PG8_STAGE(PG8_SA(0, 0), a2, voffA);
            PG8_BAR; PG8_WAIT_L(0); PG8_MMA(1, 0, At, B0); PG8_BAR; PG8_SCHED;
            PG8_STAGE(PG8_SB(0, 1), b2 + hstep, voffB);
            PG8_WAIT_V(6); PG8_BAR; PG8_MMA(1, 1, At, B1); PG8_BAR;
            PG8_LDB(B0, 1, 0); PG8_SCHED; PG8_LDA(At, 1, 0); PG8_STAGE(PG8_SA(0, 1), a2 + hstep, voffA);
            PG8_WAIT_L(8); PG8_BAR; PG8_WAIT_L(0); PG8_MMA(0, 0, At, B0); PG8_BAR; PG8_SCHED;
            PG8_LDB(B1, 1, 1); PG8_STAGE(PG8_SB(1, 0), b3, voffB);
            PG8_BAR; PG8_WAIT_L(0); PG8_MMA(0, 1, At, B1); PG8_BAR;
            PG8_LDA(At, 1, 1); PG8_STAGE(PG8_SA(1, 0), a3, voffA);
            PG8_BAR; PG8_WAIT_L(0); PG8_MMA(1, 0, At, B0); PG8_BAR; PG8_SCHED;
            PG8_STAGE(PG8_SB(1, 1), b3 + hstep, voffB);
            PG8_WAIT_V(6); PG8_BAR; PG8_MMA(1, 1, At, B1); PG8_BAR;
            }
        }
        if constexpr (ALIGN_EPI) { if (wr == 0) PG8_BAR; }
        if constexpr (!Epi::AFTER_DRAIN) { E(acc, cur, wr, wc, fr, fq); S.done(cur); }
        if (!has_next) break;
#pragma unroll
        for (int a = 0; a < 2; ++a)
#pragma unroll
            for (int b = 0; b < 2; ++b)
#pragma unroll
                for (int m = 0; m < 4; ++m)
#pragma unroll
                    for (int n = 0; n < 2; ++n) acc[a][b][m][n] = (f32x4){0.f, 0.f, 0.f, 0.f};
        cur = nxt; cA = nA; cB = nB; ++ui;
        if constexpr (ALIGN_EPI) { if (wr == 1) PG8_BAR; }
    }
    PG8_WAIT_V(0);
    if constexpr (!ALIGN_EPI) { if (wr == 0) PG8_BAR; }
    PG8_BAR;
    if constexpr (Epi::AFTER_DRAIN) { E.fused(acc, cur, wr, wc, fr, fq, lds, wid, lane); S.done(cur); }
#undef PG8_SA
#undef PG8_SB
#undef PG8_STAGE
#undef PG8_LDA
#undef PG8_LDB
#undef PG8_MMA
#undef PG8_WAIT_V
#undef PG8_WAIT_L
#undef PG8_BAR
#undef PG8_SCHED
}
}
namespace fox {
constexpr int D = 128, OPITCH = 2048;
constexpr bool WSKIP = false;
constexpr float THR = 8.f;
constexpr float SCALE = 0.08838834764831845f;
constexpr float INV_SCALE = 11.313708498984761f;
constexpr int NW = 8, QBLK = 32, KVBLK = 64, QB = NW * QBLK;
constexpr int SHM_V = KVBLK * D * 2, SHM_K = KVBLK * D * 2;
constexpr int LDS_BIAS = 2 * SHM_V + 2 * SHM_K + NW * 64 * 4;
constexpr int LDS_BYTES = LDS_BIAS + 2 * 64 * 4;

using bf16 = __hip_bfloat16;
typedef short bf16x8 __attribute__((ext_vector_type(8)));
typedef short s16x4 __attribute__((ext_vector_type(4)));
typedef float f32x16 __attribute__((ext_vector_type(16)));
typedef float f32x4 __attribute__((ext_vector_type(4)));
typedef unsigned u32x4 __attribute__((ext_vector_type(4)));
template <class A, class Bt> struct same_t { static constexpr bool v = false; };
template <class A> struct same_t<A, A> { static constexpr bool v = true; };

#define KSWZ(row, colB) ((row) * 256 + ((colB) ^ (((row) & 7) << 4)))
#define SBAR() __builtin_amdgcn_sched_barrier(0)
__device__ __forceinline__ int v_st(int k, int c) { const int kk = (k & ~0xC) | ((k & 4) << 1) | ((k & 8) >> 1); return ((kk >> 3) * 4 + (c >> 5)) * 512 + ((kk & 7) * 32 + (c & 31)) * 2; }
__device__ __forceinline__ int v_rd_base(int lane) { return ((lane & 3) << 3) | (((lane >> 2) & 3) << 6) | (((lane >> 4) & 1) << 5) | (((lane >> 5) & 1) << 8); }
constexpr int v_rd_off(int d0, int ks, int half) { return d0 * 512 + ks * 4096 + half * 2048; }
__device__ __forceinline__ int crow(int r, int hi) { return (r & 3) + 8 * (r >> 2) + 4 * hi; }
__device__ __forceinline__ unsigned cvtpk(float lo, float hi) {
    unsigned r; asm volatile("v_cvt_pk_bf16_f32 %0, %1, %2" : "=v"(r) : "v"(lo), "v"(hi)); return r;
}
__device__ __forceinline__ bf16x8 pack8(f32x4 a, f32x4 b) {
    u32x4 w = {cvtpk(a[0], a[1]), cvtpk(a[2], a[3]), cvtpk(b[0], b[1]), cvtpk(b[2], b[3])};
    return *reinterpret_cast<bf16x8*>(&w);
}
template <class T> __device__ __forceinline__ bf16x8 load8(const T* p) {
    if constexpr (same_t<T, float>::v) { return pack8(*(const f32x4*)p, *(const f32x4*)(p + 4)); }
    else { return *reinterpret_cast<const bf16x8*>(p); }
}
__device__ __forceinline__ void mask_tile(f32x16& p0, f32x16& p1, int dq, unsigned W) {
    const float NEG = -__builtin_inff();
#pragma unroll
    for (int r = 0; r < 16; ++r) {
        const int c = (r & 3) + 8 * (r >> 2);
        if ((unsigned)(dq - c) >= W) p0[r] = NEG;
        if ((unsigned)(dq - c - 32) >= W) p1[r] = NEG;
    }
}
__device__ __forceinline__ void partialSM(f32x16& p0, f32x16& p1, float& m_reg, float& mn, float& alpha) {
    float pmax = p0[0]; for (int r = 1; r < 16; ++r) pmax = fmaxf(pmax, p0[r]); for (int r = 0; r < 16; ++r) pmax = fmaxf(pmax, p1[r]);
    { auto rr = __builtin_amdgcn_permlane32_swap(__float_as_uint(pmax), __float_as_uint(pmax), false, false);
      pmax = fmaxf(__uint_as_float(rr[0]), __uint_as_float(rr[1])); }
    constexpr float C2 = 1.4426950408889634f * SCALE;
    if (__builtin_expect(__all((pmax - m_reg) * SCALE <= THR), 1)) { mn = m_reg; alpha = 1.f; }
    else { mn = fmaxf(m_reg, pmax); alpha = __builtin_amdgcn_exp2f((m_reg - mn) * C2); m_reg = mn; }
    const float mnL = -mn * C2;
    for (int r = 0; r < 16; ++r) p0[r] = fmaf(p0[r], C2, mnL); for (int r = 0; r < 16; ++r) p1[r] = fmaf(p1[r], C2, mnL);
    for (int r = 0; r < 16; ++r) p0[r] = __builtin_amdgcn_exp2f(p0[r]);
}
__device__ __forceinline__ void finishSM(f32x16& p0, f32x16& p1, float alpha, float& l_reg, bf16x8& pa0, bf16x8& pa1, bf16x8& pa2, bf16x8& pa3) {
    for (int r = 0; r < 16; ++r) p1[r] = __builtin_amdgcn_exp2f(p1[r]);
    float ps = 0; for (int r = 0; r < 16; ++r) ps += p0[r]; for (int r = 0; r < 16; ++r) ps += p1[r];
    { auto rr = __builtin_amdgcn_permlane32_swap(__float_as_uint(ps), __float_as_uint(ps), false, false);
      ps = __uint_as_float(rr[0]) + __uint_as_float(rr[1]); }
    l_reg = l_reg * alpha + ps;
#define PK4(P, B_, OUT) do { unsigned a0 = cvtpk(P[B_+0], P[B_+1]), a1 = cvtpk(P[B_+2], P[B_+3]);                          \
        unsigned b0 = cvtpk(P[B_+4], P[B_+5]), b1 = cvtpk(P[B_+6], P[B_+7]);                                             \
        auto r0 = __builtin_amdgcn_permlane32_swap(a0, b0, false, false); auto r1 = __builtin_amdgcn_permlane32_swap(a1, b1, false, false); \
        u32x4 w = {r0[0], r1[0], r0[1], r1[1]}; OUT = *reinterpret_cast<bf16x8*>(&w); } while (0)
    PK4(p0, 0, pa0); PK4(p0, 8, pa1); PK4(p1, 0, pa2); PK4(p1, 8, pa3);
#undef PK4
}
template <int KB, bool SK>
__device__ __forceinline__ void qkt(f32x16& p0, f32x16& p1, const char* K_lds, int r32, int hi, const bf16x8* qr, bool act) {
    const float* bl_ = (const float*)(K_lds + 2 * SHM_K + NW * 64 * 4) + KB * 64 + 4 * hi;
    if (SK && !act) { const float NEG = -__builtin_inff();
#pragma unroll
        for (int r = 0; r < 16; ++r) { p0[r] = NEG; p1[r] = NEG; } return; }
#pragma unroll
    for (int g = 0; g < 4; ++g) { const f32x4 v0_ = *(const f32x4*)(bl_ + 8 * g), v1_ = *(const f32x4*)(bl_ + 32 + 8 * g);
        p0[4 * g] = v0_[0]; p0[4 * g + 1] = v0_[1]; p0[4 * g + 2] = v0_[2]; p0[4 * g + 3] = v0_[3];
        p1[4 * g] = v1_[0]; p1[4 * g + 1] = v1_[1]; p1[4 * g + 2] = v1_[2]; p1[4 * g + 3] = v1_[3]; }
    const char* kb[4];
#pragma unroll
    for (int dd = 0; dd < 4; ++dd) kb[dd] = K_lds + KB * SHM_K + KSWZ(r32, (dd * 16 + hi * 8) * 2);
#pragma unroll
    for (int d0 = 0; d0 < 8; ++d0) { const char* a = kb[d0 & 3] + (d0 >> 2) * 128;
        bf16x8 b0 = *reinterpret_cast<const bf16x8*>(a);
        bf16x8 b1 = *reinterpret_cast<const bf16x8*>(a + 32 * 256);
        p0 = __builtin_amdgcn_mfma_f32_32x32x16_bf16(b0, qr[d0], p0, 0, 0, 0);
        p1 = __builtin_amdgcn_mfma_f32_32x32x16_bf16(b1, qr[d0], p1, 0, 0, 0); }
}
template <int VB, bool SK>
__device__ __forceinline__ void pv_tile(f32x16* o, int vb0, bf16x8 pa0, bf16x8 pa1, bf16x8 pa2, bf16x8 pa3, bool act) {
    if (SK && !act) return;
#define TRRD(dst, off) asm volatile("ds_read_b64_tr_b16 %0, %1 offset:%2" : "=&v"(dst) : "v"(vb0), "i"(off) : "memory")
#define PV_D0(d0) do { s16x4 l0, l1, l2, l3, h0, h1, h2, h3; constexpr int b_ = VB * SHM_V + v_rd_off(d0, 0, 0);     \
        TRRD(l0, b_); TRRD(h0, b_ + 2048); TRRD(l1, b_ + 4096); TRRD(h1, b_ + 6144); TRRD(l2, b_ + 8192); TRRD(h2, b_ + 10240); TRRD(l3, b_ + 12288); TRRD(h3, b_ + 14336); \
        asm volatile("s_waitcnt lgkmcnt(0)" ::: "memory"); SBAR();                 \
        o[d0] = __builtin_amdgcn_mfma_f32_32x32x16_bf16(pa0, (bf16x8){l0[0], l0[1], l0[2], l0[3], h0[0], h0[1], h0[2], h0[3]}, o[d0], 0, 0, 0);   \
        o[d0] = __builtin_amdgcn_mfma_f32_32x32x16_bf16(pa1, (bf16x8){l1[0], l1[1], l1[2], l1[3], h1[0], h1[1], h1[2], h1[3]}, o[d0], 0, 0, 0);   \
        o[d0] = __builtin_amdgcn_mfma_f32_32x32x16_bf16(pa2, (bf16x8){l2[0], l2[1], l2[2], l2[3], h2[0], h2[1], h2[2], h2[3]}, o[d0], 0, 0, 0);   \
        o[d0] = __builtin_amdgcn_mfma_f32_32x32x16_bf16(pa3, (bf16x8){l3[0], l3[1], l3[2], l3[3], h3[0], h3[1], h3[2], h3[3]}, o[d0], 0, 0, 0); } while (0)
    PV_D0(0); PV_D0(1); PV_D0(2); PV_D0(3);
#undef PV_D0
#undef TRRD
}

template <class TIn, class TOut> struct BlockRef {
    const TIn* K; TOut* O; int P0; int jlo; int bh;
    __device__ __forceinline__ const TIn* Vp() const { return K + (1 << 25); }
    __device__ __forceinline__ const TIn* Qp() const { return K - (1 << 25) + (size_t)P0 * D; }
};
struct FoxBases { const float* F; const float* NW; };
#define BR_F(r) (fb.F + (size_t)(r).bh * 16384)
template <class TIn> struct Seam {
    bf16x8 qr[8];
    bf16x8 st_v0, st_v1, st_k0, st_k1; f32x4 sf0, sf1, sf2, sf3;
    f32x4 tq[16];
};
__device__ __forceinline__ int swa_jlo(int P0, int W) { const int lowk = P0 - W + 1; return lowk > 0 ? lowk / KVBLK : 0; }
#define ROW(p, k0, rr) ((p) + (size_t)((k0) + ((rr) - sr)) * D + lofs_)
#define VMW() asm volatile("s_waitcnt vmcnt(0)" ::: "memory")
#define VMWN(n) asm volatile("s_waitcnt vmcnt(%0)" :: "i"(n) : "memory")
#define SLOAD_H(Kp, Vp, Fp, k0, bfb) do { S.st_v0 = load8<TIn>(ROW(Vp, k0, sr)); S.st_v1 = load8<TIn>(ROW(Vp, k0, 32 + sr));              \
                         S.st_k0 = load8<TIn>(ROW(Kp, k0, sr)); S.st_k1 = load8<TIn>(ROW(Kp, k0, 32 + sr));                         \
                         if (wid == 0) __builtin_amdgcn_global_load_lds((const unsigned*)((Fp) + (k0) + lane),                          \
                             (__attribute__((address_space(3))) unsigned*)(bias_las + (bfb) * 256), 4, 0, 0); } while (0)
#define SWRITE_HK(bf) do { *(bf16x8*)(K_lds + (bf) * SHM_K + kws) = S.st_k0; *(bf16x8*)(K_lds + (bf) * SHM_K + kws + 32 * 256) = S.st_k1; } while (0)
#define SWRITE_HV(bf) do { *(bf16x8*)(V_lds + (bf) * SHM_V + vst0) = S.st_v0; *(bf16x8*)(V_lds + (bf) * SHM_V + vst1) = S.st_v1; } while (0)
#define SWRITE_H(bf) do { SWRITE_HV(bf); SWRITE_HK(bf); } while (0)
#define SLOAD_F(p, k0) do { S.sf0 = *(const f32x4*)ROW(p, k0, sr); S.sf1 = *(const f32x4*)(ROW(p, k0, sr) + 4);                \
                            S.sf2 = *(const f32x4*)ROW(p, k0, 32 + sr); S.sf3 = *(const f32x4*)(ROW(p, k0, 32 + sr) + 4); } while (0)
#define SWRITE_KF(bf) do { *(bf16x8*)(K_lds + (bf) * SHM_K + kws) = pack8(S.sf0, S.sf1); *(bf16x8*)(K_lds + (bf) * SHM_K + kws + 32 * 256) = pack8(S.sf2, S.sf3); } while (0)
#define SWRITE_VF(bf) do { *(bf16x8*)(V_lds + (bf) * SHM_V + vst0) = pack8(S.sf0, S.sf1); *(bf16x8*)(V_lds + (bf) * SHM_V + vst1) = pack8(S.sf2, S.sf3); } while (0)
template <class TIn, class TOut>
__device__ __forceinline__ void causal_swa_prime(const BlockRef<TIn, TOut>& cur, const FoxBases& fb, int W, char* lds, Seam<TIn>& S, const int wid_in) {
    constexpr bool F32 = same_t<TIn, float>::v;
    const int wid = wid_in, lane = mk_lane_id(), tid = wid * 64 + lane, r32 = lane & 31, hi = lane >> 5;
    const int sr = tid >> 4, sc = (tid & 15) * 8, kws = KSWZ(sr, sc * 2); char* K_lds = lds + 2 * SHM_V;
    const unsigned lofs_ = (unsigned)(sr * D + sc);
    __attribute__((address_space(3))) unsigned char* bias_las = (__attribute__((address_space(3))) unsigned char*)lds + LDS_BIAS;
    const int kb0 = cur.jlo * KVBLK;
    for (int d0 = 0; d0 < 8; ++d0) S.qr[d0] = load8<TIn>(cur.Qp() + (size_t)(wid * QBLK) * D + (unsigned)(r32 * D + hi * 8) + d0 * 16);
    if constexpr (F32) { SLOAD_F((const float*)cur.K, kb0); VMW(); SWRITE_KF(0); SBAR(); SLOAD_F((const float*)cur.Vp(), kb0); }
    else { SLOAD_H(cur.K, cur.Vp(), BR_F(cur), kb0, 0); VMW(); SWRITE_HK(0); }
    __syncthreads();
}
template <class TIn, class TOut>
__device__ __forceinline__ void causal_swa_block(const BlockRef<TIn, TOut>& cur, const BlockRef<TIn, TOut>& nxt, const FoxBases& fb, int skv, int W, char* lds, Seam<TIn>& S, const int wid_in) {
    constexpr bool F32 = same_t<TIn, float>::v;
    const int wid = wid_in, lane = mk_lane_id(), tid = wid * 64 + lane, r32 = lane & 31, hi = lane >> 5;
    const int j_lo = cur.jlo;
    int j_hi = (cur.P0 + QB - 1) / KVBLK + 1; if (j_hi > skv / KVBLK) j_hi = skv / KVBLK;
    const int NT = j_hi - j_lo;
    const int kbn = nxt.jlo * KVBLK;
    const int qlo = cur.P0 + wid * QBLK, qm = qlo + r32 - 4 * hi;
    char* V_lds = lds; char* K_lds = lds + 2 * SHM_V;
    __attribute__((address_space(3))) unsigned char* bias_las = (__attribute__((address_space(3))) unsigned char*)lds + LDS_BIAS;
    float* ws = (float*)(lds + 2 * SHM_V + 2 * SHM_K) + wid * 64; float* li_l = ws, * al_l = ws + 32;
    float m_reg = -1e30f, l_reg = 0; f32x16 o[4] = {};
    const unsigned lofs_ = (unsigned)((tid >> 4) * D + (tid & 15) * 8);
    const int sr = tid >> 4, sc = (tid & 15) * 8, vst0 = v_st(sr, sc), vst1 = v_st(32 + sr, sc), kws = KSWZ(sr, sc * 2);
    const int vb0 = (int)(uintptr_t)V_lds + v_rd_base(lane);
    const TIn* Kh = cur.K; const TIn* Vh = cur.Vp(); const float* Fh = BR_F(cur);
#define RESC(a) do { if (__any((a) < 1.f)) { if (hi == 0) al_l[r32] = (a); asm volatile("s_waitcnt lgkmcnt(0)" ::: "memory");              \
                     for (int d_ = 0; d_ < 4; ++d_) for (int r = 0; r < 16; ++r) o[d_][r] *= al_l[crow(r, hi)]; } } while (0)
#define KBASE(t) ((j_lo + (t)) * KVBLK)
#define ACT(t) (KBASE(t) <= qlo + QBLK - 1 && KBASE(t) + KVBLK - 1 >= qlo - W + 1)
#define MASKT(P0_, P1_, t) do { const int kb_ = KBASE(t); if ((!SK || ACT(t)) && (kb_ + KVBLK - 1 > qlo || kb_ <= qlo + QBLK - 1 - W)) mask_tile(P0_, P1_, qm - kb_, (unsigned)W); } while (0)
    constexpr int NQL = F32 ? 16 : 8;
    constexpr bool SK = WSKIP && !F32;
#define SEAM_K0() do { VMWN(NQL); if constexpr (F32) { SWRITE_KF(0); SBAR(); SLOAD_F((const float*)nxt.Vp(), kbn); } else { SWRITE_HK(0); } SBAR(); } while (0)
    f32x16 pA0, pA1, pB0, pB1; float mnA, mnB, alA, alB; bf16x8 pa0, pa1, pa2, pa3;
    if constexpr (F32) { VMW(); SWRITE_VF(0); SBAR(); } else { SWRITE_HV(0); SBAR(); }
    if (NT > 1) { if constexpr (F32) SLOAD_F((const float*)Kh, KBASE(1)); else SLOAD_H(Kh, Vh, Fh, KBASE(1), 1); }
    SBAR(); qkt<0, SK>(pA0, pA1, K_lds, r32, hi, S.qr, ACT(0));
    if constexpr (F32) { if (NT > 1) { VMW(); SWRITE_KF(1); SBAR(); SLOAD_F((const float*)Vh, KBASE(1)); } }
    MASKT(pA0, pA1, 0); partialSM(pA0, pA1, m_reg, mnA, alA);
    if (NT > 1) { VMW(); if constexpr (F32) { SWRITE_VF(1); SBAR(); if (NT > 2) SLOAD_F((const float*)Kh, KBASE(2)); } else SWRITE_H(1); }
    __syncthreads();
#define HALF_STEP(PX0, PX1, mnX, alX, PY0, PY1, alY, t, KB, VB, SB) do {                                                      \
        SBAR(); qkt<KB, SK>(PX0, PX1, K_lds, r32, hi, S.qr, ACT(t));                                             \
        finishSM(PY0, PY1, alY, l_reg, pa0, pa1, pa2, pa3); SBAR();                                                           \
        if ((t) + 1 < NT) { if constexpr (F32) { VMW(); SWRITE_KF(SB); SBAR(); SLOAD_F((const float*)Vh, KBASE((t) + 1)); }  \
                            else { SLOAD_H(Kh, Vh, Fh, KBASE((t) + 1), SB); } SBAR(); }                                       \
        pv_tile<VB, SK>(o, vb0, pa0, pa1, pa2, pa3, ACT((t) - 1)); MASKT(PX0, PX1, (t)); partialSM(PX0, PX1, m_reg, mnX, alX);                                        \
        __syncthreads();                                                                                                      \
        if ((t) + 1 < NT) { VMW(); if constexpr (F32) { SWRITE_VF(SB); SBAR(); if ((t) + 2 < NT) SLOAD_F((const float*)Kh, KBASE((t) + 2)); } \
                            else { SWRITE_H(SB); } }                                                                          \
        RESC(alX); __syncthreads(); } while (0)
    for (int t = 1; t + 1 < NT; t += 2) {
        HALF_STEP(pB0, pB1, mnB, alB, pA0, pA1, alA, t, 1, 0, 0);
        HALF_STEP(pA0, pA1, mnA, alA, pB0, pB1, alB, t + 1, 0, 1, 1);
    }
    const bool even = (NT & 1) == 0;
    if (even) { SBAR(); qkt<1, SK>(pB0, pB1, K_lds, r32, hi, S.qr, ACT(NT - 1)); SBAR(); }
#define QROW(e) (nxt.Qp() + (size_t)(wid * QBLK + r32) * D + ((e) >> 1) * 16 + hi * 8 + ((e) & 1) * 4)
    if constexpr (F32) { SLOAD_F((const float*)nxt.K, kbn); SBAR();
#pragma unroll
        for (int e = 0; e < 8; ++e) S.tq[e] = *(const f32x4*)QROW(e); }
    else { SLOAD_H(nxt.K, nxt.Vp(), BR_F(nxt), kbn, 0); SBAR();
#pragma unroll
        for (int d0 = 0; d0 < 8; ++d0) S.qr[d0] = load8<TIn>(nxt.Qp() + (size_t)(wid * QBLK) * D + (unsigned)(r32 * D + hi * 8) + d0 * 16); }
    SBAR();
    finishSM(pA0, pA1, alA, l_reg, pa0, pa1, pa2, pa3); SBAR();
    if constexpr (F32) {
#pragma unroll
        for (int e = 8; e < 16; ++e) S.tq[e] = *(const f32x4*)QROW(e); SBAR(); }
#undef QROW
    pv_tile<0, SK>(o, vb0, pa0, pa1, pa2, pa3, ACT(even ? NT - 2 : NT - 1));
    if (even) { MASKT(pB0, pB1, NT - 1); partialSM(pB0, pB1, m_reg, mnB, alB); __syncthreads(); RESC(alB);
        finishSM(pB0, pB1, alB, l_reg, pa0, pa1, pa2, pa3); SBAR(); pv_tile<1, SK>(o, vb0, pa0, pa1, pa2, pa3, ACT(NT - 1)); }
    SBAR(); SEAM_K0();
    if (hi == 0) li_l[r32] = l_reg; asm volatile("s_waitcnt lgkmcnt(0)" ::: "memory");
    {
        typedef __attribute__((address_space(3))) float lasf;
        lasf* ssq_l = (lasf*)(__attribute__((address_space(3))) unsigned char*)lds + (LDS_BIAS - NW * 64 * 4) / 4 + wid * 64 + 32;
        float rli[16];
#pragma unroll
        for (int r = 0; r < 16; ++r) rli[r] = __builtin_amdgcn_rcpf(li_l[crow(r, hi)]);
        if (hi == 0) al_l[r32] = 0.f;
        asm volatile("s_waitcnt lgkmcnt(0)" ::: "memory");
#pragma unroll
        for (int r = 0; r < 16; ++r) { float ss_ = 0.f;
#pragma unroll
            for (int d0 = 0; d0 < 4; ++d0) { const float v = o[d0][r] * rli[r]; ss_ += v * v; }
            (void)__hip_atomic_fetch_add(ssq_l + crow(r, hi), ss_, __ATOMIC_RELAXED, __HIP_MEMORY_SCOPE_WORKGROUP); }
        asm volatile("s_waitcnt lgkmcnt(0)" ::: "memory");
#pragma unroll
        for (int r = 0; r < 16; ++r) rli[r] *= __builtin_amdgcn_rsqf(al_l[crow(r, hi)] * (1.0f / 128.0f) + 1e-6f);
        float wn_[4];
#pragma unroll
        for (int d0 = 0; d0 < 4; ++d0) wn_[d0] = fb.NW[(cur.bh & 7) * 128 + d0 * 32 + r32];
        TOut* Ow = cur.O + (size_t)(wid * QBLK) * OPITCH;
#pragma unroll
        for (int r = 0; r < 16; ++r) { const int orow = crow(r, hi);
#pragma unroll
            for (int d0 = 0; d0 < 4; ++d0) { const float v = o[d0][r] * rli[r] * wn_[d0];
                const float vn = __shfl_xor(v, 1);
                if ((r32 & 1) == 0) *(unsigned*)(Ow + (size_t)orow * OPITCH + d0 * 32 + r32) = cvtpk(v, vn); } }
    }
    if constexpr (F32) {
#pragma unroll
        for (int d0 = 0; d0 < 8; ++d0) S.qr[d0] = pack8(S.tq[2 * d0], S.tq[2 * d0 + 1]); }
    __syncthreads();
#undef RESC
#undef KBASE
#undef ACT
#undef MASKT
#undef SEAM_K0
#undef HALF_STEP
}
#undef ROW
#undef VMW
#undef VMWN
#undef SLOAD_H
#undef SWRITE_HK
#undef SWRITE_HV
#undef SWRITE_H
#undef SLOAD_F
#undef SWRITE_KF
#undef SWRITE_VF
}
constexpr int NWAVES = 8;
constexpr int NTHR = NWAVES * 64;
#ifndef MK_N_LAUNCHES
#define MK_N_LAUNCHES 1
#endif
constexpr int NPHASE = 8;
constexpr int BATCH = 2, SEQ = 16384, DM = 2048, T = BATCH * SEQ;
constexpr int NZ = 6400;
constexpr int NCH = SEQ / 128;
constexpr float NORM_EPS = 1e-6f;
constexpr size_t MiB = 1u << 20;
constexpr size_t WS_CTL = 0, CTL_ZERO_BYTES = 64 * 1024;
constexpr size_t WS_WINT = 1 * MiB;
constexpr size_t WS_WOUTT = 26 * MiB;
constexpr size_t WS_WQT = 34 * MiB;
constexpr size_t WS_KEYS = 42 * MiB;
constexpr size_t WS_FCUM = 43 * MiB;
constexpr size_t WS_MSM = 44 * MiB;
constexpr size_t WS_GATES = 46 * MiB;
constexpr size_t WS_UB = 48 * MiB;
constexpr size_t WS_VB = 80 * MiB;
constexpr size_t WS_PEI = 432 * MiB;
constexpr size_t WS_PEG = 448 * MiB;
constexpr size_t WS_H = 176 * MiB;
constexpr size_t WS_FQ = 304 * MiB, WS_FK = 368 * MiB, WS_FV = 432 * MiB;
constexpr size_t WS_MQ = 496 * MiB, WS_MK = 528 * MiB;
constexpr size_t WS_MV = 560 * MiB, WS_MO = 624 * MiB;
constexpr size_t WS_PQ = 304 * MiB;
constexpr size_t WS_CPREV = 688 * MiB;
constexpr size_t WS_MIXED = 752 * MiB;
constexpr size_t WS_END = 880 * MiB;
constexpr int MS_MLOC = 0, MS_BLAST = 1024, MS_MPREV = 2048, MS_NLOC = 4096, MS_NPREV = 4096 + 131072;
constexpr int MS_JLO = 340000;
constexpr int MS_USC = 300000, MS_VSC = 320000;
constexpr int CW_QKMAX = 2048;
constexpr int CW_QUEUE = 3072;
constexpr int CW_BAR = 4096;

constexpr int LDS_BYTES = 160 * 1024;
constexpr int MISC_OFF = LDS_BYTES - 256;
constexpr int SCR_BYTES = MISC_OFF;

#define GAS __attribute__((address_space(1)))
#define LAS __attribute__((address_space(3)))
typedef unsigned short bf16;
typedef unsigned v4u __attribute__((ext_vector_type(4)));
typedef unsigned v2u __attribute__((ext_vector_type(2)));
typedef float f32x4 __attribute__((ext_vector_type(4)));
typedef float f32x2 __attribute__((ext_vector_type(2)));
typedef float f32x16 __attribute__((ext_vector_type(16)));
typedef short bf16x8 __attribute__((ext_vector_type(8)));
typedef GAS unsigned gu32;
#define RLX_AGENT __ATOMIC_RELAXED, __HIP_MEMORY_SCOPE_AGENT
#define LDS_WAIT() asm volatile("s_waitcnt lgkmcnt(0)" ::: "memory")
#define VM_WAIT() asm volatile("s_waitcnt vmcnt(0)" ::: "memory")
__device__ __forceinline__ unsigned cvtpk(float lo, float hi) { unsigned r; asm volatile("v_cvt_pk_bf16_f32 %0, %1, %2" : "=v"(r) : "v"(lo), "v"(hi)); return r; }
__device__ __forceinline__ float bflo(unsigned w) { return __uint_as_float(w << 16); }
__device__ __forceinline__ float bfhi(unsigned w) { return __uint_as_float(w & 0xffff0000u); }
__device__ __forceinline__ float logsig(float x) { return fminf(x, 0.f) - log1pf(__expf(-fabsf(x))); }
__device__ __forceinline__ float wave_sum(float v) {
#pragma unroll
    for (int o = 1; o < 64; o <<= 1) v += __shfl_xor(v, o);
    return v;
}
__device__ __forceinline__ float wave_max(float v) {
#pragma unroll
    for (int o = 1; o < 64; o <<= 1) v = fmaxf(v, __shfl_xor(v, o));
    return v;
}
#define XB_TMO      128
#define XB_XCNT(j)  (256  + 64 * (j))
#define XB_XSUB(j)  (1280 + 64 * (j))
#define XB_XGEN(j)  (2304 + 64 * (j))
#define XB_TOP      3328
#define XB_TOPGEN   3392
#define XCD_BAR_WORDS 3456
#define XB_SPIN_CAP (1u << 18)

__device__ __forceinline__ unsigned xb_ld(unsigned* p)              { return __hip_atomic_load(p, __ATOMIC_RELAXED, __HIP_MEMORY_SCOPE_AGENT); }
__device__ __forceinline__ unsigned xb_add(unsigned* p, unsigned v) { return __hip_atomic_fetch_add(p, v, __ATOMIC_RELAXED, __HIP_MEMORY_SCOPE_AGENT); }
__device__ __forceinline__ unsigned xb_xcc_id() { return (unsigned)__builtin_amdgcn_s_getreg((3 << 11) | 20) & 0xFu; }
#define XB_SPIN(cond, bar) do { unsigned _sp = 0; while (cond) { __builtin_amdgcn_s_sleep(1); \
    if ((++_sp & 255u) == 0u) { if (xb_ld(&(bar)[XB_TMO])) break; if (_sp > XB_SPIN_CAP) { atomicAdd(&(bar)[XB_TMO], 1u); break; } } } } while (0)

struct XcdBarrier {
    unsigned* bar; unsigned x;
    volatile LAS unsigned* st;
};

__device__ __forceinline__ XcdBarrier xcd_barrier_post(unsigned* bar, volatile LAS unsigned* st, const int tid_) {
    XcdBarrier b; b.bar = bar; b.x = xb_xcc_id(); b.st = st;
    if (tid_ == 0) (void)xb_add(&bar[XB_XCNT(b.x)], 1u);
    return b;
}
__device__ __forceinline__ void xcd_barrier_complete(unsigned* bar, unsigned x, unsigned& nloc, unsigned& nx) {
    const unsigned G = gridDim.x * gridDim.y * gridDim.z;
    unsigned sum, cnt, mine, sp = 0u;
    for (;;) {
        sum = 0u; cnt = 0u; mine = 0u;
#pragma unroll
        for (unsigned j = 0; j < 16; ++j) { const unsigned c = xb_ld(&bar[XB_XCNT(j)]); sum += c; cnt += (c > 0u) ? 1u : 0u; mine = (j == x) ? c : mine; }
        if (sum == G) break;
        __builtin_amdgcn_s_sleep(1);
        if ((++sp & 255u) == 0u) { if (xb_ld(&bar[XB_TMO])) break; if (sp > XB_SPIN_CAP) { atomicAdd(&bar[XB_TMO], 1u); break; } }
    }
    nloc = mine > 0u ? mine : 1u; nx = cnt > 0u ? cnt : 1u;
}

__device__ __forceinline__ void xcd_barrier(const XcdBarrier& b, const int tid_) {
    asm volatile("s_waitcnt vmcnt(0)" ::: "memory");
    __syncthreads();
    if (tid_ == 0) {
        unsigned* bar = b.bar;
        __builtin_amdgcn_s_waitcnt(0);
        unsigned nloc = b.st[0], nx = b.st[1];
        if (nloc == 0u) { xcd_barrier_complete(bar, b.x, nloc, nx); b.st[0] = nloc; b.st[1] = nx; }
        const unsigned old = xb_add(&bar[XB_XSUB(b.x)], 1u);
        const unsigned gen = old / nloc;
        if (old + 1u == (gen + 1u) * nloc) {
            __builtin_amdgcn_fence(__ATOMIC_RELEASE, "agent");
            asm volatile("s_waitcnt vmcnt(0)" ::: "memory");
            const unsigned og = xb_add(&bar[XB_TOP], 1u);
            const unsigned tg = og / nx;
            if (og + 1u == (tg + 1u) * nx) xb_add(&bar[XB_TOPGEN], 1u);
            else XB_SPIN(xb_ld(&bar[XB_TOPGEN]) == tg, bar);
            __builtin_amdgcn_fence(__ATOMIC_ACQUIRE, "agent");
            xb_add(&bar[XB_XGEN(b.x)], 1u);
            asm volatile("s_waitcnt vmcnt(0)" ::: "memory");
        } else {
            XB_SPIN(xb_ld(&bar[XB_XGEN(b.x)]) == gen, bar);
            __builtin_amdgcn_fence(__ATOMIC_ACQUIRE, "agent");
            asm volatile("s_waitcnt vmcnt(0)" ::: "memory");
        }
    }
    __syncthreads();
}

struct Args {
    const float* x; const float* norm1_w; const float* w_in; const float* fox_f_bias; const float* conv_w; const float* conv_b;
    const float* i_bias; const float* f_bias; const float* fox_nw; const float* ml_nw; const float* w_out; const float* norm2_w;
    const float* w_q; const float* keys; const float* pu; const float* pv; const float* final_w;
    float* out; unsigned char* ws; int ph_lo, ph_hi, li, pad;
};
typedef const __attribute__((address_space(4))) Args* KA;
typedef __bf16 bf2_t __attribute__((ext_vector_type(2)));
__device__ __forceinline__ float dot2bf(unsigned a, unsigned b, float c) { return __builtin_amdgcn_fdot2_f32_bf16(__builtin_bit_cast(bf2_t, a), __builtin_bit_cast(bf2_t, b), c, false); }
#define MFMA16(a, b, c) __builtin_amdgcn_mfma_f32_16x16x32_bf16((a), (b), (c), 0, 0, 0)
#define MFMA32(a, b, c) __builtin_amdgcn_mfma_f32_32x32x16_bf16((a), (b), (c), 0, 0, 0)

__device__ __forceinline__ void p0_transpose_item(const float* W, int ldw, int src_col, bf16* WT, int dst_row, int Kp, int k0, LAS float* scr, int lane) {
#pragma unroll 8
    for (int i = 0; i < 32; ++i) { const int kk = 2 * i + (lane >> 5); scr[kk * 33 + (lane & 31)] = W[(size_t)(k0 + kk) * ldw + src_col + (lane & 31)]; }
    LDS_WAIT(); asm volatile("" ::: "memory");
    const int c = lane & 7;
#pragma unroll
    for (int j = 0; j < 4; ++j) { const int n = (lane >> 3) + 8 * j; const LAS float* s = scr + (8 * c) * 33 + n;
        v4u o; o.x = cvtpk(s[0 * 33], s[1 * 33]); o.y = cvtpk(s[2 * 33], s[3 * 33]); o.z = cvtpk(s[4 * 33], s[5 * 33]); o.w = cvtpk(s[6 * 33], s[7 * 33]);
        *(GAS v4u*)(WT + (size_t)(dst_row + n) * Kp + k0 + 8 * c) = o; }
    LDS_WAIT(); asm volatile("" ::: "memory");
}
__device__ __forceinline__ void rms_row_to_bf16(const float* xrow, const f32x4 (&w)[8], bf16* orow, int lane) {
    const GAS f32x4* xr = (const GAS f32x4*)xrow + lane;
    f32x4 v[8]; float s = 0.f;
#pragma unroll
    for (int j = 0; j < 8; ++j) { v[j] = xr[64 * j]; s += (v[j].x * v[j].x + v[j].y * v[j].y) + (v[j].z * v[j].z + v[j].w * v[j].w); }
    const float rn = __builtin_amdgcn_rsqf(wave_sum(s) * (1.f / DM) + NORM_EPS);
    GAS v2u* o8 = (GAS v2u*)orow + lane;
#pragma unroll
    for (int j = 0; j < 8; ++j) { v2u o; o.x = cvtpk(v[j].x * rn * w[j].x, v[j].y * rn * w[j].y); o.y = cvtpk(v[j].z * rn * w[j].z, v[j].w * rn * w[j].w); o8[64 * j] = o; }
}
__device__ __forceinline__ void rms_phase(const float* X, const float* wv, bf16* O, int gw, int NGW, int lane) {
    f32x4 w[8];
#pragma unroll
    for (int j = 0; j < 8; ++j) w[j] = ((const f32x4*)wv)[64 * j + lane];
    for (int m = gw; m < T; m += NGW) rms_row_to_bf16(X + (size_t)m * DM, w, O + (size_t)m * DM, lane);
}
__device__ __forceinline__ void cvt_stream(const float* src, bf16* dst, size_t ngroups8, size_t gid, size_t nthr) {
    for (size_t g = gid; g < ngroups8; g += nthr) { const f32x4 a = ((const f32x4*)src)[2 * g], b = ((const f32x4*)src)[2 * g + 1];
        v4u o; o.x = cvtpk(a.x, a.y); o.y = cvtpk(a.z, a.w); o.z = cvtpk(b.x, b.y); o.w = cvtpk(b.z, b.w); ((v4u*)dst)[g] = o; }
}
__device__ __forceinline__ void quant_row_fp8(const float* src, unsigned char* dst, float* sc_out, int lane) {
    f32x4 v[2][4]; float am = 0.f;
#pragma unroll
    for (int j = 0; j < 2; ++j)
#pragma unroll
        for (int i = 0; i < 4; ++i) { v[j][i] = *(const f32x4*)(src + 1024 * j + 16 * lane + 4 * i);
            am = fmaxf(am, fmaxf(fmaxf(fabsf(v[j][i].x), fabsf(v[j][i].y)), fmaxf(fabsf(v[j][i].z), fabsf(v[j][i].w)))); }
    am = wave_max(am);
    const float s = am > 0.f ? 224.f / am : 1.f;
#pragma unroll
    for (int j = 0; j < 2; ++j) { v4u o;
#pragma unroll
        for (int i = 0; i < 4; ++i) { int p = __builtin_amdgcn_cvt_pk_fp8_f32(v[j][i].x * s, v[j][i].y * s, 0, false); p = __builtin_amdgcn_cvt_pk_fp8_f32(v[j][i].z * s, v[j][i].w * s, p, true); o[i] = (unsigned)p; }
        *(v4u*)(dst + 1024 * j + 16 * lane) = o; }
    if (lane == 0) *sc_out = am > 0.f ? am * (1.f / 224.f) : 1.f;
}
__device__ __forceinline__ void p0_prologue(KA a, LAS unsigned char* lds, int tid, int lane, int wave, int vcu, int G) {
    unsigned char* ws = a->ws;
    bf16* WINT = (bf16*)(ws + WS_WINT); bf16* WOUTT = (bf16*)(ws + WS_WOUTT); bf16* WQT = (bf16*)(ws + WS_WQT);
    LAS float* scr = (LAS float*)(lds + wave * 16384);
    const int gw = vcu * NWAVES + wave, NGW = G * NWAVES;
    constexpr int I_IN = 32 * 192, I_SQ = 32 * 64;
    for (int it = gw; it < I_IN + 2 * I_SQ; it += NGW) {
        int r = it;
        if (r < I_IN) { const int kb = r / 192, nb = r % 192, n0 = nb * 32; const int src = n0 < 3072 ? n0 : (n0 < 5120 ? n0 + 8 : n0 + 16);
            p0_transpose_item(a->w_in, 6160, src, WINT, n0, DM, kb * 64, scr, lane); continue; }
        r -= I_IN;
        if (r < I_SQ) { p0_transpose_item(a->w_out, DM, (r % 64) * 32, WOUTT, (r % 64) * 32, DM, (r / 64) * 64, scr, lane); continue; }
        r -= I_SQ;
        p0_transpose_item(a->w_q, DM, (r % 64) * 32, WQT, (r % 64) * 32, DM, (r / 64) * 64, scr, lane);
    }
    const size_t gid = (size_t)vcu * NTHR + tid, nthr = (size_t)G * NTHR;
    for (size_t g = gid; g < 256 * 256; g += nthr) { const int i = (int)(g >> 8), k0 = (int)(g & 255) * 8;
        const int src = i < 8 ? 3072 + i : (i < 12 ? 5128 + (i - 8) : 5132 + (i - 12));
        float v[8];
#pragma unroll
        for (int j = 0; j < 8; ++j) v[j] = i < 16 ? a->w_in[(size_t)(k0 + j) * 6160 + src] : 0.f;
        v4u o; o.x = cvtpk(v[0], v[1]); o.y = cvtpk(v[2], v[3]); o.z = cvtpk(v[4], v[5]); o.w = cvtpk(v[6], v[7]);
        *(v4u*)(WINT + (size_t)(6144 + i) * DM + k0) = o; }
    cvt_stream(a->keys, (bf16*)(ws + WS_KEYS), 2 * 128 * 128 / 8, gid, nthr);
    { float* MSM = (float*)(ws + WS_MSM);
      for (int r = gw; r < 2 * 16384; r += NGW) { const int t = r >> 14, row = r & 16383;
          quant_row_fp8((t ? a->pv : a->pu) + (size_t)row * DM, ws + (t ? WS_VB : WS_UB) + (size_t)row * DM, MSM + (t ? MS_VSC : MS_USC) + row, lane); } }
    rms_phase(a->x, a->norm1_w, (bf16*)(ws + WS_H), gw, NGW, lane);
}

__device__ __forceinline__ void fox_cumsum(KA a, LAS unsigned char* lds, int bh, int tid, int lane, int wave) {
    const float* GATES = (const float*)(a->ws + WS_GATES); float* F = (float*)(a->ws + WS_FCUM) + (size_t)bh * SEQ;
    const int b = bh >> 3, h = bh & 7; const float bias = a->fox_f_bias[h];
    LAS float* wt = (LAS float*)lds;
    float v[32]; float run = 0.f;
#pragma unroll
    for (int i = 0; i < 32; ++i) { run += logsig(GATES[((size_t)b * SEQ + tid * 32 + i) * 16 + h] + bias); v[i] = run; }
    float sc = run;
#pragma unroll
    for (int o = 1; o < 64; o <<= 1) { const float n = __shfl_up(sc, o); if (lane >= o) sc += n; }
    if (lane == 63) wt[wave] = sc;
    __syncthreads();
    float off = sc - run;
    for (int w = 0; w < wave; ++w) off += wt[w];
#pragma unroll
    for (int i = 0; i < 32; i += 4) *(f32x4*)(F + tid * 32 + i) = (f32x4){v[i] + off, v[i + 1] + off, v[i + 2] + off, v[i + 3] + off} * (-11.313708498984761f);
    __syncthreads();
}

__device__ __forceinline__ void fox_qk_norm_max(KA a, int idx, int part, int lane, int wave) {
    const int bh = idx >> 1, isk = idx & 1;
    const bf16* base = (const bf16*)(a->ws + (isk ? WS_FK : WS_FQ)) + ((size_t)bh * SEQ + (size_t)part * 2048 + wave * 256) * 128;
    float mx = 0.f;
#pragma unroll 4
    for (int it = 0; it < 64; ++it) { const v4u p = *(const v4u*)(base + (size_t)it * 512 + 8 * lane);
        float s = 0.f;
#pragma unroll
        for (int w = 0; w < 4; ++w) { const float lo = bflo(p[w]), hi = bfhi(p[w]); s += lo * lo + hi * hi; }
        s += __shfl_xor(s, 1); s += __shfl_xor(s, 2); s += __shfl_xor(s, 4); s += __shfl_xor(s, 8);
        mx = fmaxf(mx, s); }
    mx = wave_max(mx);
    if (lane == 0) atomicMax((unsigned*)(a->ws + WS_CTL) + CW_QKMAX + idx, __float_as_uint(mx));
}
__device__ __forceinline__ void fox_jlo(KA a, int gid) {
    const int bh = gid >> 6, qb = gid & 63, P0 = qb * 256;
    const float* Fs = (const float*)(a->ws + WS_FCUM) + (size_t)bh * SEQ;
    const unsigned* qk = (const unsigned*)(a->ws + WS_CTL) + CW_QKMAX + 2 * bh;
    const float B = 0.08838834764831845f * sqrtf(__uint_as_float(qk[0]) * __uint_as_float(qk[1]));
    const float thr = 2.f * B + 30.f, f0 = Fs[P0];
    int lo = 0, hi = P0 / 64;
    while (lo < hi) { const int mid = (lo + hi) >> 1; const float D = (f0 - Fs[64 * mid + 63]) * 0.08838834764831845f;
        if (D < thr) hi = mid; else lo = mid + 1; }
    ((int*)(a->ws + WS_MSM))[MS_JLO + gid] = lo;
}

constexpr int LP = 136;
__device__ __forceinline__ float silu(float x) { return x / (1.f + __expf(-x)); }
__device__ __forceinline__ void chunk_gates(KA a, int t0, int h, int lane, float& b0, float& b1, float& i0, float& i1) {
    const float* GATES = (const float*)(a->ws + WS_GATES);
    const float* g0 = GATES + (size_t)(t0 + 2 * lane) * 16; const float ib = a->i_bias[h], fb = a->f_bias[h];
    i0 = g0[8 + h] + ib; i1 = g0[16 + 8 + h] + ib;
    const float l0 = logsig(g0[12 + h] + fb), l1 = logsig(g0[16 + 12 + h] + fb);
    float sc = l0 + l1;
#pragma unroll
    for (int o = 1; o < 64; o <<= 1) { const float n = __shfl_up(sc, o); if (lane >= o) sc += n; }
    b1 = sc; b0 = sc - l1;
}
__device__ __forceinline__ void stage_vt_chunk(const bf16* MV, int t0, int col, LAS bf16* VT, int erow, int lane) {
    const bf16* p = MV + (size_t)(t0 + 2 * lane) * 1024 + col;
    const v4u r0 = *(const v4u*)p, r1 = *(const v4u*)(p + 1024);
#pragma unroll
    for (int j = 0; j < 8; ++j) { const unsigned lo = (j & 1) ? (r0[j >> 1] >> 16) : (r0[j >> 1] & 0xffffu), hi = (j & 1) ? (r1[j >> 1] >> 16) : (r1[j >> 1] & 0xffffu);
        *(LAS unsigned*)(VT + (erow + j) * LP + 2 * lane) = lo | (hi << 16); }
}

__device__ __forceinline__ void mlstm_a_unit(KA a, LAS unsigned char* lds, int u, int tid, int lane, int wave) {
    const int bh = u >> 7, c = u & 127, b = bh >> 2, h = bh & 3, t0 = b * SEQ + c * 128;
    unsigned char* ws = a->ws; float* MSM = (float*)(ws + WS_MSM);
    LAS bf16* VT = (LAS bf16*)lds;
    LAS bf16* AKT = (LAS bf16*)(lds + 256 * LP * 2);
    LAS float* AE = (LAS float*)(lds + 384 * LP * 2);
    if (wave == 0) {
        float b0, b1, i0, i1; chunk_gates(a, t0, h, lane, b0, b1, i0, i1);
        const float bl = __shfl(b1, 63);
        const float w0 = bl - b0 + i0, w1 = bl - b1 + i1;
        const float ml = wave_max(fmaxf(w0, w1));
        AE[2 * lane] = __expf(w0 - ml); AE[2 * lane + 1] = __expf(w1 - ml);
        if (lane == 0) { MSM[MS_MLOC + u] = ml; MSM[MS_BLAST + u] = bl; }
    }
    __syncthreads();
    const bf16* MV = (const bf16*)(ws + WS_MV); const bf16* MK = (const bf16*)(ws + WS_MK);
#pragma unroll
    for (int i = 0; i < 4; ++i) { const int e0 = 8 * (4 * wave + i); stage_vt_chunk(MV, t0, h * 256 + e0, VT, e0, lane); }
    const float a0 = AE[2 * lane], a1 = AE[2 * lane + 1];
#pragma unroll
    for (int i = 0; i < 2; ++i) {
        const int d0 = 8 * (2 * wave + i), ch = 512 + h * 128 + d0;
        const bf16* p = MK + (size_t)(t0 + 2 * lane - 3) * 512 + h * 128 + d0;
        v4u rr[5];
#pragma unroll
        for (int r = 0; r < 5; ++r) { if (c * 128 + 2 * lane - 3 + r >= 0) rr[r] = *(const v4u*)(p + r * 512); else rr[r] = (v4u){0u, 0u, 0u, 0u}; }
#pragma unroll
        for (int jj = 0; jj < 8; ++jj) {
            float xv[5];
#pragma unroll
            for (int r = 0; r < 5; ++r) xv[r] = (jj & 1) ? bfhi(rr[r][jj >> 1]) : bflo(rr[r][jj >> 1]);
            const float cw0 = a->conv_w[ch + jj], cw1 = a->conv_w[1024 + ch + jj], cw2 = a->conv_w[2048 + ch + jj], cw3 = a->conv_w[3072 + ch + jj], cb = a->conv_b[ch + jj];
            const float y0 = cb + cw0 * xv[0] + cw1 * xv[1] + cw2 * xv[2] + cw3 * xv[3];
            const float y1 = cb + cw0 * xv[1] + cw1 * xv[2] + cw2 * xv[3] + cw3 * xv[4];
            const float k0 = silu(y0) * 0.08838834764831845f * a0, k1 = silu(y1) * 0.08838834764831845f * a1;
            *(LAS unsigned*)(AKT + (d0 + jj) * LP + 2 * lane) = cvtpk(k0, k1);
            const float ns = wave_sum(k0 + k1);
            if (lane == 0) MSM[MS_NLOC + u * 128 + d0 + jj] = ns;
        }
    }
    __syncthreads();
    f32x4 acc[2][8];
#pragma unroll
    for (int mi = 0; mi < 2; ++mi)
#pragma unroll
        for (int ni = 0; ni < 8; ++ni) acc[mi][ni] = (f32x4){0.f, 0.f, 0.f, 0.f};
    const int fr = lane & 15, fq = lane >> 4;
#pragma unroll
    for (int ks = 0; ks < 4; ++ks) {
        bf16x8 af[2], bf_[8];
#pragma unroll
        for (int mi = 0; mi < 2; ++mi) af[mi] = *(const LAS bf16x8*)(VT + (32 * wave + 16 * mi + fr) * LP + 32 * ks + 8 * fq);
#pragma unroll
        for (int ni = 0; ni < 8; ++ni) bf_[ni] = *(const LAS bf16x8*)(AKT + (16 * ni + fr) * LP + 32 * ks + 8 * fq);
#pragma unroll
        for (int mi = 0; mi < 2; ++mi)
#pragma unroll
            for (int ni = 0; ni < 8; ++ni) acc[mi][ni] = MFMA16(af[mi], bf_[ni], acc[mi][ni]);
    }
    float* Cout = (float*)(ws + WS_MIXED) + (size_t)u * 32768;
#pragma unroll
    for (int mi = 0; mi < 2; ++mi)
#pragma unroll
        for (int ni = 0; ni < 8; ++ni)
#pragma unroll
            for (int r = 0; r < 4; ++r) Cout[(32 * wave + 16 * mi + 4 * fq + r) * 128 + 16 * ni + fr] = acc[mi][ni][r];
    __syncthreads();
}

__device__ __forceinline__ void mlstm_scan(KA a, int vcu, int G, int tid) {
    unsigned char* ws = a->ws; float* MSM = (float*)(ws + WS_MSM);
    const float* CL = (const float*)(ws + WS_MIXED); unsigned* CP = (unsigned*)(ws + WS_CPREV);
    const int gid = vcu * NTHR + tid, nthr = G * NTHR;
    for (int pi = gid; pi < 8 * 16384; pi += nthr) {
        const int bh = pi >> 14, i2 = pi & 16383;
        float c0 = 0.f, c1 = 0.f, m = 0.f;
#pragma unroll 8
        for (int c = 0; c < NCH; ++c) {
            const float ml = MSM[MS_MLOC + bh * 128 + c], bl = MSM[MS_BLAST + bh * 128 + c];
            const size_t o = (size_t)(bh * 128 + c) * 16384 + i2;
            const f32x2 cl = ((const f32x2*)CL)[o];
            CP[o] = cvtpk(c0, c1);
            if (i2 == 0) MSM[MS_MPREV + bh * 128 + c] = m;
            const float mn = fmaxf(bl + m, ml), ap = __expf(bl + m - mn), al = __expf(ml - mn);
            c0 = ap * c0 + al * cl.x; c1 = ap * c1 + al * cl.y; m = mn;
        }
    }
    if (gid < 1024) {
        const int bh = gid >> 7, d = gid & 127; float n = 0.f, m = 0.f;
        for (int c = 0; c < NCH; ++c) {
            const float ml = MSM[MS_MLOC + bh * 128 + c], bl = MSM[MS_BLAST + bh * 128 + c];
            const float nl = MSM[MS_NLOC + (bh * 128 + c) * 128 + d];
            MSM[MS_NPREV + (bh * 128 + c) * 128 + d] = n;
            const float mn = fmaxf(bl + m, ml), ap = __expf(bl + m - mn), al = __expf(ml - mn);
            n = ap * n + al * nl; m = mn;
        }
    }
}

__device__ __forceinline__ void stage_conv_rows(KA a, const bf16* src, int chbase, float scale, int t0, int c, int h, LAS bf16* dst, int tid) {
    const int d0 = (tid & 15) * 8, ch = chbase + h * 128 + d0;
    float cw[4][8], cb[8];
#pragma unroll
    for (int j = 0; j < 4; ++j) { const f32x4 w0 = *(const f32x4*)(a->conv_w + j * 1024 + ch), w1 = *(const f32x4*)(a->conv_w + j * 1024 + ch + 4);
        cw[j][0] = w0.x; cw[j][1] = w0.y; cw[j][2] = w0.z; cw[j][3] = w0.w; cw[j][4] = w1.x; cw[j][5] = w1.y; cw[j][6] = w1.z; cw[j][7] = w1.w; }
    { const f32x4 w0 = *(const f32x4*)(a->conv_b + ch), w1 = *(const f32x4*)(a->conv_b + ch + 4);
      cb[0] = w0.x; cb[1] = w0.y; cb[2] = w0.z; cb[3] = w0.w; cb[4] = w1.x; cb[5] = w1.y; cb[6] = w1.z; cb[7] = w1.w; }
#pragma unroll
    for (int it = 0; it < 4; ++it) {
        const int l = (it * 512 + tid) >> 4;
        const bf16* p = src + (size_t)(t0 + l - 3) * 512 + h * 128 + d0;
        v4u rr[4];
#pragma unroll
        for (int r = 0; r < 4; ++r) { if (c * 128 + l - 3 + r >= 0) rr[r] = *(const v4u*)(p + r * 512); else rr[r] = (v4u){0u, 0u, 0u, 0u}; }
        float y[8];
#pragma unroll
        for (int jj = 0; jj < 8; ++jj) { float s = cb[jj];
#pragma unroll
            for (int r = 0; r < 4; ++r) s += cw[r][jj] * ((jj & 1) ? bfhi(rr[r][jj >> 1]) : bflo(rr[r][jj >> 1]));
            y[jj] = silu(s) * scale; }
        v4u o; o.x = cvtpk(y[0], y[1]); o.y = cvtpk(y[2], y[3]); o.z = cvtpk(y[4], y[5]); o.w = cvtpk(y[6], y[7]);
        *(LAS v4u*)(dst + l * LP + d0) = o;
    }
}
__device__ __forceinline__ void mlstm_c_unit(KA a, LAS unsigned char* lds, int u, int tid, int lane, int wave) {
    const int bh = u >> 7, c = u & 127, b = bh >> 2, h = bh & 3, t0 = b * SEQ + c * 128;
    unsigned char* ws = a->ws; const float* MSM = (const float*)(ws + WS_MSM);
    LAS bf16* QL = (LAS bf16*)lds;
    LAS bf16* KL = (LAS bf16*)(lds + 128 * LP * 2);
    LAS bf16* VTH = (LAS bf16*)(lds + 256 * LP * 2);
    LAS bf16* CTH = (LAS bf16*)(lds + 384 * LP * 2);
    LAS float* AR = (LAS float*)(lds + 512 * LP * 2);
    if (wave == 0) {
        float b0, b1, i0, i1; chunk_gates(a, t0, h, lane, b0, b1, i0, i1);
        const float c0 = i0 - b0, c1 = i1 - b1, pmx = fmaxf(c0, c1);
        float sc = pmx;
#pragma unroll
        for (int o = 1; o < 64; o <<= 1) { const float n = __shfl_up(sc, o); if (lane >= o) sc = fmaxf(sc, n); }
        float ex = __shfl_up(sc, 1); if (lane == 0) ex = -__builtin_inff();
        const float pm0 = fmaxf(ex, c0), pm1 = sc;
        const float mp = MSM[MS_MPREV + u];
        const float g0 = b0 + mp, g1 = b1 + mp, mt0 = fmaxf(g0, b0 + pm0), mt1 = fmaxf(g1, b1 + pm1);
        AR[2 * lane] = b0 - mt0; AR[2 * lane + 1] = b1 - mt1;
        AR[128 + 2 * lane] = c0; AR[128 + 2 * lane + 1] = c1;
        AR[256 + 2 * lane] = __expf(g0 - mt0); AR[256 + 2 * lane + 1] = __expf(g1 - mt1);
        AR[384 + 2 * lane] = __expf(-mt0); AR[384 + 2 * lane + 1] = __expf(-mt1);
    }
    if (tid >= 64 && tid < 192) AR[512 + tid - 64] = MSM[MS_NPREV + u * 128 + tid - 64];
    stage_conv_rows(a, (const bf16*)(ws + WS_MQ), 0, 1.0f, t0, c, h, QL, tid);
    stage_conv_rows(a, (const bf16*)(ws + WS_MK), 512, 0.08838834764831845f, t0, c, h, KL, tid);
    __syncthreads();
    const int fr = lane & 15, fq = lane >> 4, t = 16 * wave + fr;
    f32x4 st[8];
#pragma unroll
    for (int ni = 0; ni < 8; ++ni) st[ni] = (f32x4){0.f, 0.f, 0.f, 0.f};
    bf16x8 qf[4];
#pragma unroll
    for (int ks = 0; ks < 4; ++ks) qf[ks] = *(const LAS bf16x8*)(QL + t * LP + 32 * ks + 8 * fq);
#pragma unroll
    for (int ks = 0; ks < 4; ++ks)
#pragma unroll
        for (int ni = 0; ni < 8; ++ni) { const bf16x8 kf = *(const LAS bf16x8*)(KL + (16 * ni + fr) * LP + 32 * ks + 8 * fq); st[ni] = MFMA16(kf, qf[ks], st[ni]); }
    float qn = 0.f;
#pragma unroll
    for (int j = 0; j < 4; ++j) { const v4u qq = *(const LAS v4u*)(QL + t * LP + 32 * fq + 8 * j);
#pragma unroll
        for (int w = 0; w < 4; ++w) { qn += bflo(qq[w]) * AR[512 + 32 * fq + 8 * j + 2 * w] + bfhi(qq[w]) * AR[512 + 32 * fq + 8 * j + 2 * w + 1]; } }
    qn += __shfl_xor(qn, 16); qn += __shfl_xor(qn, 32);
    const float rc = AR[t], inter = AR[256 + t], emt = AR[384 + t];
    float rs = 0.f;
#pragma unroll
    for (int ni = 0; ni < 8; ++ni) { const f32x4 cc = *(const LAS f32x4*)(AR + 128 + 16 * ni + 4 * fq);
#pragma unroll
        for (int r = 0; r < 4; ++r) { const int s = 16 * ni + 4 * fq + r; const float wgt = (s <= t) ? __expf(rc + cc[r]) : 0.f; const float v = st[ni][r] * wgt; st[ni][r] = v; rs += v; } }
    rs += __shfl_xor(rs, 16); rs += __shfl_xor(rs, 32);
    const float den = rs + inter * qn, inv = 1.0f / fmaxf(fabsf(den), emt);
    __syncthreads();
#pragma unroll
    for (int ni = 0; ni < 8; ++ni) { v2u o; o.x = cvtpk(st[ni][0], st[ni][1]); o.y = cvtpk(st[ni][2], st[ni][3]); *(LAS v2u*)(KL + t * LP + 16 * ni + 4 * fq) = o; }
    const bf16* MV = (const bf16*)(ws + WS_MV); const bf16* CP = (const bf16*)(ws + WS_CPREV) + (size_t)u * 32768;
    f32x4 hv[2][8];
#pragma unroll
    for (int hf = 0; hf < 2; ++hf) {
#pragma unroll
        for (int i = 0; i < 2; ++i) { const int e0 = 8 * (2 * wave + i); stage_vt_chunk(MV, t0, h * 256 + 128 * hf + e0, VTH, e0, lane); }
#pragma unroll
        for (int it = 0; it < 4; ++it) { const int q = it * 512 + tid, e = q >> 4, d0 = (q & 15) * 8;
            *(LAS v4u*)(CTH + e * LP + d0) = *(const v4u*)(CP + (size_t)(128 * hf + e) * 128 + d0); }
        __syncthreads();
        f32x4 a1[8], a2[8];
#pragma unroll
        for (int ni = 0; ni < 8; ++ni) { a1[ni] = (f32x4){0.f, 0.f, 0.f, 0.f}; a2[ni] = (f32x4){0.f, 0.f, 0.f, 0.f}; }
#pragma unroll
        for (int ks = 0; ks < 4; ++ks) {
            const bf16x8 sf = *(const LAS bf16x8*)(KL + t * LP + 32 * ks + 8 * fq);
#pragma unroll
            for (int ni = 0; ni < 8; ++ni) { const bf16x8 vf = *(const LAS bf16x8*)(VTH + (16 * ni + fr) * LP + 32 * ks + 8 * fq); a1[ni] = MFMA16(vf, sf, a1[ni]);
                const bf16x8 cf = *(const LAS bf16x8*)(CTH + (16 * ni + fr) * LP + 32 * ks + 8 * fq); a2[ni] = MFMA16(cf, qf[ks], a2[ni]); }
        }
#pragma unroll
        for (int ni = 0; ni < 8; ++ni) hv[hf][ni] = (a1[ni] + a2[ni] * inter) * inv;
        __syncthreads();
    }
    const bf16* MO = (const bf16*)(ws + WS_MO) + (size_t)(t0 + t) * 1024 + h * 256;
    float ss = 0.f;
#pragma unroll
    for (int hf = 0; hf < 2; ++hf)
#pragma unroll
        for (int ni = 0; ni < 8; ++ni) { const v2u g = *(const v2u*)(MO + 128 * hf + 16 * ni + 4 * fq);
            const float g0 = bflo(g.x), g1 = bfhi(g.x), g2 = bflo(g.y), g3 = bfhi(g.y);
            f32x4 v = hv[hf][ni]; v[0] *= 1.f / (1.f + __expf(-g0)); v[1] *= 1.f / (1.f + __expf(-g1)); v[2] *= 1.f / (1.f + __expf(-g2)); v[3] *= 1.f / (1.f + __expf(-g3));
            hv[hf][ni] = v; ss += (v[0] * v[0] + v[1] * v[1]) + (v[2] * v[2] + v[3] * v[3]); }
    ss += __shfl_xor(ss, 16); ss += __shfl_xor(ss, 32);
    const float rn = __builtin_amdgcn_rsqf(ss * (1.f / 256.f) + NORM_EPS);
    bf16* MX = (bf16*)(ws + WS_MIXED) + (size_t)(t0 + t) * DM + 1024 + h * 256;
#pragma unroll
    for (int hf = 0; hf < 2; ++hf)
#pragma unroll
        for (int ni = 0; ni < 8; ++ni) { const int e = 128 * hf + 16 * ni + 4 * fq; const f32x4 w = *(const f32x4*)(a->ml_nw + h * 256 + e); const f32x4 v = hv[hf][ni];
            v2u o; o.x = cvtpk(v[0] * rn * w[0], v[1] * rn * w[1]); o.y = cvtpk(v[2] * rn * w[2], v[3] * rn * w[3]); *(v2u*)(MX + e) = o; }
}
__device__ __forceinline__ int sord(float f) { const int b = __float_as_int(f); return b ^ ((b >> 31) & 0x7fffffff); }
__device__ __forceinline__ float sdec(int v) { return __int_as_float(v ^ ((v >> 31) & 0x7fffffff)); }
#define PEER_INS(L, xin) do { int x_ = (xin); _Pragma("unroll") for (int i_ = 0; i_ < 16; ++i_) { const int hi_ = max(L[i_], x_); x_ = min(L[i_], x_); L[i_] = hi_; } } while (0)
__device__ __forceinline__ float gelu_erf(float v) { return 0.5f * v * (1.f + erff(v * 0.70710678118654752f)); }

__device__ __forceinline__ void peer_select(KA a, int t0, int lane, int wave) {
    const bf16* PQ = (const bf16*)(a->ws + WS_PQ); const bf16* KEYS = (const bf16*)(a->ws + WS_KEYS);
    const int c = lane & 31, hh = lane >> 5;
    int AB[2][16];
#pragma unroll
    for (int p = 0; p < 2; ++p) {
        bf16x8 qf[8];
#pragma unroll
        for (int ks = 0; ks < 8; ++ks) qf[ks] = *(const bf16x8*)(PQ + (size_t)(t0 + c) * DM + wave * 256 + p * 128 + 16 * ks + 8 * hh);
        int L[16];
#pragma unroll
        for (int i = 0; i < 16; ++i) L[i] = (int)0x80000000;
#pragma unroll 1
        for (int nt = 0; nt < 4; ++nt) {
            f32x16 acc;
#pragma unroll
            for (int r = 0; r < 16; ++r) acc[r] = 0.f;
#pragma unroll
            for (int ks = 0; ks < 8; ++ks) { const bf16x8 kf = *(const bf16x8*)(KEYS + (size_t)(p * 128 + 32 * nt + c) * 128 + 16 * ks + 8 * hh); acc = MFMA32(kf, qf[ks], acc); }
#pragma unroll
            for (int r = 0; r < 16; ++r) { const int n = 32 * nt + (r & 3) + 8 * (r >> 2); const int key = (sord(acc[r]) & ~127) | n | (4 * hh); PEER_INS(L, key); }
        }
        int M[16];
#pragma unroll
        for (int i = 0; i < 16; ++i) { const int o = __shfl_xor(L[15 - i], 32); M[i] = max(L[i], o); }
#pragma unroll
        for (int dist = 8; dist >= 1; dist >>= 1)
#pragma unroll
            for (int i = 0; i < 16; ++i) if ((i & dist) == 0) { const int hi_ = max(M[i], M[i + dist]), lo_ = min(M[i], M[i + dist]); M[i] = hi_; M[i + dist] = lo_; }
#pragma unroll
        for (int i = 0; i < 16; ++i) AB[p][i] = M[i];
    }
    float va[16], vb[16];
#pragma unroll
    for (int i = 0; i < 16; ++i) { va[i] = sdec(AB[0][i] & ~127); vb[i] = sdec(AB[1][i] & ~127); }
    int L[16];
#pragma unroll
    for (int j = 0; j < 16; ++j) L[j] = (sord(va[0] + vb[j]) & ~255) | j;
#pragma unroll
    for (int i = 1; i < 16; ++i)
#pragma unroll
        for (int j = 0; j < 16; ++j) if ((i + 1) * (j + 1) <= 16) { const int key = (sord(va[i] + vb[j]) & ~255) | (i * 16 + j); PEER_INS(L, key); }
    float sv[16]; float mx = -__builtin_inff();
#pragma unroll
    for (int k = 0; k < 16; ++k) { sv[k] = sdec(L[k] & ~255); mx = fmaxf(mx, sv[k]); }
    float den = 0.f;
#pragma unroll
    for (int k = 0; k < 16; ++k) { sv[k] = __expf(sv[k] - mx); den += sv[k]; }
    const float rden = 1.f / den;
    int* PEI = (int*)(a->ws + WS_PEI) + (size_t)(t0 + c) * 128 + wave * 16; float* PEG = (float*)(a->ws + WS_PEG) + (size_t)(t0 + c) * 128 + wave * 16;
    int ev[16];
#pragma unroll
    for (int k = 0; k < 16; ++k) {
        const int id = L[k] & 255, ii = id >> 4, jj = id & 15;
        int ka = 0, kb = 0;
#pragma unroll
        for (int i = 0; i < 16; ++i) { ka = (ii == i) ? AB[0][i] : ka; kb = (jj == i) ? AB[1][i] : kb; }
        ev[k] = (ka & 127) * 128 + (kb & 127);
    }
    if (hh == 0) {
#pragma unroll
        for (int k = 0; k < 16; k += 4) *(v4u*)(PEI + k) = (v4u){(unsigned)ev[k], (unsigned)ev[k + 1], (unsigned)ev[k + 2], (unsigned)ev[k + 3]};
    } else {
#pragma unroll
        for (int k = 0; k < 16; k += 4) *(f32x4*)(PEG + k) = (f32x4){sv[k] * rden, sv[k + 1] * rden, sv[k + 2] * rden, sv[k + 3] * rden};
    }
}
__device__ __forceinline__ void peer_gather_token(KA a, size_t tok, int lane) {
    const bf16* XN = (const bf16*)(a->ws + WS_H); const unsigned char* U8 = a->ws + WS_UB; const unsigned char* V8 = a->ws + WS_VB;
    const float* MSM = (const float*)(a->ws + WS_MSM);
    float xr[32];
#pragma unroll
    for (int j = 0; j < 2; ++j) { const v4u p0 = *(const v4u*)(XN + tok * DM + 1024 * j + 16 * lane), p1 = *(const v4u*)(XN + tok * DM + 1024 * j + 16 * lane + 8);
#pragma unroll
        for (int w = 0; w < 4; ++w) { xr[16 * j + 2 * w] = bflo(p0[w]); xr[16 * j + 2 * w + 1] = bfhi(p0[w]); xr[16 * j + 8 + 2 * w] = bflo(p1[w]); xr[16 * j + 8 + 2 * w + 1] = bfhi(p1[w]); } }
    const v2u ei = *(const v2u*)((const int*)(a->ws + WS_PEI) + tok * 128 + 2 * lane);
    const f32x2 gi = *(const f32x2*)((const float*)(a->ws + WS_PEG) + tok * 128 + 2 * lane);
    float y[32];
#pragma unroll
    for (int i = 0; i < 32; ++i) y[i] = 0.f;
    for (int k0 = 0; k0 < 128; k0 += 4) {
        int e[4]; float g[4];
#pragma unroll
        for (int q = 0; q < 4; ++q) { const int src = (k0 + q) >> 1;
            e[q] = __builtin_amdgcn_readlane((q & 1) ? (int)ei.y : (int)ei.x, src); g[q] = __int_as_float(__builtin_amdgcn_readlane(__float_as_int((q & 1) ? gi.y : gi.x), src)); }
        v4u ur[4][2], vr[4][2];
#pragma unroll
        for (int q = 0; q < 4; ++q)
#pragma unroll
            for (int j = 0; j < 2; ++j) ur[q][j] = *(const v4u*)(U8 + (size_t)e[q] * DM + 1024 * j + 16 * lane);
#pragma unroll
        for (int q = 0; q < 4; ++q)
#pragma unroll
            for (int j = 0; j < 2; ++j) vr[q][j] = *(const v4u*)(V8 + (size_t)e[q] * DM + 1024 * j + 16 * lane);
        float act[4];
#pragma unroll
        for (int q = 0; q < 4; ++q) { float d = 0.f;
#pragma unroll
            for (int j = 0; j < 2; ++j)
#pragma unroll
                for (int w = 0; w < 4; ++w) { const f32x2 lo = __builtin_amdgcn_cvt_pk_f32_fp8((int)ur[q][j][w], false), hi = __builtin_amdgcn_cvt_pk_f32_fp8((int)ur[q][j][w], true);
                    d += lo.x * xr[16 * j + 4 * w] + lo.y * xr[16 * j + 4 * w + 1] + hi.x * xr[16 * j + 4 * w + 2] + hi.y * xr[16 * j + 4 * w + 3]; }
            d = wave_sum(d) * MSM[MS_USC + e[q]]; act[q] = gelu_erf(d) * g[q] * MSM[MS_VSC + e[q]]; }
#pragma unroll
        for (int q = 0; q < 4; ++q)
#pragma unroll
            for (int j = 0; j < 2; ++j)
#pragma unroll
                for (int w = 0; w < 4; ++w) { const f32x2 lo = __builtin_amdgcn_cvt_pk_f32_fp8((int)vr[q][j][w], false), hi = __builtin_amdgcn_cvt_pk_f32_fp8((int)vr[q][j][w], true);
                    y[16 * j + 4 * w] += act[q] * lo.x; y[16 * j + 4 * w + 1] += act[q] * lo.y; y[16 * j + 4 * w + 2] += act[q] * hi.x; y[16 * j + 4 * w + 3] += act[q] * hi.y; }
    }
    float* orow = a->out + tok * DM; float ss = 0.f;
#pragma unroll
    for (int j = 0; j < 2; ++j)
#pragma unroll
        for (int i = 0; i < 4; ++i) { const f32x4 x0 = *(const f32x4*)(orow + 1024 * j + 16 * lane + 4 * i);
            y[16 * j + 4 * i] += x0.x; y[16 * j + 4 * i + 1] += x0.y; y[16 * j + 4 * i + 2] += x0.z; y[16 * j + 4 * i + 3] += x0.w; }
#pragma unroll
    for (int i = 0; i < 32; ++i) ss += y[i] * y[i];
    const float rn = __builtin_amdgcn_rsqf(wave_sum(ss) * (1.f / DM) + NORM_EPS);
#pragma unroll
    for (int j = 0; j < 2; ++j)
#pragma unroll
        for (int i = 0; i < 4; ++i) { const f32x4 w0 = *(const f32x4*)(a->final_w + 1024 * j + 16 * lane + 4 * i);
            *(f32x4*)(orow + 1024 * j + 16 * lane + 4 * i) = (f32x4){y[16 * j + 4 * i] * rn * w0.x, y[16 * j + 4 * i + 1] * rn * w0.y, y[16 * j + 4 * i + 2] * rn * w0.z, y[16 * j + 4 * i + 3] * rn * w0.w}; }
}

__global__ void __launch_bounds__(NTHR, 2) fwd_kernel(Args args) {
    extern __shared__ __attribute__((aligned(16))) unsigned char lds_raw[];
    LAS unsigned char* lds = (LAS unsigned char*)lds_raw;
    volatile LAS unsigned* MISC = (volatile LAS unsigned*)(lds + MISC_OFF);
    const int wave = __builtin_amdgcn_readfirstlane((int)threadIdx.x >> 6) & 7;
#define TIDS() const int lane = mk_lane_id(), tid = wave * 64 + lane
    const int tid0 = wave * 64 + mk_lane_id();
    const int G = gridDim.x; const int bx = blockIdx.x; const int vcu = (G % 8 == 0) ? (bx % 8) * (G / 8) + bx / 8 : bx;
    KA ka = (KA)__builtin_amdgcn_kernarg_segment_ptr();
#define KARGS(name) KA name = ka; asm volatile("" : "+s"(name))
    gu32* ctl; { KARGS(a_); ctl = (gu32*)(a_->ws + WS_CTL); }
    if (tid0 < 64) MISC[tid0] = 0u;
    __syncthreads();
    XcdBarrier bar = xcd_barrier_post((unsigned*)ctl + CW_BAR + args.li * XCD_BAR_WORDS, MISC + 8, tid0);
    const int lo = args.ph_lo, hi = args.ph_hi;
#ifndef PH_MASK
#define PH_MASK 0x3ff
#endif
#define IN(k) (((PH_MASK >> (k)) & 1) && lo <= (k) && (k) < hi)
#define BOTH(k) (IN(k) && IN((k) + 1))
#define GRID_BAR() xcd_barrier(bar, wave * 64 + mk_lane_id())

    if (IN(0)) { KARGS(a_); TIDS(); p0_prologue(a_, lds, tid, lane, wave, vcu, G); if (BOTH(0)) GRID_BAR(); }

    if (IN(1)) {
        KARGS(a_); unsigned char* ws = a_->ws;
        pg8::Gemm g{(const pg8::bf16_t*)(ws + WS_H), (const pg8::bf16_t*)(ws + WS_WINT), T, NZ, DM}; pg8::StaticOrder S; S.init(T, NZ, G, bx);
        static_assert(WS_FK - WS_FQ == (1u << 26) && WS_FV - WS_FK == (1u << 26) && WS_MK - WS_MQ == (1u << 25) && WS_MO - WS_MV == (1u << 26), "EpiZ strides");
        pg8::EpiZ E{ws, WS_FQ, WS_MQ, WS_MV, WS_GATES};
        pg8::gemm_phase<pg8::EpiZ, pg8::StaticOrder, true, true>(lds, g, S, E, wave);
        if (BOTH(1)) GRID_BAR();
    }

    if (IN(2)) {
        KARGS(a_); TIDS();
        for (int s = bx; s < 16; s += G) fox_cumsum(a_, lds, s, tid, lane, wave);
        for (int w = bx; w < 256; w += G) fox_qk_norm_max(a_, w & 31, w >> 5, lane, wave);
        for (int u = vcu; u < 8 * NCH; u += G) mlstm_a_unit(a_, lds, u, tid, lane, wave);
        if (BOTH(2)) GRID_BAR();
    }

    if (IN(3)) { KARGS(a_); TIDS(); { const int gid = bx * NTHR + tid; if (gid < 1024) fox_jlo(a_, gid); } mlstm_scan(a_, vcu, G, tid); if (BOTH(3)) GRID_BAR(); }

    if (IN(4)) {
        KARGS(a_); unsigned char* ws = a_->ws;
        const int tid = wave * 64 + mk_lane_id();
        unsigned* qhead = (unsigned*)(ws + WS_CTL) + CW_QUEUE;
        if (tid == 0) { MISC[16] = __hip_atomic_fetch_add(qhead, 1u, RLX_AGENT); MISC[17] = __hip_atomic_fetch_add(qhead, 1u, RLX_AGENT); }
        __syncthreads();
        int i_cur = __builtin_amdgcn_readfirstlane((int)MISC[16]), i_nxt = __builtin_amdgcn_readfirstlane((int)MISC[17]);
        __syncthreads();
#ifndef NO_ATT
        if (i_cur < 1024) {
            using namespace fox;
            typedef __hip_bfloat16 hb;
            static_assert(WS_FK - WS_FQ == (size_t)2 << 25 && WS_FV - WS_FK == (size_t)2 << 25, "q | k | v are 2^25 bf16 elements apart (BlockRef::Qp / Vp)");
            const hb* K = (const hb*)(ws + WS_FK); hb* O = (hb*)(ws + WS_MIXED);
            const FoxBases fb{(const float*)(ws + WS_FCUM), a_->fox_nw}; const int* JLO = (const int*)(ws + WS_MSM) + MS_JLO;
#define FOX_REF(r, it) do { const int h_ = 7 - ((it) >> 7), b_ = (it) & 1, qb_ = 63 - (((it) & 127) >> 1), bh_ = b_ * 8 + h_;                               \
                (r).K = K + (size_t)bh_ * SEQ * 128; (r).O = O + ((size_t)b_ * SEQ + (size_t)qb_ * QB) * DM + h_ * 128; (r).P0 = qb_ * QB; (r).jlo = JLO[bh_ * 64 + qb_]; (r).bh = bh_; } while (0)
            BlockRef<hb, hb> cur; FOX_REF(cur, i_cur);
            Seam<hb> Sm;
            causal_swa_prime<hb, hb>(cur, fb, SEQ, (char*)lds_raw, Sm, wave);
            for (int par = 0;; par ^= 1) {
                if (tid == 0) MISC[18 + par] = __hip_atomic_fetch_add(qhead, 1u, RLX_AGENT);
                const bool nxt_att = i_nxt < 1024;
                BlockRef<hb, hb> nxt; if (nxt_att) FOX_REF(nxt, i_nxt); else nxt = cur;
                causal_swa_block<hb, hb>(cur, nxt, fb, SEQ, SEQ, (char*)lds_raw, Sm, wave);
                const int i_n2 = __builtin_amdgcn_readfirstlane((int)MISC[18 + par]);
                i_cur = i_nxt; i_nxt = i_n2;
                if (!nxt_att) break;
                cur = nxt;
            }
#undef FOX_REF
        }
#endif
        VM_WAIT(); __syncthreads();
#ifndef NO_MLC
        for (int par = 0; i_cur < 2048; par ^= 1) {
            const int lane = mk_lane_id(), tid = wave * 64 + lane;
            if (tid == 0) MISC[20 + par] = __hip_atomic_fetch_add(qhead, 1u, RLX_AGENT);
            mlstm_c_unit(a_, lds, i_cur - 1024, tid, lane, wave);
            __syncthreads();
            i_cur = i_nxt; i_nxt = __builtin_amdgcn_readfirstlane((int)MISC[20 + par]);
        }
#endif
        if (BOTH(4)) GRID_BAR();
    }

    if (IN(5)) {
        KARGS(a_); unsigned char* ws = a_->ws;
        pg8::Gemm g{(const pg8::bf16_t*)(ws + WS_MIXED), (const pg8::bf16_t*)(ws + WS_WOUTT), T, DM, DM}; pg8::StaticOrder S; S.init(T, DM, G, bx);
        pg8::EpiRes E{a_->x, a_->out, DM};
        pg8::gemm_phase<pg8::EpiRes, pg8::StaticOrder, true, true>(lds, g, S, E, wave);
        if (BOTH(5)) GRID_BAR();
    }

    if (IN(6)) { KARGS(a_); TIDS(); (void)tid; rms_phase(a_->out, a_->norm2_w, (bf16*)(a_->ws + WS_H), vcu * NWAVES + wave, G * NWAVES, lane); if (BOTH(6)) GRID_BAR(); }

    if (IN(7)) {
        KARGS(a_); unsigned char* ws = a_->ws;
        pg8::Gemm g{(const pg8::bf16_t*)(ws + WS_H), (const pg8::bf16_t*)(ws + WS_WQT), T, DM, DM}; pg8::StaticOrder S; S.init(T, DM, G, bx);
        pg8::EpiBf16<0> E{(pg8::bf16_t*)(ws + WS_PQ), DM, nullptr, 0, 0, 1.f};
        pg8::gemm_phase<pg8::EpiBf16<0>, pg8::StaticOrder, true, true>(lds, g, S, E, wave);
        if (BOTH(7)) GRID_BAR();
    }

    if (IN(8)) {
        KARGS(a_); TIDS(); (void)tid;
        for (int tile = vcu; tile < T / 32; tile += G) peer_select(a_, tile * 32, lane, wave);
        if (BOTH(8)) GRID_BAR();
    }

    if (IN(9)) {
        KARGS(a_); TIDS(); (void)tid;
        for (int tok = vcu * NWAVES + wave; tok < T; tok += G * NWAVES) peer_gather_token(a_, (size_t)tok, lane);
    }
#undef IN
#undef BOTH
#undef GRID_BAR
}

extern "C" void kernel_launch(void* const* d_in, const int* in_sizes, int n_in, void* d_out, int out_size, void* d_ws, size_t ws_size, hipStream_t stream) {
    static int grid = 0;
    constexpr int NPH = 10;
    if (grid == 0) {
        if (n_in != 17 || in_sizes[0] != T * DM || out_size != T * DM || ws_size < WS_END) { fprintf(stderr, "kernel_launch: shape/workspace mismatch (n_in %d, in0 %d, out %d, ws %zu)\n", n_in, n_in > 0 ? in_sizes[0] : -1, out_size, ws_size); grid = -1; return; }
        int dev = 0, cus = 0, per_cu = 0;
        if (hipGetDevice(&dev) != hipSuccess || hipDeviceGetAttribute(&cus, hipDeviceAttributeMultiprocessorCount, dev) != hipSuccess) { grid = -1; return; }
        if (hipFuncSetAttribute((const void*)fwd_kernel, hipFuncAttributeMaxDynamicSharedMemorySize, LDS_BYTES) != hipSuccess) { fprintf(stderr, "kernel_launch: hipFuncSetAttribute failed\n"); grid = -1; return; }
        if (hipOccupancyMaxActiveBlocksPerMultiprocessor(&per_cu, (const void*)fwd_kernel, NTHR, LDS_BYTES) != hipSuccess || per_cu < 1) { fprintf(stderr, "kernel_launch: occupancy query says %d blocks per CU\n", per_cu); (void)hipGetLastError(); grid = -1; return; }
        grid = cus;
    }
    if (grid < 0) return;
    if (hipMemsetAsync((char*)d_ws + WS_CTL, 0, CTL_ZERO_BYTES, stream) != hipSuccess) return;
    Args a{};
    a.x = (const float*)d_in[0]; a.norm1_w = (const float*)d_in[1]; a.w_in = (const float*)d_in[2]; a.fox_f_bias = (const float*)d_in[3];
    a.conv_w = (const float*)d_in[4]; a.conv_b = (const float*)d_in[5]; a.i_bias = (const float*)d_in[6]; a.f_bias = (const float*)d_in[7];
    a.fox_nw = (const float*)d_in[8]; a.ml_nw = (const float*)d_in[9]; a.w_out = (const float*)d_in[10]; a.norm2_w = (const float*)d_in[11];
    a.w_q = (const float*)d_in[12]; a.keys = (const float*)d_in[13]; a.pu = (const float*)d_in[14]; a.pv = (const float*)d_in[15]; a.final_w = (const float*)d_in[16];
    a.out = (float*)d_out; a.ws = (unsigned char*)d_ws;
#if MK_N_LAUNCHES == 1
    a.ph_lo = 0; a.ph_hi = NPH; a.li = 0; a.pad = 0;
    hipLaunchKernelGGL(fwd_kernel, dim3(grid), dim3(NTHR), LDS_BYTES, stream, a);
#else
    for (int p = 0; p < NPH; ++p) { a.ph_lo = p; a.ph_hi = p + 1; a.li = 0; a.pad = 0; hipLaunchKernelGGL(fwd_kernel, dim3(grid), dim3(NTHR), LDS_BYTES, stream, a); }
#endif
}
```

```cpp
#include <hip/hip_runtime.h>
#include <hip/hip_bf16.h>
#include <cstdio>
#include <cstdint>
__device__ __forceinline__ int mk_lane_id() { unsigned l_; asm volatile("v_mbcnt_lo_u32_b32 %0, -1, 0\n\tv_mbcnt_hi_u32_b32 %0, -1, %0" : "=v"(l_)); return (int)(l_ & 63u); }
namespace pg8 {
#define PG8_LAS __attribute__((address_space(3)))
typedef unsigned short bf16_t;
typedef short bf16x8 __attribute__((ext_vector_type(8)));
typedef float f32x4 __attribute__((ext_vector_type(4)));
typedef unsigned u32x4 __attribute__((ext_vector_type(4)));
constexpr int BM = 256, BK = 64, HALF = 128, HTB = HALF * BK * 2  , STAGE_BYTES = 8 * HTB, NXCD = 8, WGM = 8;

__host__ __device__ __forceinline__ int lds_byte(int r, int c) { const int st = (r >> 4) * 2 + (c >> 5), rr = r & 15, cc = c & 31, ob = rr * 64 + cc * 2; return st * 1024 + (ob ^ (((ob >> 9) & 1) << 5)); }
__host__ __device__ __forceinline__ void stage_rc(int b, int& R, int& C) { const int st = b / 1024, sb = b % 1024, swz = sb ^ (((sb >> 9) & 1) << 5); R = (st >> 1) * 16 + swz / 64; C = (st & 1) * 32 + (swz % 64) / 2; }
__host__ __device__ __forceinline__ int perm32(int rho) { const int n = rho >> 4, i = rho & 15; return 8 * (i >> 2) + 4 * n + (i & 3); }

struct Unit { int pm, pn; };
struct Gemm { const bf16_t* A; const bf16_t* Bt; int M, N, K; };

struct StaticOrder {
    int nM, nN, nwg, G, c;
    __host__ __device__ void init(int M, int N, int G_, int c_) { nM = M / BM; nN = N / BM; nwg = nM * nN; G = G_; c = c_; }
    __host__ __device__ bool next(int i, Unit& u) const {
        const long L = (long)i * G + c; if (L >= nwg) return false;
        int wgid = (int)L; { const int q = nwg / NXCD, r = nwg % NXCD, xcd = wgid % NXCD, off = wgid / NXCD; wgid = (xcd < r ? xcd * (q + 1) : r * (q + 1) + (xcd - r) * q) + off; }
        const int nig = WGM * nN, gid = wgid / nig, fm = gid * WGM, gsz = (nM - fm) < WGM ? (nM - fm) : WGM;
        u.pm = fm + ((wgid % nig) % gsz); u.pn = (wgid % nig) / gsz; return true;
    }
    __device__ __forceinline__ void a_ready(const Unit&) const {}
    __device__ __forceinline__ void done(const Unit&) const {}
};

__device__ __forceinline__ unsigned cvt_pk_bf16(float lo, float hi) { unsigned r; asm volatile("v_cvt_pk_bf16_f32 %0, %1, %2" : "=v"(r) : "v"(lo), "v"(hi)); return r; }
typedef float f32x2 __attribute__((ext_vector_type(2)));
__device__ __forceinline__ f32x2 gelu_pk(f32x2 v) {
    const f32x2 av = __builtin_elementwise_abs(v), d = av * 0.2316418882f + 1.0f;
    f32x2 t; t.x = __builtin_amdgcn_rcpf(d.x); t.y = __builtin_amdgcn_rcpf(d.y);
    f32x2 q = t * 0.5307027145f + (-0.7265760135f); q = q * t + 0.7107068705f; q = q * t + (-0.142248368f); q = q * t + 0.127414796f; q = q * t;
    const f32x2 s = (v * v) * (-0.72134752044f);
    f32x2 e; e.x = __builtin_amdgcn_exp2f(s.x); e.y = __builtin_amdgcn_exp2f(s.y);
    const f32x2 m = v * (q * e), r = v - m;
    f32x2 o; o.x = v.x < 0.f ? m.x : r.x; o.y = v.y < 0.f ? m.y : r.y; return o;
}

template <int ACT  > struct EpiBf16 {
    static constexpr bool PERM = true, AFTER_DRAIN = false; static_assert(ACT == 0 || ACT == 1, "EpiBf16: ACT is 0 (none) or 1 (gelu_pk)");
    bf16_t* O; int ldc; const float* bias; int split_cols; size_t split_stride; float scale0;
    __device__ __forceinline__ void operator()(const f32x4 (&acc)[2][2][4][2], const Unit& u, int wr, int wc, int fr, int fq) const {
        const int row0 = u.pm * BM + wr * 64 + fr; int colt = u.pn * BM; bf16_t* base = O;
        float sc = 1.f; if (split_cols) { const int t = colt / split_cols; base += (size_t)t * split_stride; colt -= t * split_cols; if (t == 0) sc = scale0; }
        const int col0 = colt + wc * 32 + 8 * fq, bcol0 = u.pn * BM + wc * 32 + 8 * fq;
        f32x4 bv[2][2];
#pragma unroll
        for (int bj = 0; bj < 2; ++bj)
#pragma unroll
            for (int n = 0; n < 2; ++n) bv[bj][n] = bias ? *(const f32x4*)(bias + bcol0 + bj * HALF + 4 * n) : (f32x4){0.f, 0.f, 0.f, 0.f};
#pragma unroll
        for (int ai = 0; ai < 2; ++ai)
#pragma unroll
            for (int m = 0; m < 4; ++m) { bf16_t* rowp = base + (size_t)(row0 + ai * HALF + m * 16) * ldc + col0;
#pragma unroll
                for (int bj = 0; bj < 2; ++bj) { f32x4 v0 = acc[ai][bj][m][0] + bv[bj][0], v1 = acc[ai][bj][m][1] + bv[bj][1];
                    if (ACT == 1) { f32x2 a = gelu_pk((f32x2){v0[0], v0[1]}), b = gelu_pk((f32x2){v0[2], v0[3]}), c = gelu_pk((f32x2){v1[0], v1[1]}), d = gelu_pk((f32x2){v1[2], v1[3]});
                        v0 = (f32x4){a.x, a.y, b.x, b.y}; v1 = (f32x4){c.x, c.y, d.x, d.y}; }
                    v0 = v0 * sc; v1 = v1 * sc; u32x4 w; w.x = cvt_pk_bf16(v0[0], v0[1]); w.y = cvt_pk_bf16(v0[2], v0[3]); w.z = cvt_pk_bf16(v1[0], v1[1]); w.w = cvt_pk_bf16(v1[2], v1[3]);
                    *(u32x4*)(rowp + bj * HALF) = w; } }
    }
};

struct EpiZ {
    static constexpr bool PERM = true, AFTER_DRAIN = false;
    unsigned char* ws; size_t off_fq, off_mq, off_mv, off_gates;
    __device__ __forceinline__ void operator()(const f32x4 (&acc)[2][2][4][2], const Unit& u, int wr, int wc, int fr, int fq) const {
        const int pn = u.pn, row0 = u.pm * BM + wr * 64 + fr;
        if (pn < 12) {
            bf16_t* base = (bf16_t*)(ws + off_fq + ((size_t)(pn >> 2) << 26)); const int hp = (pn & 3) * 2, d = wc * 32 + 8 * fq;
#pragma unroll
            for (int ai = 0; ai < 2; ++ai)
#pragma unroll
                for (int m = 0; m < 4; ++m) { const int row = row0 + ai * HALF + m * 16, b = row >> 14, s = row & 16383;
#pragma unroll
                    for (int bj = 0; bj < 2; ++bj) { const f32x4 v0 = acc[ai][bj][m][0], v1 = acc[ai][bj][m][1];
                        u32x4 w; w.x = cvt_pk_bf16(v0[0], v0[1]); w.y = cvt_pk_bf16(v0[2], v0[3]); w.z = cvt_pk_bf16(v1[0], v1[1]); w.w = cvt_pk_bf16(v1[2], v1[3]);
                        *(u32x4*)(base + ((size_t)(b * 8 + hp + bj) * 16384 + s) * 128 + d) = w; } }
        } else if (pn < 24) {
            const bool isqk = pn < 16;
            const size_t boff = isqk ? off_mq + ((size_t)((pn - 12) >> 1) << 25) : off_mv + ((size_t)((pn - 16) >> 2) << 26);
            bf16_t* base = (bf16_t*)(ws + boff); const int ld = isqk ? 512 : 1024, cb = isqk ? ((pn - 12) & 1) * 256 : ((pn - 16) & 3) * 256;
            const int col0 = cb + wc * 32 + 8 * fq;
#pragma unroll
            for (int ai = 0; ai < 2; ++ai)
#pragma unroll
                for (int m = 0; m < 4; ++m) { bf16_t* rowp = base + (size_t)(row0 + ai * HALF + m * 16) * ld + col0;
#pragma unroll
                    for (int bj = 0; bj < 2; ++bj) { const f32x4 v0 = acc[ai][bj][m][0], v1 = acc[ai][bj][m][1];
                        u32x4 w; w.x = cvt_pk_bf16(v0[0], v0[1]); w.y = cvt_pk_bf16(v0[2], v0[3]); w.z = cvt_pk_bf16(v1[0], v1[1]); w.w = cvt_pk_bf16(v1[2], v1[3]);
                        *(u32x4*)(rowp + bj * HALF) = w; } }
        } else {
            if (wc == 0 && fq < 2) {
#pragma unroll
                for (int ai = 0; ai < 2; ++ai)
#pragma unroll
                    for (int m = 0; m < 4; ++m) { float* rowp = (float*)(ws + off_gates) + (size_t)(row0 + ai * HALF + m * 16) * 16 + 8 * fq;
                        *(f32x4*)rowp = acc[ai][0][m][0]; *(f32x4*)(rowp + 4) = acc[ai][0][m][1]; }
            }
        }
    }
};
struct EpiRes {
    static constexpr bool PERM = true, AFTER_DRAIN = false;
    const float* res; float* O; int ldc; const float* w2; bf16_t* XW; float* SSQP;
    __device__ __forceinline__ void operator()(const f32x4 (&acc)[2][2][4][2], const Unit& u, int wr, int wc, int fr, int fq) const {
        const int row0 = u.pm * BM + wr * 64 + fr, col0 = u.pn * BM + wc * 32 + 8 * fq;
        f32x4 wv[2][2];
#pragma unroll
        for (int bj = 0; bj < 2; ++bj) { wv[bj][0] = *(const f32x4*)(w2 + col0 + bj * HALF); wv[bj][1] = *(const f32x4*)(w2 + col0 + bj * HALF + 4); }
#pragma unroll
        for (int ai = 0; ai < 2; ++ai)
#pragma unroll
            for (int m = 0; m < 4; ++m) { const int row = row0 + ai * HALF + m * 16; const size_t off = (size_t)row * ldc + col0; float ss = 0.f;
#pragma unroll
                for (int bj = 0; bj < 2; ++bj) { const f32x4 r0 = __builtin_nontemporal_load((const f32x4*)(res + off + bj * HALF)), r1 = __builtin_nontemporal_load((const f32x4*)(res + off + bj * HALF + 4));
                    const f32x4 v0 = acc[ai][bj][m][0] + r0, v1 = acc[ai][bj][m][1] + r1;
                    __builtin_nontemporal_store(v0, (f32x4*)(O + off + bj * HALF)); __builtin_nontemporal_store(v1, (f32x4*)(O + off + bj * HALF + 4));
                    ss += (v0[0] * v0[0] + v0[1] * v0[1]) + (v0[2] * v0[2] + v0[3] * v0[3]) + (v1[0] * v1[0] + v1[1] * v1[1]) + (v1[2] * v1[2] + v1[3] * v1[3]);
                    const f32x4 x0 = v0 * wv[bj][0], x1 = v1 * wv[bj][1];
                    u32x4 w; w.x = cvt_pk_bf16(x0[0], x0[1]); w.y = cvt_pk_bf16(x0[2], x0[3]); w.z = cvt_pk_bf16(x1[0], x1[1]); w.w = cvt_pk_bf16(x1[2], x1[3]);
                    *(u32x4*)(XW + off + bj * HALF) = w; }
                ss += __shfl_xor(ss, 16); ss += __shfl_xor(ss, 32);
                if (fq == 0) SSQP[(size_t)row * 32 + u.pn * 4 + wc] = ss; }
    }
};
template <class Epi, class Sched, bool ALIGN_EPI = false, bool SP2 = false>
__device__ __forceinline__ void gemm_phase(PG8_LAS unsigned char* lds, const Gemm g, const Sched& S, const Epi& E, const int wid_in) {
    const int wid = wid_in, lane = mk_lane_id(), tid = wid * 64 + lane, wr = wid >> 2, wc = wid & 3, fr = lane & 15, fq = lane >> 4;
    const int K = g.K, nt = K / BK;
    unsigned voffA[2], voffB[2];
#pragma unroll
    for (int i = 0; i < 2; ++i) { int R, C; stage_rc(tid * 16 + i * 8192, R, C); const int Rb = Epi::PERM ? ((R & ~31) + perm32(R & 31)) : R;
        voffA[i] = (unsigned)(R * K + C) * 2u; voffB[i] = (unsigned)(Rb * K + C) * 2u; }
    const size_t kstep = (size_t)(BK * 2);
    const size_t hstep = (size_t)HALF * K * 2;
    const size_t tstep = 2 * hstep;
    const unsigned ldsw = (unsigned)wid * 1024u;
    const int aoff = lds_byte(wr * 64 + fr, fq * 8), boff = lds_byte(wc * 32 + fr, fq * 8);
#define PG8_SA(b, h) (((b) * 2 + (h)) * HTB)
#define PG8_SB(b, h) ((4 + (b) * 2 + (h)) * HTB)
#define PG8_STAGE(bufoff, gbase, voff) do { _Pragma("unroll") for (int _i = 0; _i < 2; ++_i) \
        __builtin_amdgcn_global_load_lds((const unsigned*)((const char*)(gbase) + (voff)[_i]), (PG8_LAS unsigned*)(lds + (bufoff) + ldsw + _i * 8192), 16, 0, 0); } while (0)
#define PG8_LDA(dst, b, h) do { _Pragma("unroll") for (int m = 0; m < 4; ++m) _Pragma("unroll") for (int k = 0; k < 2; ++k) dst[m][k] = *(const PG8_LAS bf16x8*)(lds + PG8_SA(b, h) + aoff + m * 2048 + k * 1024); } while (0)
#define PG8_LDB(dst, b, h) do { _Pragma("unroll") for (int n = 0; n < 2; ++n) _Pragma("unroll") for (int k = 0; k < 2; ++k) dst[n][k] = *(const PG8_LAS bf16x8*)(lds + PG8_SB(b, h) + boff + n * 2048 + k * 1024); } while (0)
#define PG8_MMA(ai, bj, At, Bt) do { __builtin_amdgcn_s_setprio(1); _Pragma("unroll") for (int m = 0; m < 4; ++m) _Pragma("unroll") for (int n = 0; n < 2; ++n) _Pragma("unroll") for (int k = 0; k < 2; ++k) \
        acc[ai][bj][m][n] = __builtin_amdgcn_mfma_f32_16x16x32_bf16(Bt[n][k], At[m][k], acc[ai][bj][m][n], 0, 0, 0); __builtin_amdgcn_s_setprio(0); } while (0)
#define PG8_WAIT_V(n) asm volatile("s_waitcnt vmcnt(" #n ")" ::: "memory")
#define PG8_WAIT_L(n) asm volatile("s_waitcnt lgkmcnt(" #n ")" ::: "memory")
#define PG8_BAR __builtin_amdgcn_s_barrier()
#define PG8_SCHED __builtin_amdgcn_sched_barrier(0)
    Unit cur, nxt; int ui = 0;
    if (!S.next(0, cur)) return;
    f32x4 acc[2][2][4][2];
#pragma unroll
    for (int a = 0; a < 2; ++a)
#pragma unroll
        for (int b = 0; b < 2; ++b)
#pragma unroll
            for (int m = 0; m < 4; ++m)
#pragma unroll
                for (int n = 0; n < 2; ++n) acc[a][b][m][n] = (f32x4){0.f, 0.f, 0.f, 0.f};
    bf16x8 At[4][2], B0[2][2], B1[2][2];
    const char* cA = (const char*)g.A + (size_t)cur.pm * tstep; const char* cB = (const char*)g.Bt + (size_t)cur.pn * tstep;
    S.a_ready(cur);
    if constexpr (SP2) {
        PG8_STAGE(PG8_SB(0, 0), cB, voffB); PG8_STAGE(PG8_SB(0, 1), cB + hstep, voffB); PG8_STAGE(PG8_SA(0, 0), cA, voffA); PG8_STAGE(PG8_SA(0, 1), cA + hstep, voffA);
        if (wr == 1) PG8_BAR;
        PG8_WAIT_V(2); PG8_BAR;
        PG8_STAGE(PG8_SB(1, 0), cB + kstep, voffB); PG8_STAGE(PG8_SA(1, 0), cA + kstep, voffA); PG8_STAGE(PG8_SB(1, 1), cB + hstep + kstep, voffB);
        PG8_WAIT_V(6); PG8_BAR;
    } else {
        PG8_STAGE(PG8_SB(0, 0), cB, voffB); PG8_STAGE(PG8_SA(0, 0), cA, voffA); PG8_STAGE(PG8_SB(0, 1), cB + hstep, voffB); PG8_STAGE(PG8_SA(0, 1), cA + hstep, voffA);
        if (wr == 1) PG8_BAR;
        PG8_WAIT_V(4); PG8_BAR;
        PG8_STAGE(PG8_SB(1, 0), cB + kstep, voffB); PG8_STAGE(PG8_SA(1, 0), cA + kstep, voffA); PG8_STAGE(PG8_SB(1, 1), cB + hstep + kstep, voffB);
        PG8_WAIT_V(6); PG8_BAR;
    }
    for (;;) {
        const bool has_next = S.next(ui + 1, nxt);
        const char* nA = has_next ? (const char*)g.A + (size_t)nxt.pm * tstep : cA; const char* nB = has_next ? (const char*)g.Bt + (size_t)nxt.pn * tstep : cB;
        for (int t = 0; t < nt; t += 2) {
            const bool last = (t == nt - 2);
            const char* a1 = cA + (size_t)(t + 1) * kstep;
            const char* a2 = last ? nA : cA + (size_t)(t + 2) * kstep; const char* b2 = last ? nB : cB + (size_t)(t + 2) * kstep;
            const char* a3 = a2 + kstep; const char* b3 = b2 + kstep;
            if (last && has_next) S.a_ready(nxt);
            if constexpr (SP2) {
            PG8_LDB(B0, 0, 0); PG8_LDB(B1, 0, 1); PG8_SCHED; PG8_LDA(At, 0, 0); PG8_STAGE(PG8_SA(1, 1), a1 + hstep, voffA);
            PG8_WAIT_V(8); PG8_WAIT_L(0); PG8_BAR; PG8_MMA(0, 0, At, B0); PG8_MMA(0, 1, At, B1); PG8_BAR; PG8_SCHED;
            PG8_LDA(At, 0, 1); PG8_STAGE(PG8_SB(0, 0), b2, voffB); PG8_STAGE(PG8_SB(0, 1), b2 + hstep, voffB); PG8_STAGE(PG8_SA(0, 0), a2, voffA);
            PG8_WAIT_V(8); PG8_WAIT_L(0); PG8_BAR; PG8_MMA(1, 0, At, B0); PG8_MMA(1, 1, At, B1); PG8_BAR; PG8_SCHED;
            PG8_LDB(B0, 1, 0); PG8_LDB(B1, 1, 1); PG8_SCHED; PG8_LDA(At, 1, 0); PG8_STAGE(PG8_SA(0, 1), a2 + hstep, voffA);
            PG8_WAIT_V(8); PG8_WAIT_L(0); PG8_BAR; PG8_MMA(0, 0, At, B0); PG8_MMA(0, 1, At, B1); PG8_BAR; PG8_SCHED;
            PG8_LDA(At, 1, 1); PG8_STAGE(PG8_SB(1, 0), b3, voffB); PG8_STAGE(PG8_SB(1, 1), b3 + hstep, voffB); PG8_STAGE(PG8_SA(1, 0), a3, voffA);
            PG8_WAIT_V(8); PG8_WAIT_L(0); PG8_BAR; PG8_MMA(1, 0, At, B0); PG8_MMA(1, 1, At, B1); PG8_BAR; PG8_SCHED;
            } else {
            PG8_LDB(B0, 0, 0); PG8_SCHED; PG8_LDA(At, 0, 0); PG8_STAGE(PG8_SA(1, 1), a1 + hstep, voffA);
            PG8_WAIT_L(8); PG8_BAR; PG8_WAIT_L(0); PG8_MMA(0, 0, At, B0); PG8_BAR; PG8_SCHED;
            PG8_LDB(B1, 0, 1); PG8_STAGE(PG8_SB(0, 0), b2, voffB);
            PG8_BAR; PG8_WAIT_L(0); PG8_MMA(0, 1, At, B1); PG8_BAR;
            PG8_LDA(At, 0, 1); PG8_STAGE(PG8_SA(0, 0), a2, voffA);
            PG8_BAR; PG8_WAIT_L(0); PG8_MMA(1, 0, At, B0); PG8_BAR; PG8_SCHED;
            PG8_STAGE(PG8_SB(0, 1), b2 + hstep, voffB);
            PG8_WAIT_V(6); PG8_BAR; PG8_MMA(1, 1, At, B1); PG8_BAR;
            PG8_LDB(B0, 1, 0); PG8_SCHED; PG8_LDA(At, 1, 0); PG8_STAGE(PG8_SA(0, 1), a2 + hstep, voffA);
            PG8_WAIT_L(8); PG8_BAR; PG8_WAIT_L(0); PG8_MMA(0, 0, At, B0); PG8_BAR; PG8_SCHED;
            PG8_LDB(B1, 1, 1); PG8_STAGE(PG8_SB(1, 0), b3, voffB);
            PG8_BAR; PG8_WAIT_L(0); PG8_MMA(0, 1, At, B1); PG8_BAR;
            PG8_LDA(At, 1, 1); PG8_STAGE(PG8_SA(1, 0), a3, voffA);
            PG8_BAR; PG8_WAIT_L(0); PG8_MMA(1, 0, At, B0); PG8_BAR; PG8_SCHED;
            PG8_STAGE(PG8_SB(1, 1), b3 + hstep, voffB);
            PG8_WAIT_V(6); PG8_BAR; PG8_MMA(1, 1, At, B1); PG8_BAR;
            }
        }
        if constexpr (ALIGN_EPI) { if (wr == 0) PG8_BAR; }
        if constexpr (!Epi::AFTER_DRAIN) { E(acc, cur, wr, wc, fr, fq); S.done(cur); }
        if (!has_next) break;
#pragma unroll
        for (int a = 0; a < 2; ++a)
#pragma unroll
            for (int b = 0; b < 2; ++b)
#pragma unroll
                for (int m = 0; m < 4; ++m)
#pragma unroll
                    for (int n = 0; n < 2; ++n) acc[a][b][m][n] = (f32x4){0.f, 0.f, 0.f, 0.f};
        cur = nxt; cA = nA; cB = nB; ++ui;
        if constexpr (ALIGN_EPI) { if (wr == 1) PG8_BAR; }
    }
    PG8_WAIT_V(0);
    if constexpr (!ALIGN_EPI) { if (wr == 0) PG8_BAR; }
    PG8_BAR;
    if constexpr (Epi::AFTER_DRAIN) { E.fused(acc, cur, wr, wc, fr, fq, lds, wid, lane); S.done(cur); }
#undef PG8_SA
#undef PG8_SB
#undef PG8_STAGE
#undef PG8_LDA
#undef PG8_LDB
#undef PG8_MMA
#undef PG8_WAIT_V
#undef PG8_WAIT_L
#undef PG8_BAR
#undef PG8_SCHED
}
}
namespace fox {
constexpr int D = 128, OPITCH = 2048;
constexpr size_t FOX_WS_K = (size_t)368 << 20, FOX_WS_O = (size_t)752 << 20;
constexpr int FOX_CW_DONE = 8192;
constexpr bool WSKIP = false;
constexpr float THR = 8.f;
constexpr float SCALE = 0.08838834764831845f;
constexpr float INV_SCALE = 11.313708498984761f;
constexpr int NW = 8, QBLK = 32, KVBLK = 64, QB = NW * QBLK;
constexpr int SHM_V = KVBLK * D * 2, SHM_K = KVBLK * D * 2;
constexpr int LDS_BIAS = 2 * SHM_V + 2 * SHM_K + NW * 64 * 4;
constexpr int LDS_BYTES = LDS_BIAS + 2 * 64 * 4;

using bf16 = __hip_bfloat16;
typedef short bf16x8 __attribute__((ext_vector_type(8)));
typedef short s16x4 __attribute__((ext_vector_type(4)));
typedef float f32x16 __attribute__((ext_vector_type(16)));
typedef float f32x4 __attribute__((ext_vector_type(4)));
typedef float f32x2v __attribute__((ext_vector_type(2)));
typedef unsigned u32x4 __attribute__((ext_vector_type(4)));
template <class A, class Bt> struct same_t { static constexpr bool v = false; };
template <class A> struct same_t<A, A> { static constexpr bool v = true; };

#define KSWZ(row, colB) ((row) * 256 + ((colB) ^ (((row) & 7) << 4)))
#define SBAR() __builtin_amdgcn_sched_barrier(0)
#define WGBAR() do { asm volatile("s_waitcnt lgkmcnt(0)" ::: "memory"); __builtin_amdgcn_s_barrier(); asm volatile("" ::: "memory"); } while (0)
__device__ __forceinline__ int v_st(int k, int c) { const int kk = (k & ~0xC) | ((k & 4) << 1) | ((k & 8) >> 1); return ((kk >> 3) * 4 + (c >> 5)) * 512 + ((kk & 7) * 32 + (c & 31)) * 2; }
__device__ __forceinline__ int v_rd_base(int lane) { return ((lane & 3) << 3) | (((lane >> 2) & 3) << 6) | (((lane >> 4) & 1) << 5) | (((lane >> 5) & 1) << 8); }
constexpr int v_rd_off(int d0, int ks, int half) { return d0 * 512 + ks * 4096 + half * 2048; }
__device__ __forceinline__ int crow(int r, int hi) { return (r & 3) + 8 * (r >> 2) + 4 * hi; }
__device__ __forceinline__ unsigned cvtpk(float lo, float hi) {
    unsigned r; asm volatile("v_cvt_pk_bf16_f32 %0, %1, %2" : "=v"(r) : "v"(lo), "v"(hi)); return r;
}
__device__ __forceinline__ bf16x8 pack8(f32x4 a, f32x4 b) {
    u32x4 w = {cvtpk(a[0], a[1]), cvtpk(a[2], a[3]), cvtpk(b[0], b[1]), cvtpk(b[2], b[3])};
    return *reinterpret_cast<bf16x8*>(&w);
}
template <class T> __device__ __forceinline__ bf16x8 load8(const T* p) {
    if constexpr (same_t<T, float>::v) { return pack8(*(const f32x4*)p, *(const f32x4*)(p + 4)); }
    else { return *reinterpret_cast<const bf16x8*>(p); }
}
__device__ __forceinline__ void mask_tile(f32x16& p0, f32x16& p1, int dq, unsigned W) {
    const float NEG = -__builtin_inff();
#pragma unroll
    for (int r = 0; r < 16; ++r) {
        const int c = (r & 3) + 8 * (r >> 2);
        if ((unsigned)(dq - c) >= W) p0[r] = NEG;
        if ((unsigned)(dq - c - 32) >= W) p1[r] = NEG;
    }
}
__device__ __forceinline__ void partialSM(f32x16& p0, f32x16& p1, float& m_reg, float& mn, float& alpha) {
    float pmax = p0[0]; for (int r = 1; r < 16; ++r) pmax = fmaxf(pmax, p0[r]); for (int r = 0; r < 16; ++r) pmax = fmaxf(pmax, p1[r]);
    { auto rr = __builtin_amdgcn_permlane32_swap(__float_as_uint(pmax), __float_as_uint(pmax), false, false);
      pmax = fmaxf(__uint_as_float(rr[0]), __uint_as_float(rr[1])); }
    constexpr float C2 = 1.4426950408889634f * SCALE;
    if (__builtin_expect(__all((pmax - m_reg) * SCALE <= THR), 1)) { mn = m_reg; alpha = 1.f; }
    else { mn = fmaxf(m_reg, pmax); alpha = __builtin_amdgcn_exp2f((m_reg - mn) * C2); m_reg = mn; }
    const float mnL = -mn * C2;
    for (int r = 0; r < 16; ++r) p0[r] = fmaf(p0[r], C2, mnL); for (int r = 0; r < 16; ++r) p1[r] = fmaf(p1[r], C2, mnL);
    for (int r = 0; r < 16; ++r) p0[r] = __builtin_amdgcn_exp2f(p0[r]);
}
__device__ __forceinline__ void finishSM(f32x16& p0, f32x16& p1, float alpha, float& l_reg, bf16x8& pa0, bf16x8& pa1, bf16x8& pa2, bf16x8& pa3) {
    for (int r = 0; r < 16; ++r) p1[r] = __builtin_amdgcn_exp2f(p1[r]);
    float ps = 0; for (int r = 0; r < 16; ++r) ps += p0[r]; for (int r = 0; r < 16; ++r) ps += p1[r];
    { auto rr = __builtin_amdgcn_permlane32_swap(__float_as_uint(ps), __float_as_uint(ps), false, false);
      ps = __uint_as_float(rr[0]) + __uint_as_float(rr[1]); }
    l_reg = l_reg * alpha + ps;
#define PK4(P, B_, OUT) do { unsigned a0 = cvtpk(P[B_+0], P[B_+1]), a1 = cvtpk(P[B_+2], P[B_+3]);                          \
        unsigned b0 = cvtpk(P[B_+4], P[B_+5]), b1 = cvtpk(P[B_+6], P[B_+7]);                                             \
        auto r0 = __builtin_amdgcn_permlane32_swap(a0, b0, false, false); auto r1 = __builtin_amdgcn_permlane32_swap(a1, b1, false, false); \
        u32x4 w = {r0[0], r1[0], r0[1], r1[1]}; OUT = *reinterpret_cast<bf16x8*>(&w); } while (0)
    PK4(p0, 0, pa0); PK4(p0, 8, pa1); PK4(p1, 0, pa2); PK4(p1, 8, pa3);
#undef PK4
}
template <int KB, bool SK>
__device__ __forceinline__ void qkt(f32x16& p0, f32x16& p1, const char* K_lds, int r32, int hi, const bf16x8* qr, bool act) {
    const float* bl_ = (const float*)(K_lds + 2 * SHM_K + NW * 64 * 4) + KB * 64 + 4 * hi;
    if (SK && !act) { const float NEG = -__builtin_inff();
#pragma unroll
        for (int r = 0; r < 16; ++r) { p0[r] = NEG; p1[r] = NEG; } return; }
#pragma unroll
    for (int g = 0; g < 4; ++g) { const f32x4 v0_ = *(const f32x4*)(bl_ + 8 * g), v1_ = *(const f32x4*)(bl_ + 32 + 8 * g);
        p0[4 * g] = v0_[0]; p0[4 * g + 1] = v0_[1]; p0[4 * g + 2] = v0_[2]; p0[4 * g + 3] = v0_[3];
        p1[4 * g] = v1_[0]; p1[4 * g + 1] = v1_[1]; p1[4 * g + 2] = v1_[2]; p1[4 * g + 3] = v1_[3]; }
    const char* kb[4];
#pragma unroll
    for (int dd = 0; dd < 4; ++dd) kb[dd] = K_lds + KB * SHM_K + KSWZ(r32, (dd * 16 + hi * 8) * 2);
#pragma unroll
    for (int d0 = 0; d0 < 8; ++d0) { const char* a = kb[d0 & 3] + (d0 >> 2) * 128;
        bf16x8 b0 = *reinterpret_cast<const bf16x8*>(a);
        bf16x8 b1 = *reinterpret_cast<const bf16x8*>(a + 32 * 256);
        p0 = __builtin_amdgcn_mfma_f32_32x32x16_bf16(b0, qr[d0], p0, 0, 0, 0);
        p1 = __builtin_amdgcn_mfma_f32_32x32x16_bf16(b1, qr[d0], p1, 0, 0, 0); }
}
template <int VB, bool SK>
__device__ __forceinline__ void pv_tile(f32x16* o, int vb0, bf16x8 pa0, bf16x8 pa1, bf16x8 pa2, bf16x8 pa3, bool act) {
    if (SK && !act) return;
#define TRRD(dst, off) asm volatile("ds_read_b64_tr_b16 %0, %1 offset:%2" : "=&v"(dst) : "v"(vb0), "i"(off) : "memory")
#define PV_D0(d0) do { s16x4 l0, l1, l2, l3, h0, h1, h2, h3; constexpr int b_ = VB * SHM_V + v_rd_off(d0, 0, 0);     \
        TRRD(l0, b_); TRRD(h0, b_ + 2048); TRRD(l1, b_ + 4096); TRRD(h1, b_ + 6144); TRRD(l2, b_ + 8192); TRRD(h2, b_ + 10240); TRRD(l3, b_ + 12288); TRRD(h3, b_ + 14336); \
        asm volatile("s_waitcnt lgkmcnt(0)" ::: "memory"); SBAR();                 \
        o[d0] = __builtin_amdgcn_mfma_f32_32x32x16_bf16(pa0, (bf16x8){l0[0], l0[1], l0[2], l0[3], h0[0], h0[1], h0[2], h0[3]}, o[d0], 0, 0, 0);   \
        o[d0] = __builtin_amdgcn_mfma_f32_32x32x16_bf16(pa1, (bf16x8){l1[0], l1[1], l1[2], l1[3], h1[0], h1[1], h1[2], h1[3]}, o[d0], 0, 0, 0);   \
        o[d0] = __builtin_amdgcn_mfma_f32_32x32x16_bf16(pa2, (bf16x8){l2[0], l2[1], l2[2], l2[3], h2[0], h2[1], h2[2], h2[3]}, o[d0], 0, 0, 0);   \
        o[d0] = __builtin_amdgcn_mfma_f32_32x32x16_bf16(pa3, (bf16x8){l3[0], l3[1], l3[2], l3[3], h3[0], h3[1], h3[2], h3[3]}, o[d0], 0, 0, 0); } while (0)
    PV_D0(0); PV_D0(1); PV_D0(2); PV_D0(3);
#undef PV_D0
#undef TRRD
}

template <class TIn, class TOut> struct BlockRef {
    int bh, P0, jlo, jhi;
    int kvbh, omib;
    int kind, nprev, slot0, bi;
    __device__ __forceinline__ const TIn* Kp(unsigned char* ws) const { return (const TIn*)(ws + FOX_WS_K) + (size_t)kvbh * 16384 * D; }
    __device__ __forceinline__ const TIn* Vp(unsigned char* ws) const { return Kp(ws) + (1 << 25); }
    __device__ __forceinline__ const TIn* Qp(unsigned char* ws) const { return Kp(ws) - (1 << 25) + (size_t)P0 * D; }
    __device__ __forceinline__ TOut* Op(unsigned char* ws) const { return (TOut*)(ws + FOX_WS_O + ((size_t)omib << 20)) + ((size_t)(bh >> 3) * 16384 + (size_t)P0) * OPITCH + (bh & 7) * D; }
    __device__ __forceinline__ unsigned* donep(unsigned char* ws) const { return (unsigned*)ws + FOX_CW_DONE + bi; }
};
struct FoxBases { const float* F; const float* NW; unsigned char* ws; };
#define BR_F(r) (fb.F + (size_t)(r).bh * 16384)
constexpr int SLOT_FLOATS = 256 * 128 + 256 * 2;
constexpr int SLOTS_LO = 1008;
constexpr size_t SLOT_LO_OFF = (size_t)176 << 20, SLOT_HI_OFF = (size_t)880 << 20;
__device__ __forceinline__ float* fox_slot(unsigned char* ws, int k) { return (float*)(ws + (k < SLOTS_LO ? SLOT_LO_OFF + (size_t)k * (SLOT_FLOATS * 4) : SLOT_HI_OFF + (size_t)(k - SLOTS_LO) * (SLOT_FLOATS * 4))); }
constexpr float C2G = 1.4426950408889634f * SCALE;
template <class TIn> struct Seam {
    bf16x8 qr[8];
    bf16x8 st_v0, st_v1, st_k0, st_k1; f32x4 sf0, sf1, sf2, sf3;
    f32x4 tq[16];
};
__device__ __forceinline__ int swa_jlo(int P0, int W) { const int lowk = P0 - W + 1; return lowk > 0 ? lowk / KVBLK : 0; }
#define ROW(p, k0, rr) ((p) + (size_t)((k0) + ((rr) - sr)) * D + lofs_)
#define VMW() asm volatile("s_waitcnt vmcnt(0)" ::: "memory")
#define VMWN(n) asm volatile("s_waitcnt vmcnt(%0)" :: "i"(n) : "memory")
#define SLOAD_H(Kp, Vp, Fp, k0, bfb) do { S.st_v0 = load8<TIn>(ROW(Vp, k0, sr)); S.st_v1 = load8<TIn>(ROW(Vp, k0, 32 + sr));              \
                         S.st_k0 = load8<TIn>(ROW(Kp, k0, sr)); S.st_k1 = load8<TIn>(ROW(Kp, k0, 32 + sr));                         \
                         if (wid == 0) __builtin_amdgcn_global_load_lds((const unsigned*)((Fp) + (k0) + lane),                          \
                             (__attribute__((address_space(3))) unsigned*)(bias_las + (bfb) * 256), 4, 0, 0); } while (0)
#define SWRITE_HK(bf) do { *(bf16x8*)(K_lds + (bf) * SHM_K + kws) = S.st_k0; *(bf16x8*)(K_lds + (bf) * SHM_K + kws + 32 * 256) = S.st_k1; } while (0)
#define SWRITE_HV(bf) do { *(bf16x8*)(V_lds + (bf) * SHM_V + vst0) = S.st_v0; *(bf16x8*)(V_lds + (bf) * SHM_V + vst1) = S.st_v1; } while (0)
#define SWRITE_H(bf) do { SWRITE_HV(bf); SWRITE_HK(bf); } while (0)
#define SLOAD_F(p, k0) do { S.sf0 = *(const f32x4*)ROW(p, k0, sr); S.sf1 = *(const f32x4*)(ROW(p, k0, sr) + 4);                \
                            S.sf2 = *(const f32x4*)ROW(p, k0, 32 + sr); S.sf3 = *(const f32x4*)(ROW(p, k0, 32 + sr) + 4); } while (0)
#define SWRITE_KF(bf) do { *(bf16x8*)(K_lds + (bf) * SHM_K + kws) = pack8(S.sf0, S.sf1); *(bf16x8*)(K_lds + (bf) * SHM_K + kws + 32 * 256) = pack8(S.sf2, S.sf3); } while (0)
#define SWRITE_VF(bf) do { *(bf16x8*)(V_lds + (bf) * SHM_V + vst0) = pack8(S.sf0, S.sf1); *(bf16x8*)(V_lds + (bf) * SHM_V + vst1) = pack8(S.sf2, S.sf3); } while (0)
template <class TIn, class TOut>
__device__ __forceinline__ void causal_swa_prime(const BlockRef<TIn, TOut>& cur, const FoxBases& fb, int W, char* lds, Seam<TIn>& S, const int wid_in) {
    constexpr bool F32 = same_t<TIn, float>::v;
    const int wid = wid_in, lane = mk_lane_id(), tid = wid * 64 + lane, r32 = lane & 31, hi = lane >> 5;
    const int sr = tid >> 4, sc = (tid & 15) * 8, kws = KSWZ(sr, sc * 2); char* K_lds = lds + 2 * SHM_V;
    const unsigned lofs_ = (unsigned)(sr * D + sc);
    __attribute__((address_space(3))) unsigned char* bias_las = (__attribute__((address_space(3))) unsigned char*)lds + LDS_BIAS;
    const int kb0 = cur.jlo * KVBLK;
    for (int d0 = 0; d0 < 8; ++d0) S.qr[d0] = load8<TIn>(cur.Qp(fb.ws) + (size_t)(wid * QBLK) * D + (unsigned)(r32 * D + hi * 8) + d0 * 16);
    if constexpr (F32) { SLOAD_F((const float*)cur.Kp(fb.ws), kb0); VMW(); SWRITE_KF(0); SBAR(); SLOAD_F((const float*)cur.Vp(fb.ws), kb0); }
    else { SLOAD_H(cur.Kp(fb.ws), cur.Vp(fb.ws), BR_F(cur), kb0, 0); VMW(); SWRITE_HK(0); }
    WGBAR();
}
template <class TIn, class TOut, class Next>
__device__ __forceinline__ void causal_swa_block(const BlockRef<TIn, TOut>& cur, BlockRef<TIn, TOut>& nxt, int& nidx, const Next& NX, const FoxBases& fb, int skv, int W, char* lds, Seam<TIn>& S, const int wid_in) {
    constexpr bool F32 = same_t<TIn, float>::v;
    const int wid = wid_in, lane = mk_lane_id(), tid = wid * 64 + lane, r32 = lane & 31, hi = lane >> 5;
    const int j_lo = cur.jlo;
    const int j_hi = cur.jhi;
    const int NT = j_hi - j_lo;
    const int tc_ = NT > 10 ? ((NT - 10) | 1) : -1;
    if (tc_ < 0) NX.claim();
    const int qlo = cur.P0 + wid * QBLK, qm = qlo + r32 - 4 * hi;
    char* V_lds = lds; char* K_lds = lds + 2 * SHM_V;
    __attribute__((address_space(3))) unsigned char* bias_las = (__attribute__((address_space(3))) unsigned char*)lds + LDS_BIAS;
    float* ws = (float*)(lds + 2 * SHM_V + 2 * SHM_K) + wid * 64; float* li_l = ws, * al_l = ws + 32;
    float m_reg = -1e30f, l_reg = 0; f32x16 o[4] = {};
    const unsigned lofs_ = (unsigned)((tid >> 4) * D + (tid & 15) * 8);
    const int sr = tid >> 4, sc = (tid & 15) * 8, vst0 = v_st(sr, sc), vst1 = v_st(32 + sr, sc), kws = KSWZ(sr, sc * 2);
    const int vb0 = (int)(uintptr_t)V_lds + v_rd_base(lane);
    const TIn* Kh = cur.Kp(fb.ws); const TIn* Vh = cur.Vp(fb.ws); const float* Fh = BR_F(cur);
#define RESC(a) do { if (__any((a) < 1.f)) { if (hi == 0) al_l[r32] = (a); asm volatile("s_waitcnt lgkmcnt(0)" ::: "memory");              \
                     for (int d_ = 0; d_ < 4; ++d_) for (int r = 0; r < 16; ++r) o[d_][r] *= al_l[crow(r, hi)]; } } while (0)
#define KBASE(t) ((j_lo + (t)) * KVBLK)
#define ACT(t) (KBASE(t) <= qlo + QBLK - 1 && KBASE(t) + KVBLK - 1 >= qlo - W + 1)
#define MASKT(P0_, P1_, t) do { const int kb_ = KBASE(t); if ((!SK || ACT(t)) && (kb_ + KVBLK - 1 > qlo || kb_ <= qlo + QBLK - 1 - W)) mask_tile(P0_, P1_, qm - kb_, (unsigned)W); } while (0)
    constexpr int NQL = F32 ? 16 : 8;
    constexpr bool SK = WSKIP && !F32;
#define SEAM_K0() do { VMWN(NQL); if constexpr (F32) { SWRITE_KF(0); SBAR(); SLOAD_F((const float*)nxt.Vp(fb.ws), kbn); } else { SWRITE_HK(0); } SBAR(); } while (0)
    f32x16 pA0, pA1, pB0, pB1; float mnA, mnB, alA, alB; bf16x8 pa0, pa1, pa2, pa3;
    if constexpr (F32) { VMW(); SWRITE_VF(0); SBAR(); } else { SWRITE_HV(0); SBAR(); }
    if (NT > 1) { if constexpr (F32) SLOAD_F((const float*)Kh, KBASE(1)); else SLOAD_H(Kh, Vh, Fh, KBASE(1), 1); }
    SBAR(); qkt<0, SK>(pA0, pA1, K_lds, r32, hi, S.qr, ACT(0));
    if constexpr (F32) { if (NT > 1) { VMW(); SWRITE_KF(1); SBAR(); SLOAD_F((const float*)Vh, KBASE(1)); } }
    MASKT(pA0, pA1, 0); partialSM(pA0, pA1, m_reg, mnA, alA);
    if (NT > 1) { VMW(); if constexpr (F32) { SWRITE_VF(1); SBAR(); if (NT > 2) SLOAD_F((const float*)Kh, KBASE(2)); } else SWRITE_H(1); }
    WGBAR();
#define HALF_STEP(PX0, PX1, mnX, alX, PY0, PY1, alY, t, KB, VB, SB) do {                                                      \
        SBAR(); qkt<KB, SK>(PX0, PX1, K_lds, r32, hi, S.qr, ACT(t));                                             \
        finishSM(PY0, PY1, alY, l_reg, pa0, pa1, pa2, pa3); SBAR();                                                           \
        if ((t) + 1 < NT) { if constexpr (F32) { VMW(); SWRITE_KF(SB); SBAR(); SLOAD_F((const float*)Vh, KBASE((t) + 1)); }  \
                            else { SLOAD_H(Kh, Vh, Fh, KBASE((t) + 1), SB); } SBAR(); }                                       \
        pv_tile<VB, SK>(o, vb0, pa0, pa1, pa2, pa3, ACT((t) - 1)); MASKT(PX0, PX1, (t)); partialSM(PX0, PX1, m_reg, mnX, alX);                                        \
        WGBAR();                                                                                                      \
        if ((t) + 1 < NT) { VMW(); if constexpr (F32) { SWRITE_VF(SB); SBAR(); if ((t) + 2 < NT) SLOAD_F((const float*)Kh, KBASE((t) + 2)); } \
                            else { SWRITE_H(SB); } }                                                                          \
        RESC(alX); WGBAR(); } while (0)
    for (int t = 1; t + 1 < NT; t += 2) {
        if (t == tc_) NX.claim();
        HALF_STEP(pB0, pB1, mnB, alB, pA0, pA1, alA, t, 1, 0, 0);
        HALF_STEP(pA0, pA1, mnA, alA, pB0, pB1, alB, t + 1, 0, 1, 1);
    }
    nidx = NX.resolve(nxt, cur);
    const int kbn = nxt.jlo * KVBLK;
    const bool even = (NT & 1) == 0;
    if (even) { SBAR(); qkt<1, SK>(pB0, pB1, K_lds, r32, hi, S.qr, ACT(NT - 1)); SBAR(); }
#define QROW(e) (nxt.Qp(fb.ws) + (size_t)(wid * QBLK + r32) * D + ((e) >> 1) * 16 + hi * 8 + ((e) & 1) * 4)
    if constexpr (F32) { SLOAD_F((const float*)nxt.Kp(fb.ws), kbn); SBAR();
#pragma unroll
        for (int e = 0; e < 8; ++e) S.tq[e] = *(const f32x4*)QROW(e); }
    else { SLOAD_H(nxt.Kp(fb.ws), nxt.Vp(fb.ws), BR_F(nxt), kbn, 0); SBAR();
#pragma unroll
        for (int d0 = 0; d0 < 8; ++d0) S.qr[d0] = load8<TIn>(nxt.Qp(fb.ws) + (size_t)(wid * QBLK) * D + (unsigned)(r32 * D + hi * 8) + d0 * 16); }
    SBAR();
    finishSM(pA0, pA1, alA, l_reg, pa0, pa1, pa2, pa3); SBAR();
    if constexpr (F32) {
#pragma unroll
        for (int e = 8; e < 16; ++e) S.tq[e] = *(const f32x4*)QROW(e); SBAR(); }
#undef QROW
    pv_tile<0, SK>(o, vb0, pa0, pa1, pa2, pa3, ACT(even ? NT - 2 : NT - 1));
    if (even) { MASKT(pB0, pB1, NT - 1); partialSM(pB0, pB1, m_reg, mnB, alB); WGBAR(); RESC(alB);
        finishSM(pB0, pB1, alB, l_reg, pa0, pa1, pa2, pa3); SBAR(); pv_tile<1, SK>(o, vb0, pa0, pa1, pa2, pa3, ACT(NT - 1)); }
    SBAR(); SEAM_K0();
    if (cur.kind != 0) {
        float* Os = fox_slot(fb.ws, cur.slot0) + (size_t)(wid * QBLK) * 128 + (unsigned)(4 * hi * 128 + r32);
#pragma unroll
        for (int g = 0; g < 4; ++g) { SBAR(); float* Og = Os + 8 * g * 128;
#pragma unroll
            for (int i = 0; i < 4; ++i)
#pragma unroll
                for (int d0 = 0; d0 < 4; ++d0) Og[i * 128 + d0 * 32] = o[d0][4 * g + i]; }
        SBAR();
        if (hi == 0) *(f32x2v*)(fox_slot(fb.ws, cur.slot0) + 256 * 128 + (wid * QBLK + r32) * 2) = (f32x2v){m_reg, l_reg};
        asm volatile("s_waitcnt vmcnt(0)" ::: "memory");
        WGBAR();
        if (cur.kind == 1) {
            if (tid == 0) { __builtin_amdgcn_fence(__ATOMIC_RELEASE, "agent"); asm volatile("s_waitcnt vmcnt(0)" ::: "memory");
                (void)__hip_atomic_fetch_add(cur.donep(fb.ws), 1u, __ATOMIC_RELAXED, __HIP_MEMORY_SCOPE_AGENT); }
        } else {
            if (tid == 0) { unsigned sp_ = 0; while (__hip_atomic_load(cur.donep(fb.ws), __ATOMIC_RELAXED, __HIP_MEMORY_SCOPE_AGENT) < (unsigned)cur.nprev) { __builtin_amdgcn_s_sleep(2); if (++sp_ > (1u << 21)) break; }
                __builtin_amdgcn_fence(__ATOMIC_ACQUIRE, "agent"); asm volatile("s_waitcnt vmcnt(0)" ::: "memory"); }
            WGBAR();
            const int lane2 = 2 * lane; const f32x2v wv_ = *(const f32x2v*)(fb.NW + (cur.bh & 7) * 128 + lane2);
            TOut* Orow = cur.Op(fb.ws) + (size_t)(wid * QBLK) * OPITCH + lane2;
            for (int rr = 0; rr < QBLK; ++rr) {
                const int row = wid * QBLK + rr;
                float M_ = -1e30f;
                for (int sg = 0; sg <= cur.nprev; ++sg) M_ = fmaxf(M_, fox_slot(fb.ws, cur.slot0 - cur.nprev + sg)[256 * 128 + row * 2]);
                float lsum = 0.f; f32x2v acc_ = (f32x2v){0.f, 0.f};
                for (int sg = 0; sg <= cur.nprev; ++sg) { const float* Ps = fox_slot(fb.ws, cur.slot0 - cur.nprev + sg);
                    const f32x2v ml_ = *(const f32x2v*)(Ps + 256 * 128 + row * 2); const float w_ = __builtin_amdgcn_exp2f((ml_[0] - M_) * C2G);
                    lsum += ml_[1] * w_; acc_ += *(const f32x2v*)(Ps + row * 128 + lane2) * w_; }
                acc_ = acc_ * __builtin_amdgcn_rcpf(lsum);
                float ss_ = acc_[0] * acc_[0] + acc_[1] * acc_[1];
#pragma unroll
                for (int of = 1; of < 64; of <<= 1) ss_ += __shfl_xor(ss_, of);
                const float rn_ = __builtin_amdgcn_rsqf(ss_ * (1.0f / 128.0f) + 1e-6f);
                *(unsigned*)(Orow + (size_t)rr * OPITCH) = cvtpk(acc_[0] * rn_ * wv_[0], acc_[1] * rn_ * wv_[1]);
            }
        }
    } else {
    if (hi == 0) li_l[r32] = l_reg; asm volatile("s_waitcnt lgkmcnt(0)" ::: "memory");
    {
        typedef __attribute__((address_space(3))) float lasf;
        lasf* ssq_l = (lasf*)(__attribute__((address_space(3))) unsigned char*)lds + (LDS_BIAS - NW * 64 * 4) / 4 + wid * 64 + 32;
        float rli[16];
#pragma unroll
        for (int r = 0; r < 16; ++r) rli[r] = __builtin_amdgcn_rcpf(li_l[crow(r, hi)]);
        if (hi == 0) al_l[r32] = 0.f;
        asm volatile("s_waitcnt lgkmcnt(0)" ::: "memory");
#pragma unroll
        for (int r = 0; r < 16; ++r) { float ss_ = 0.f;
#pragma unroll
            for (int d0 = 0; d0 < 4; ++d0) { const float v = o[d0][r] * rli[r]; ss_ += v * v; }
            (void)__hip_atomic_fetch_add(ssq_l + crow(r, hi), ss_, __ATOMIC_RELAXED, __HIP_MEMORY_SCOPE_WORKGROUP); }
        asm volatile("s_waitcnt lgkmcnt(0)" ::: "memory");
#pragma unroll
        for (int r = 0; r < 16; ++r) rli[r] *= __builtin_amdgcn_rsqf(al_l[crow(r, hi)] * (1.0f / 128.0f) + 1e-6f);
        float wn_[4];
#pragma unroll
        for (int d0 = 0; d0 < 4; ++d0) wn_[d0] = fb.NW[(cur.bh & 7) * 128 + d0 * 32 + r32];
        TOut* Ow = cur.Op(fb.ws) + (size_t)(wid * QBLK) * OPITCH;
        char* os_ = lds + 73728 + wid * 10240;
        const bool odd_ = (r32 & 1) != 0;
#pragma unroll
        for (int rp = 0; rp < 8; ++rp) { const int r = 2 * rp; char* orow_ = os_ + (crow(r, hi) + (odd_ ? 1 : 0)) * 320 + 2 * (r32 & ~1);
#pragma unroll
            for (int d0 = 0; d0 < 4; ++d0) { const float va = o[d0][r] * rli[r] * wn_[d0], vb = o[d0][r + 1] * rli[r + 1] * wn_[d0];
                const float snd = odd_ ? va : vb;
                const float rcv = __builtin_bit_cast(float, __builtin_amdgcn_update_dpp(0, __builtin_bit_cast(int, snd), 0xB1, 0xF, 0xF, true));
                *(unsigned*)(orow_ + 64 * d0) = cvtpk(odd_ ? rcv : va, odd_ ? vb : rcv); } }
        asm volatile("s_waitcnt lgkmcnt(0)" ::: "memory");
#pragma unroll
        for (int i = 0; i < 8; ++i) { const int q_ = 64 * i + lane, row_ = q_ >> 4, ch_ = q_ & 15;
            const u32x4 w_ = *(const u32x4*)(os_ + row_ * 320 + ch_ * 16);
            *(u32x4*)(Ow + (size_t)row_ * OPITCH + ch_ * 8) = w_; }
    }
    if constexpr (F32) {
#pragma unroll
        for (int d0 = 0; d0 < 8; ++d0) S.qr[d0] = pack8(S.tq[2 * d0], S.tq[2 * d0 + 1]); }
    }
    if (cur.kind == 0) WGBAR();
#undef RESC
#undef KBASE
#undef ACT
#undef MASKT
#undef SEAM_K0
#undef HALF_STEP
}
#undef ROW
#undef VMW
#undef VMWN
#undef SLOAD_H
#undef SWRITE_HK
#undef SWRITE_HV
#undef SWRITE_H
#undef SLOAD_F
#undef SWRITE_KF
#undef SWRITE_VF
}
constexpr int NWAVES = 8;
constexpr int NTHR = NWAVES * 64;
#ifndef MK_N_LAUNCHES
#define MK_N_LAUNCHES 1
#endif
constexpr int NPHASE = 8;
constexpr int BATCH = 2, SEQ = 16384, DM = 2048, T = BATCH * SEQ;
constexpr int NZ = 6144;
constexpr int NCH = SEQ / 128;
constexpr float NORM_EPS = 1e-6f;
constexpr size_t MiB = 1u << 20;
constexpr size_t WS_CTL = 0, CTL_ZERO_BYTES = 64 * 1024;
constexpr size_t WS_WINT = 1 * MiB;
constexpr size_t WS_WOUTT = 26 * MiB;
constexpr size_t WS_WQT = 34 * MiB;
constexpr size_t WS_KEYS = 42 * MiB;
constexpr size_t WS_FCUM = 43 * MiB;
constexpr size_t WS_MSM = 44 * MiB;
constexpr size_t WS_GATES = 46 * MiB;
constexpr size_t WS_UB = 48 * MiB;
constexpr size_t WS_VB = 80 * MiB;
constexpr size_t WS_SSQP = 464 * MiB;
constexpr size_t WS_PEI = 432 * MiB;
constexpr size_t WS_PEG = 448 * MiB;
constexpr size_t WS_H = 176 * MiB;
constexpr size_t WS_FQ = 304 * MiB, WS_FK = 368 * MiB, WS_FV = 432 * MiB;
constexpr size_t WS_MQ = 496 * MiB, WS_MK = 528 * MiB;
constexpr size_t WS_MV = 560 * MiB, WS_MO = 624 * MiB;
constexpr size_t WS_PQ = 304 * MiB;
constexpr size_t WS_CPREV = 688 * MiB;
constexpr size_t WS_MIXED = 752 * MiB;
constexpr size_t WS_END = 880 * MiB;
constexpr size_t WS_NEED = 1024 * MiB;
constexpr int MS_MLOC = 0, MS_BLAST = 1024, MS_MPREV = 2048, MS_NLOC = 4096, MS_NPREV = 4096 + 131072;
constexpr int MS_QBF = 348400;
constexpr float QF_K0 = 12.f, QF_K1 = 13.25f, QF_K2 = 14.5f;
constexpr int MS_KTMAX = 344200;
constexpr int MS_QBDMIN = 343100;
constexpr int MS_QBMAX = 342000;
constexpr int MS_JLO = 340000;
constexpr int MS_USC = 300000, MS_VSC = 320000;
constexpr int CW_QKMAX = 2048;
constexpr int CW_QUEUE = 3072;
constexpr int CW_SEGDONE = 8192;
constexpr int CW_BAR = 4096;

constexpr int LDS_BYTES = 160 * 1024;
constexpr int MISC_OFF = LDS_BYTES - 256;
constexpr int SCR_BYTES = MISC_OFF;

#define GAS __attribute__((address_space(1)))
#define LAS __attribute__((address_space(3)))
typedef unsigned short bf16;
typedef unsigned v4u __attribute__((ext_vector_type(4)));
typedef unsigned v2u __attribute__((ext_vector_type(2)));
typedef float f32x4 __attribute__((ext_vector_type(4)));
typedef float f32x2 __attribute__((ext_vector_type(2)));
typedef float f32x16 __attribute__((ext_vector_type(16)));
typedef short bf16x8 __attribute__((ext_vector_type(8)));
typedef GAS unsigned gu32;
#define RLX_AGENT __ATOMIC_RELAXED, __HIP_MEMORY_SCOPE_AGENT
#define LDS_WAIT() asm volatile("s_waitcnt lgkmcnt(0)" ::: "memory")
#define VM_WAIT() asm volatile("s_waitcnt vmcnt(0)" ::: "memory")
__device__ __forceinline__ unsigned cvtpk(float lo, float hi) { unsigned r; asm volatile("v_cvt_pk_bf16_f32 %0, %1, %2" : "=v"(r) : "v"(lo), "v"(hi)); return r; }
typedef __bf16 bf16x2c_t __attribute__((ext_vector_type(2)));
__device__ __forceinline__ unsigned cvtpk_c(float lo, float hi) { typedef float f2c_ __attribute__((ext_vector_type(2))); return __builtin_bit_cast(unsigned, __builtin_convertvector((f2c_){lo, hi}, bf16x2c_t)); }
__device__ __forceinline__ float bflo(unsigned w) { return __uint_as_float(w << 16); }
__device__ __forceinline__ float bfhi(unsigned w) { return __uint_as_float(w & 0xffff0000u); }
__device__ __forceinline__ float logsig(float x) { return fminf(x, 0.f) - log1pf(__expf(-fabsf(x))); }
#define WDPP_(v, ctl) __builtin_bit_cast(float, __builtin_amdgcn_update_dpp(0, __builtin_bit_cast(int, (v)), (ctl), 0xF, 0xF, true))
__device__ __forceinline__ float wave_sum(float v) {
    v += WDPP_(v, 0xB1); v += WDPP_(v, 0x4E); v += WDPP_(v, 0x141); v += WDPP_(v, 0x128);
    v += __shfl_xor(v, 16); v += __shfl_xor(v, 32);
    return v;
}
__device__ __forceinline__ float row16_sum(float v) { v += WDPP_(v, 0xB1); v += WDPP_(v, 0x4E); v += WDPP_(v, 0x141); v += WDPP_(v, 0x128); return v; }
__device__ __forceinline__ float wave_max(float v) {
    v = fmaxf(v, WDPP_(v, 0xB1)); v = fmaxf(v, WDPP_(v, 0x4E)); v = fmaxf(v, WDPP_(v, 0x141)); v = fmaxf(v, WDPP_(v, 0x128));
    v = fmaxf(v, __shfl_xor(v, 16)); v = fmaxf(v, __shfl_xor(v, 32));
    return v;
}
#define XB_TMO      128
#define XB_XCNT(j)  (256  + 64 * (j))
#define XB_XSUB(j)  (1280 + 64 * (j))
#define XB_XGEN(j)  (2304 + 64 * (j))
#define XB_TOP      3328
#define XB_TOPGEN   3392
#define XCD_BAR_WORDS 3456
#define XB_SPIN_CAP (1u << 18)

__device__ __forceinline__ unsigned xb_ld(unsigned* p)              { return __hip_atomic_load(p, __ATOMIC_RELAXED, __HIP_MEMORY_SCOPE_AGENT); }
__device__ __forceinline__ unsigned xb_add(unsigned* p, unsigned v) { return __hip_atomic_fetch_add(p, v, __ATOMIC_RELAXED, __HIP_MEMORY_SCOPE_AGENT); }
__device__ __forceinline__ unsigned xb_xcc_id() { return (unsigned)__builtin_amdgcn_s_getreg((3 << 11) | 20) & 0xFu; }
#define XB_SPIN(cond, bar) do { unsigned _sp = 0; while (cond) { __builtin_amdgcn_s_sleep(1); \
    if ((++_sp & 255u) == 0u) { if (xb_ld(&(bar)[XB_TMO])) break; if (_sp > XB_SPIN_CAP) { atomicAdd(&(bar)[XB_TMO], 1u); break; } } } } while (0)

struct XcdBarrier {
    unsigned* bar; unsigned x;
    volatile LAS unsigned* st;
};

__device__ __forceinline__ XcdBarrier xcd_barrier_post(unsigned* bar, volatile LAS unsigned* st, const int tid_) {
    XcdBarrier b; b.bar = bar; b.x = xb_xcc_id(); b.st = st;
    if (tid_ == 0) (void)xb_add(&bar[XB_XCNT(b.x)], 1u);
    return b;
}
__device__ __forceinline__ void xcd_barrier_complete(unsigned* bar, unsigned x, unsigned& nloc, unsigned& nx) {
    const unsigned G = gridDim.x * gridDim.y * gridDim.z;
    unsigned sum, cnt, mine, sp = 0u;
    for (;;) {
        sum = 0u; cnt = 0u; mine = 0u;
#pragma unroll
        for (unsigned j = 0; j < 16; ++j) { const unsigned c = xb_ld(&bar[XB_XCNT(j)]); sum += c; cnt += (c > 0u) ? 1u : 0u; mine = (j == x) ? c : mine; }
        if (sum == G) break;
        __builtin_amdgcn_s_sleep(1);
        if ((++sp & 255u) == 0u) { if (xb_ld(&bar[XB_TMO])) break; if (sp > XB_SPIN_CAP) { atomicAdd(&bar[XB_TMO], 1u); break; } }
    }
    nloc = mine > 0u ? mine : 1u; nx = cnt > 0u ? cnt : 1u;
}

__device__ __forceinline__ void xcd_barrier(const XcdBarrier& b, const int tid_) {
    asm volatile("s_waitcnt vmcnt(0)" ::: "memory");
    __syncthreads();
    if (tid_ == 0) {
        unsigned* bar = b.bar;
        __builtin_amdgcn_s_waitcnt(0);
        unsigned nloc = b.st[0], nx = b.st[1];
        if (nloc == 0u) { xcd_barrier_complete(bar, b.x, nloc, nx); b.st[0] = nloc; b.st[1] = nx; }
        const unsigned old = xb_add(&bar[XB_XSUB(b.x)], 1u);
        const unsigned gen = old / nloc;
        if (old + 1u == (gen + 1u) * nloc) {
            __builtin_amdgcn_fence(__ATOMIC_RELEASE, "agent");
            asm volatile("s_waitcnt vmcnt(0)" ::: "memory");
            const unsigned og = xb_add(&bar[XB_TOP], 1u);
            const unsigned tg = og / nx;
            if (og + 1u == (tg + 1u) * nx) xb_add(&bar[XB_TOPGEN], 1u);
            else XB_SPIN(xb_ld(&bar[XB_TOPGEN]) == tg, bar);
            __builtin_amdgcn_fence(__ATOMIC_ACQUIRE, "agent");
            xb_add(&bar[XB_XGEN(b.x)], 1u);
            asm volatile("s_waitcnt vmcnt(0)" ::: "memory");
        } else {
            XB_SPIN(xb_ld(&bar[XB_XGEN(b.x)]) == gen, bar);
            __builtin_amdgcn_fence(__ATOMIC_ACQUIRE, "agent");
            asm volatile("s_waitcnt vmcnt(0)" ::: "memory");
        }
    }
    __syncthreads();
}

struct Args {
    const float* x; const float* norm1_w; const float* w_in; const float* fox_f_bias; const float* conv_w; const float* conv_b;
    const float* i_bias; const float* f_bias; const float* fox_nw; const float* ml_nw; const float* w_out; const float* norm2_w;
    const float* w_q; const float* keys; const float* pu; const float* pv; const float* final_w;
    float* out; unsigned char* ws; int ph_lo, ph_hi, li, pad;
};
typedef const __attribute__((address_space(4))) Args* KA;
typedef __bf16 bf2_t __attribute__((ext_vector_type(2)));
__device__ __forceinline__ float dot2bf(unsigned a, unsigned b, float c) { return __builtin_amdgcn_fdot2_f32_bf16(__builtin_bit_cast(bf2_t, a), __builtin_bit_cast(bf2_t, b), c, false); }
#define MFMA16(a, b, c) __builtin_amdgcn_mfma_f32_16x16x32_bf16((a), (b), (c), 0, 0, 0)
#define MFMA32(a, b, c) __builtin_amdgcn_mfma_f32_32x32x16_bf16((a), (b), (c), 0, 0, 0)

__device__ __forceinline__ void p0_transpose_item(const float* W, int ldw, int src_col, bf16* WT, int dst_row, int Kp, int k0, LAS float* scr, int lane) {
#pragma unroll 8
    for (int i = 0; i < 32; ++i) { const int kk = 2 * i + (lane >> 5); scr[kk * 33 + (lane & 31)] = W[(size_t)(k0 + kk) * ldw + src_col + (lane & 31)]; }
    LDS_WAIT(); asm volatile("" ::: "memory");
    const int c = lane & 7;
#pragma unroll
    for (int j = 0; j < 4; ++j) { const int n = (lane >> 3) + 8 * j; const LAS float* s = scr + (8 * c) * 33 + n;
        v4u o; o.x = cvtpk(s[0 * 33], s[1 * 33]); o.y = cvtpk(s[2 * 33], s[3 * 33]); o.z = cvtpk(s[4 * 33], s[5 * 33]); o.w = cvtpk(s[6 * 33], s[7 * 33]);
        *(GAS v4u*)(WT + (size_t)(dst_row + n) * Kp + k0 + 8 * c) = o; }
    LDS_WAIT(); asm volatile("" ::: "memory");
}
__device__ __forceinline__ void rms_row_to_bf16(const float* xrow, const f32x4 (&w)[8], bf16* orow, int lane) {
    const GAS f32x4* xr = (const GAS f32x4*)xrow + lane;
    f32x4 v[8]; float s = 0.f;
#pragma unroll
    for (int j = 0; j < 8; ++j) { v[j] = xr[64 * j]; s += (v[j].x * v[j].x + v[j].y * v[j].y) + (v[j].z * v[j].z + v[j].w * v[j].w); }
    const float rn = __builtin_amdgcn_rsqf(wave_sum(s) * (1.f / DM) + NORM_EPS);
    GAS v2u* o8 = (GAS v2u*)orow + lane;
#pragma unroll
    for (int j = 0; j < 8; ++j) { v2u o; o.x = cvtpk(v[j].x * rn * w[j].x, v[j].y * rn * w[j].y); o.y = cvtpk(v[j].z * rn * w[j].z, v[j].w * rn * w[j].w); o8[64 * j] = o; }
}
__device__ __forceinline__ void rms_phase(const float* X, const float* wv, bf16* O, int gw, int NGW, int lane) {
    f32x4 w[8];
#pragma unroll
    for (int j = 0; j < 8; ++j) w[j] = ((const f32x4*)wv)[64 * j + lane];
    for (int m = gw; m < T; m += NGW) rms_row_to_bf16(X + (size_t)m * DM, w, O + (size_t)m * DM, lane);
}
__device__ __forceinline__ void rms_gate_phase(const float* X, const float* wv, bf16* O, float* GATES, const LAS f32x4* WG, int gw, int NGW, int lane) {
    f32x4 w[8];
#pragma unroll
    for (int j = 0; j < 8; ++j) w[j] = ((const f32x4*)wv)[64 * j + lane];
    for (int m = gw; m < T; m += NGW) {
        const GAS f32x4* xr = (const GAS f32x4*)(X + (size_t)m * DM) + lane;
        f32x4 v[8]; float s = 0.f;
#pragma unroll
        for (int j = 0; j < 8; ++j) { v[j] = __builtin_nontemporal_load(xr + 64 * j); s += (v[j].x * v[j].x + v[j].y * v[j].y) + (v[j].z * v[j].z + v[j].w * v[j].w); }
        const float rn = __builtin_amdgcn_rsqf(wave_sum(s) * (1.f / DM) + NORM_EPS);
        GAS v2u* o8 = (GAS v2u*)(O + (size_t)m * DM) + lane;
        f32x4 acc[4];
#pragma unroll
        for (int c = 0; c < 4; ++c) acc[c] = (f32x4){0.f, 0.f, 0.f, 0.f};
#pragma unroll
        for (int j = 0; j < 8; ++j) { const f32x4 h = v[j] * rn * w[j];
            v2u o; o.x = cvtpk(h.x, h.y); o.y = cvtpk(h.z, h.w); o8[64 * j] = o;
#pragma unroll
            for (int i = 0; i < 4; ++i)
#pragma unroll
                for (int c = 0; c < 4; ++c) acc[c] += WG[((j * 4 + i) * 4 + c) * 64 + lane] * h[i]; }
        float k8[8], k4[4], k2[2], k1;
        const bool b5 = (lane & 32) != 0, b4 = (lane & 16) != 0, b3 = (lane & 8) != 0, b2 = (lane & 4) != 0;
#pragma unroll
        for (int i = 0; i < 8; ++i) { const float keep = b5 ? acc[2 + (i >> 2)][i & 3] : acc[i >> 2][i & 3], send = b5 ? acc[i >> 2][i & 3] : acc[2 + (i >> 2)][i & 3]; k8[i] = keep + __shfl_xor(send, 32); }
#pragma unroll
        for (int i = 0; i < 4; ++i) { const float keep = b4 ? k8[4 + i] : k8[i], send = b4 ? k8[i] : k8[4 + i]; k4[i] = keep + __shfl_xor(send, 16); }
#pragma unroll
        for (int i = 0; i < 2; ++i) { const float keep = b3 ? k4[2 + i] : k4[i], send = b3 ? k4[i] : k4[2 + i]; k2[i] = keep + __shfl_xor(send, 8); }
        { const float keep = b2 ? k2[1] : k2[0], send = b2 ? k2[0] : k2[1]; k1 = keep + __shfl_xor(send, 4); }
        k1 += __shfl_xor(k1, 2); k1 += __shfl_xor(k1, 1);
        if ((lane & 3) == 0) GATES[(size_t)m * 16 + (lane >> 2)] = k1;
    }
}
__device__ __forceinline__ void cvt_stream(const float* src, bf16* dst, size_t ngroups8, size_t gid, size_t nthr) {
    for (size_t g = gid; g < ngroups8; g += nthr) { const f32x4 a = ((const f32x4*)src)[2 * g], b = ((const f32x4*)src)[2 * g + 1];
        v4u o; o.x = cvtpk(a.x, a.y); o.y = cvtpk(a.z, a.w); o.z = cvtpk(b.x, b.y); o.w = cvtpk(b.z, b.w); ((v4u*)dst)[g] = o; }
}
__device__ __forceinline__ void quant_row_fp8(const float* src, unsigned char* dst, float* sc_out, int lane) {
    f32x4 v[2][4]; float am = 0.f;
#pragma unroll
    for (int j = 0; j < 2; ++j)
#pragma unroll
        for (int i = 0; i < 4; ++i) { v[j][i] = __builtin_nontemporal_load((const f32x4*)(src + 1024 * j + 16 * lane + 4 * i));
            am = fmaxf(am, fmaxf(fmaxf(fabsf(v[j][i].x), fabsf(v[j][i].y)), fmaxf(fabsf(v[j][i].z), fabsf(v[j][i].w)))); }
    am = wave_max(am);
    const float s = am > 0.f ? 224.f / am : 1.f;
#pragma unroll
    for (int j = 0; j < 2; ++j) { v4u o;
#pragma unroll
        for (int i = 0; i < 4; ++i) { int p = __builtin_amdgcn_cvt_pk_fp8_f32(v[j][i].x * s, v[j][i].y * s, 0, false); p = __builtin_amdgcn_cvt_pk_fp8_f32(v[j][i].z * s, v[j][i].w * s, p, true); o[i] = (unsigned)p; }
        __builtin_nontemporal_store(o, (v4u*)(dst + 1024 * j + 16 * lane)); }
    if (lane == 0) *sc_out = am > 0.f ? am * (1.f / 224.f) : 1.f;
}
__device__ __forceinline__ void p0_prologue(KA a, LAS unsigned char* lds, int tid, int lane, int wave, int vcu, int G) {
    unsigned char* ws = a->ws;
    bf16* WINT = (bf16*)(ws + WS_WINT); bf16* WOUTT = (bf16*)(ws + WS_WOUTT); bf16* WQT = (bf16*)(ws + WS_WQT);
    LAS float* scr = (LAS float*)(lds + wave * 16384);
    const int gw = vcu * NWAVES + wave, NGW = G * NWAVES;
    constexpr int I_IN = 32 * 192, I_SQ = 32 * 64;
    for (int it = gw; it < I_IN + 2 * I_SQ; it += NGW) {
        int r = it;
        if (r < I_IN) { const int kb = r / 192, nb = r % 192, n0 = nb * 32; const int src = n0 < 3072 ? n0 : (n0 < 5120 ? n0 + 8 : n0 + 16);
            p0_transpose_item(a->w_in, 6160, src, WINT, n0, DM, kb * 64, scr, lane); continue; }
        r -= I_IN;
        if (r < I_SQ) { p0_transpose_item(a->w_out, DM, (r % 64) * 32, WOUTT, (r % 64) * 32, DM, (r / 64) * 64, scr, lane); continue; }
        r -= I_SQ;
        p0_transpose_item(a->w_q, DM, (r % 64) * 32, WQT, (r % 64) * 32, DM, (r / 64) * 64, scr, lane);
    }
    const size_t gid = (size_t)vcu * NTHR + tid, nthr = (size_t)G * NTHR;
    cvt_stream(a->keys, (bf16*)(ws + WS_KEYS), 2 * 128 * 128 / 8, gid, nthr);
    { float* MSM = (float*)(ws + WS_MSM);
      for (int r = gw; r < 2 * 16384; r += NGW) { const int t = r >> 14, row = r & 16383;
          quant_row_fp8((t ? a->pv : a->pu) + (size_t)row * DM, ws + (t ? WS_VB : WS_UB) + (size_t)row * DM, MSM + (t ? MS_VSC : MS_USC) + row, lane); } }
    __syncthreads();
    { LAS float* WGf = (LAS float*)lds;
      for (int q = tid; q < 8 * 4 * 4 * 64 * 4; q += NTHR) { const int e4 = q & 3, ln = (q >> 2) & 63, c = (q >> 8) & 3, i = (q >> 10) & 3, j = q >> 12;
          const int k = 256 * j + 4 * ln + i, gt = 4 * c + e4, src = gt < 8 ? 3072 + gt : (gt < 12 ? 5128 + (gt - 8) : 5132 + (gt - 12));
          WGf[q] = a->w_in[(size_t)k * 6160 + src]; } }
    __syncthreads();
    rms_gate_phase(a->x, a->norm1_w, (bf16*)(ws + WS_H), (float*)(ws + WS_GATES), (const LAS f32x4*)lds, gw, NGW, lane);
}

__device__ __forceinline__ void fox_cumsum(KA a, LAS unsigned char* lds, int bh, int tid, int lane, int wave) {
    const float* GATES = (const float*)(a->ws + WS_GATES); float* F = (float*)(a->ws + WS_FCUM) + (size_t)bh * SEQ;
    const int b = bh >> 3, h = bh & 7; const float bias = a->fox_f_bias[h];
    LAS float* wt = (LAS float*)lds;
    float v[32]; float run = 0.f;
#pragma unroll
    for (int i = 0; i < 32; ++i) { run += logsig(GATES[((size_t)b * SEQ + tid * 32 + i) * 16 + h] + bias); v[i] = run; }
    float sc = run;
#pragma unroll
    for (int o = 1; o < 64; o <<= 1) { const float n = __shfl_up(sc, o); if (lane >= o) sc += n; }
    if (lane == 63) wt[wave] = sc;
    __syncthreads();
    float off = sc - run;
    for (int w = 0; w < wave; ++w) off += wt[w];
#pragma unroll
    for (int i = 0; i < 32; i += 4) *(f32x4*)(F + tid * 32 + i) = (f32x4){v[i] + off, v[i + 1] + off, v[i + 2] + off, v[i + 3] + off} * (-11.313708498984761f);
    __syncthreads();
}

__device__ __forceinline__ void fox_qk_norm_max(KA a, int bh, int part, int lane, int wave) {
    const bf16* base = (const bf16*)(a->ws + WS_FQ) + ((size_t)bh * SEQ + (size_t)part * 2048 + wave * 256) * 128;
    float qmx = 0.f, kmx = 0.f, dmn = 3.0e38f, tmx[4], fa = -3.0e38f, fb = -3.0e38f, fc = -3.0e38f;
#pragma unroll
    for (int tl = 0; tl < 4; ++tl) { float m4 = 0.f;
#pragma unroll 4
      for (int i16 = 0; i16 < 16; ++i16) { const int it = 16 * tl + i16; const v4u p = *(const v4u*)(base + (size_t)it * 512 + 8 * lane), kq = *(const v4u*)(base + ((size_t)1 << 25) + (size_t)it * 512 + 8 * lane);
        float s = 0.f, sk = 0.f, d = 0.f;
#pragma unroll
        for (int w = 0; w < 4; ++w) { const float lo = bflo(p[w]), hi = bfhi(p[w]), kl = bflo(kq[w]), kh = bfhi(kq[w]); s += lo * lo + hi * hi; sk += kl * kl + kh * kh; d += lo * kl + hi * kh; }
        s = row16_sum(s); sk = row16_sum(sk); d = row16_sum(d);
        qmx = fmaxf(qmx, s); m4 = fmaxf(m4, sk); dmn = fminf(dmn, d);
        const float qn = sqrtf(s); fa = fmaxf(fa, qn * QF_K0 - d); fb = fmaxf(fb, qn * QF_K1 - d); fc = fmaxf(fc, qn * QF_K2 - d); }
      tmx[tl] = wave_max(m4); kmx = fmaxf(kmx, tmx[tl]); }
    qmx = wave_max(qmx); dmn = -wave_max(-dmn); fa = wave_max(fa); fb = wave_max(fb); fc = wave_max(fc);
    if (lane == 0) { unsigned* qk = (unsigned*)(a->ws + WS_CTL) + CW_QKMAX + 2 * bh; atomicMax(qk, __float_as_uint(qmx)); atomicMax(qk + 1, __float_as_uint(kmx));
        float* M_ = (float*)(a->ws + WS_MSM); M_[MS_QBMAX + bh * 64 + part * 8 + wave] = qmx; M_[MS_QBDMIN + bh * 64 + part * 8 + wave] = dmn;
        *(f32x4*)(M_ + MS_QBF + 4 * (bh * 64 + part * 8 + wave)) = (f32x4){fa, fb, fc, 0.f};
        *(f32x4*)(M_ + MS_KTMAX + bh * 256 + (part * 8 + wave) * 4) = (f32x4){tmx[0], tmx[1], tmx[2], tmx[3]}; }
}
__device__ __forceinline__ void fox_jlo(KA a, int gid) {
    const int bh = gid >> 6, qb = gid & 63, P0 = qb * 256;
    const float* Fs = (const float*)(a->ws + WS_FCUM) + (size_t)bh * SEQ;
    const unsigned* qk = (const unsigned*)(a->ws + WS_CTL) + CW_QKMAX + 2 * bh;
    const float* M_ = (const float*)(a->ws + WS_MSM);
    const float qn = sqrtf(M_[MS_QBMAX + gid]), dmin = M_[MS_QBDMIN + gid]; const f32x4 qf = *(const f32x4*)(M_ + MS_QBF + 4 * gid);
    auto FB = [&](float K) { float v = qn * K - dmin;
        if (K >= QF_K0 && K <= QF_K1) v = fminf(v, qf[0] + (qf[1] - qf[0]) * ((K - QF_K0) * (1.f / (QF_K1 - QF_K0))));
        else if (K > QF_K1 && K <= QF_K2) v = fminf(v, qf[1] + (qf[2] - qf[1]) * ((K - QF_K1) * (1.f / (QF_K2 - QF_K1))));
        return 0.08838834764831845f * v; };
    const float thr = FB(sqrtf(__uint_as_float(qk[1]))) + 22.f, f0 = Fs[P0];
    int lo = 0, hi = P0 / 64;
    while (lo < hi) { const int mid = (lo + hi) >> 1; const float D = (f0 - Fs[64 * mid + 63]) * 0.08838834764831845f;
        if (D < thr) hi = mid; else lo = mid + 1; }
    { const float* KT = M_ + MS_KTMAX + bh * 256; float S_ = 4.6e-6f;
      const int nt_ = P0 / 64; bool stop_ = false;
      while (lo < nt_ && !stop_) { float fv_[8], kv_[8];
#pragma unroll
          for (int k = 0; k < 8; ++k) { const int j = lo + k < nt_ ? lo + k : nt_ - 1; fv_[k] = Fs[64 * j + 63]; kv_[k] = KT[j]; }
          const int lo0_ = lo;
#pragma unroll
          for (int k = 0; k < 8; ++k) if (!stop_ && lo0_ + k < nt_) { const float D = (f0 - fv_[k]) * 0.08838834764831845f, w_ = 64.f * __expf(FB(sqrtf(kv_[k])) - D);
              if (S_ + w_ > 2.5e-4f) stop_ = true; else { S_ += w_; ++lo; } } } }
    ((int*)(a->ws + WS_MSM))[MS_JLO + gid] = lo;
#ifdef PROBE_TILESUM
    atomicAdd((unsigned*)(a->ws + WS_CTL) + 3200, (unsigned)(P0 / 64 + 4 - lo));
#endif
}

constexpr int LP = 136;
__device__ __forceinline__ float silu(float x) { return x * __builtin_amdgcn_rcpf(1.f + __expf(-x)); }
__device__ __forceinline__ void chunk_gates(KA a, int t0, int h, int lane, float& b0, float& b1, float& i0, float& i1) {
    const float* GATES = (const float*)(a->ws + WS_GATES);
    const float* g0 = GATES + (size_t)(t0 + 2 * lane) * 16; const float ib = a->i_bias[h], fb = a->f_bias[h];
    i0 = g0[8 + h] + ib; i1 = g0[16 + 8 + h] + ib;
    const float l0 = logsig(g0[12 + h] + fb), l1 = logsig(g0[16 + 12 + h] + fb);
    float sc = l0 + l1;
#pragma unroll
    for (int o = 1; o < 64; o <<= 1) { const float n = __shfl_up(sc, o); if (lane >= o) sc += n; }
    b1 = sc; b0 = sc - l1;
}
__device__ __forceinline__ void stage_vt_chunk(const bf16* MV, int t0, int col, LAS bf16* VT, int erow, int lane) {
    const bf16* p = MV + (size_t)(t0 + 2 * lane) * 1024 + col;
    const v4u r0 = *(const v4u*)p, r1 = *(const v4u*)(p + 1024);
#pragma unroll
    for (int j = 0; j < 8; ++j) { const unsigned lo = (j & 1) ? (r0[j >> 1] >> 16) : (r0[j >> 1] & 0xffffu), hi = (j & 1) ? (r1[j >> 1] >> 16) : (r1[j >> 1] & 0xffffu);
        *(LAS unsigned*)(VT + (erow + j) * LP + 2 * lane) = lo | (hi << 16); }
}

__device__ __forceinline__ void mlstm_a_unit(KA a, LAS unsigned char* lds, int u, int tid, int lane, int wave) {
    const int bh = u >> 7, c = u & 127, b = bh >> 2, h = bh & 3, t0 = b * SEQ + c * 128;
    unsigned char* ws = a->ws; float* MSM = (float*)(ws + WS_MSM);
    LAS bf16* VT = (LAS bf16*)lds;
    LAS bf16* AKT = (LAS bf16*)(lds + 256 * LP * 2);
    LAS float* AE = (LAS float*)(lds + 384 * LP * 2);
    if (wave == 0) {
        float b0, b1, i0, i1; chunk_gates(a, t0, h, lane, b0, b1, i0, i1);
        const float bl = __shfl(b1, 63);
        const float w0 = bl - b0 + i0, w1 = bl - b1 + i1;
        const float ml = wave_max(fmaxf(w0, w1));
        AE[2 * lane] = __expf(w0 - ml); AE[2 * lane + 1] = __expf(w1 - ml);
        if (lane == 0) { MSM[MS_MLOC + u] = ml; MSM[MS_BLAST + u] = bl; }
    }
    __syncthreads();
    const bf16* MV = (const bf16*)(ws + WS_MV); const bf16* MK = (const bf16*)(ws + WS_MK);
#pragma unroll
    for (int i = 0; i < 4; ++i) { const int e0 = 8 * (4 * wave + i); stage_vt_chunk(MV, t0, h * 256 + e0, VT, e0, lane); }
    const float a0 = AE[2 * lane], a1 = AE[2 * lane + 1];
#pragma unroll
    for (int i = 0; i < 2; ++i) {
        const int d0 = 8 * (2 * wave + i), ch = 512 + h * 128 + d0;
        const bf16* p = MK + (size_t)(t0 + 2 * lane - 3) * 512 + h * 128 + d0;
        v4u rr[5];
#pragma unroll
        for (int r = 0; r < 5; ++r) { if (c * 128 + 2 * lane - 3 + r >= 0) rr[r] = *(const v4u*)(p + r * 512); else rr[r] = (v4u){0u, 0u, 0u, 0u}; }
#pragma unroll
        for (int jj = 0; jj < 8; ++jj) {
            float xv[5];
#pragma unroll
            for (int r = 0; r < 5; ++r) xv[r] = (jj & 1) ? bfhi(rr[r][jj >> 1]) : bflo(rr[r][jj >> 1]);
            const float cw0 = a->conv_w[ch + jj], cw1 = a->conv_w[1024 + ch + jj], cw2 = a->conv_w[2048 + ch + jj], cw3 = a->conv_w[3072 + ch + jj], cb = a->conv_b[ch + jj];
            const float y0 = cb + cw0 * xv[0] + cw1 * xv[1] + cw2 * xv[2] + cw3 * xv[3];
            const float y1 = cb + cw0 * xv[1] + cw1 * xv[2] + cw2 * xv[3] + cw3 * xv[4];
            const float k0 = silu(y0) * 0.08838834764831845f * a0, k1 = silu(y1) * 0.08838834764831845f * a1;
            *(LAS unsigned*)(AKT + (d0 + jj) * LP + 2 * lane) = cvtpk(k0, k1);
            const float ns = wave_sum(k0 + k1);
            if (lane == 0) MSM[MS_NLOC + u * 128 + d0 + jj] = ns;
        }
    }
    __syncthreads();
    f32x4 acc[2][8];
#pragma unroll
    for (int mi = 0; mi < 2; ++mi)
#pragma unroll
        for (int ni = 0; ni < 8; ++ni) acc[mi][ni] = (f32x4){0.f, 0.f, 0.f, 0.f};
    const int fr = lane & 15, fq = lane >> 4;
#pragma unroll
    for (int ks = 0; ks < 4; ++ks) {
        bf16x8 af[2], bf_[8];
#pragma unroll
        for (int mi = 0; mi < 2; ++mi) af[mi] = *(const LAS bf16x8*)(VT + (32 * wave + 16 * mi + fr) * LP + 32 * ks + 8 * fq);
#pragma unroll
        for (int ni = 0; ni < 8; ++ni) bf_[ni] = *(const LAS bf16x8*)(AKT + (16 * ni + fr) * LP + 32 * ks + 8 * fq);
#pragma unroll
        for (int mi = 0; mi < 2; ++mi)
#pragma unroll
            for (int ni = 0; ni < 8; ++ni) acc[mi][ni] = MFMA16(bf_[ni], af[mi], acc[mi][ni]);
    }
    bf16* Cout = (bf16*)(ws + WS_MIXED) + (size_t)u * 32768;
#pragma unroll
    for (int mi = 0; mi < 2; ++mi)
#pragma unroll
        for (int ni = 0; ni < 8; ++ni) { v2u o_; o_.x = cvtpk_c(acc[mi][ni][0], acc[mi][ni][1]); o_.y = cvtpk_c(acc[mi][ni][2], acc[mi][ni][3]);
            *(GAS v2u*)(Cout + (32 * wave + 16 * mi + fr) * 128 + 16 * ni + 4 * fq) = o_; }
    __syncthreads();
}

__device__ __forceinline__ void mlstm_scan(KA a, int vcu, int G, int tid) {
    unsigned char* ws = a->ws; float* MSM = (float*)(ws + WS_MSM);
    const unsigned* __restrict__ CL = (const unsigned*)(ws + WS_MIXED); unsigned* __restrict__ CP = (unsigned*)(ws + WS_CPREV);
    const float* __restrict__ MLp = MSM + MS_MLOC; const float* __restrict__ BLp = MSM + MS_BLAST; float* __restrict__ MPp = MSM + MS_MPREV;
    const int gid = vcu * NTHR + tid, nthr = G * NTHR;
    for (int pi = gid; pi < 8 * 16384; pi += nthr) {
        const int bh = pi >> 14, i2 = pi & 16383;
        float c0 = 0.f, c1 = 0.f, m = 0.f;
        const size_t ob = (size_t)bh * 128 * 16384 + i2;
#pragma unroll 1
        for (int cb = 0; cb < NCH; cb += 8) {
            unsigned clw[8]; float mlv[8], blv[8];
#pragma unroll
            for (int k = 0; k < 8; ++k) { clw[k] = CL[ob + (size_t)(cb + k) * 16384]; mlv[k] = MLp[bh * 128 + cb + k]; blv[k] = BLp[bh * 128 + cb + k]; }
#pragma unroll
            for (int k = 0; k < 8; ++k) { const int c = cb + k;
                CP[ob + (size_t)c * 16384] = cvtpk(c0, c1);
                if (i2 == 0) MPp[bh * 128 + c] = m;
                const float mn = fmaxf(blv[k] + m, mlv[k]), ap = __expf(blv[k] + m - mn), al = __expf(mlv[k] - mn);
                c0 = ap * c0 + al * bflo(clw[k]); c1 = ap * c1 + al * bfhi(clw[k]); m = mn; }
        }
    }
    if (gid < 1024) {
        const int bh = gid >> 7, d = gid & 127; float n = 0.f, m = 0.f;
        const float* __restrict__ NLp = MSM + MS_NLOC; float* __restrict__ NPp = MSM + MS_NPREV;
#pragma unroll 1
        for (int cb = 0; cb < NCH; cb += 8) { float nlv[8], mlv[8], blv[8];
#pragma unroll
            for (int k = 0; k < 8; ++k) { nlv[k] = NLp[(bh * 128 + cb + k) * 128 + d]; mlv[k] = MLp[bh * 128 + cb + k]; blv[k] = BLp[bh * 128 + cb + k]; }
#pragma unroll
            for (int k = 0; k < 8; ++k) { NPp[(bh * 128 + cb + k) * 128 + d] = n;
                const float mn = fmaxf(blv[k] + m, mlv[k]), ap = __expf(blv[k] + m - mn), al = __expf(mlv[k] - mn);
                n = ap * n + al * nlv[k]; m = mn; } }
    }
}

__device__ __forceinline__ void vt_chunk_load(const bf16* MV, int t0, int col, int lane, v4u& r0, v4u& r1) { const bf16* p = MV + (size_t)(t0 + 2 * lane) * 1024 + col; r0 = *(const v4u*)p; r1 = *(const v4u*)(p + 1024); }
__device__ __forceinline__ void vt_chunk_write(const v4u& r0, const v4u& r1, LAS bf16* VT, int erow, int lane) {
#pragma unroll
    for (int j = 0; j < 8; ++j) { const unsigned lo = (j & 1) ? (r0[j >> 1] >> 16) : (r0[j >> 1] & 0xffffu), hi = (j & 1) ? (r1[j >> 1] >> 16) : (r1[j >> 1] & 0xffffu);
        *(LAS unsigned*)(VT + (erow + j) * LP + 2 * lane) = lo | (hi << 16); }
}
__device__ __forceinline__ void stage_conv_rows(KA a, const bf16* src, int chbase, float scale, int t0, int c, int h, LAS bf16* dst, int tid) {
    const int d0 = (tid & 15) * 8, ch = chbase + h * 128 + d0;
    float cw[4][8], cb[8];
#pragma unroll
    for (int j = 0; j < 4; ++j) { const f32x4 w0 = *(const f32x4*)(a->conv_w + j * 1024 + ch), w1 = *(const f32x4*)(a->conv_w + j * 1024 + ch + 4);
        cw[j][0] = w0.x; cw[j][1] = w0.y; cw[j][2] = w0.z; cw[j][3] = w0.w; cw[j][4] = w1.x; cw[j][5] = w1.y; cw[j][6] = w1.z; cw[j][7] = w1.w; }
    { const f32x4 w0 = *(const f32x4*)(a->conv_b + ch), w1 = *(const f32x4*)(a->conv_b + ch + 4);
      cb[0] = w0.x; cb[1] = w0.y; cb[2] = w0.z; cb[3] = w0.w; cb[4] = w1.x; cb[5] = w1.y; cb[6] = w1.z; cb[7] = w1.w; }
#pragma unroll
    for (int it = 0; it < 4; ++it) {
        const int l = (it * 512 + tid) >> 4;
        const bf16* p = src + (size_t)(t0 + l - 3) * 512 + h * 128 + d0;
        v4u rr[4];
#pragma unroll
        for (int r = 0; r < 4; ++r) { if (c * 128 + l - 3 + r >= 0) rr[r] = *(const v4u*)(p + r * 512); else rr[r] = (v4u){0u, 0u, 0u, 0u}; }
        float y[8];
#pragma unroll
        for (int jj = 0; jj < 8; ++jj) { float s = cb[jj];
#pragma unroll
            for (int r = 0; r < 4; ++r) s += cw[r][jj] * ((jj & 1) ? bfhi(rr[r][jj >> 1]) : bflo(rr[r][jj >> 1]));
            y[jj] = silu(s) * scale; }
        v4u o; o.x = cvtpk(y[0], y[1]); o.y = cvtpk(y[2], y[3]); o.z = cvtpk(y[4], y[5]); o.w = cvtpk(y[6], y[7]);
        *(LAS v4u*)(dst + l * LP + d0) = o;
    }
}
__device__ __forceinline__ void mlstm_c_unit(KA a, LAS unsigned char* lds, int u, int tid, int lane, int wave) {
    const int bh = u >> 7, c = u & 127, b = bh >> 2, h = bh & 3, t0 = b * SEQ + c * 128;
    unsigned char* ws = a->ws; const float* MSM = (const float*)(ws + WS_MSM);
    LAS bf16* QL = (LAS bf16*)lds;
    LAS bf16* KL = (LAS bf16*)(lds + 128 * LP * 2);
    LAS bf16* VTH = (LAS bf16*)(lds + 256 * LP * 2);
    LAS bf16* CTH = (LAS bf16*)(lds + 384 * LP * 2);
    LAS float* AR = (LAS float*)(lds + 512 * LP * 2);
    if (wave == 0) {
        float b0, b1, i0, i1; chunk_gates(a, t0, h, lane, b0, b1, i0, i1);
        const float c0 = i0 - b0, c1 = i1 - b1, pmx = fmaxf(c0, c1);
        float sc = pmx;
#pragma unroll
        for (int o = 1; o < 64; o <<= 1) { const float n = __shfl_up(sc, o); if (lane >= o) sc = fmaxf(sc, n); }
        float ex = __shfl_up(sc, 1); if (lane == 0) ex = -__builtin_inff();
        const float pm0 = fmaxf(ex, c0), pm1 = sc;
        const float mp = MSM[MS_MPREV + u];
        const float g0 = b0 + mp, g1 = b1 + mp, mt0 = fmaxf(g0, b0 + pm0), mt1 = fmaxf(g1, b1 + pm1);
        AR[2 * lane] = b0 - mt0; AR[2 * lane + 1] = b1 - mt1;
        AR[128 + 2 * lane] = c0; AR[128 + 2 * lane + 1] = c1;
        AR[256 + 2 * lane] = __expf(g0 - mt0); AR[256 + 2 * lane + 1] = __expf(g1 - mt1);
        AR[384 + 2 * lane] = __expf(-mt0); AR[384 + 2 * lane + 1] = __expf(-mt1);
    }
    if (tid >= 64 && tid < 192) AR[512 + tid - 64] = MSM[MS_NPREV + u * 128 + tid - 64];
    const bf16* MV = (const bf16*)(ws + WS_MV); const bf16* CP = (const bf16*)(ws + WS_CPREV) + (size_t)u * 32768;
    v4u vr_[2][2], cr_[4];
#pragma unroll
    for (int i = 0; i < 2; ++i) vt_chunk_load(MV, t0, h * 256 + 8 * (2 * wave + i), lane, vr_[i][0], vr_[i][1]);
#pragma unroll
    for (int it = 0; it < 4; ++it) { const int q = it * 512 + tid; cr_[it] = *(const v4u*)(CP + (size_t)(q >> 4) * 128 + (q & 15) * 8); }
    stage_conv_rows(a, (const bf16*)(ws + WS_MQ), 0, 1.0f, t0, c, h, QL, tid);
    stage_conv_rows(a, (const bf16*)(ws + WS_MK), 512, 0.08838834764831845f, t0, c, h, KL, tid);
#pragma unroll
    for (int i = 0; i < 2; ++i) vt_chunk_write(vr_[i][0], vr_[i][1], VTH, 8 * (2 * wave + i), lane);
#pragma unroll
    for (int it = 0; it < 4; ++it) { const int q = it * 512 + tid; *(LAS v4u*)(CTH + (q >> 4) * LP + (q & 15) * 8) = cr_[it]; }
    __syncthreads();
    const bf16* MOp = (const bf16*)(ws + WS_MO) + (size_t)(t0 + 16 * wave + (lane & 15)) * 1024 + h * 256;
    v2u mo_[2][8];
#pragma unroll
    for (int i = 0; i < 2; ++i) vt_chunk_load(MV, t0, h * 256 + 128 + 8 * (2 * wave + i), lane, vr_[i][0], vr_[i][1]);
#pragma unroll
    for (int it = 0; it < 4; ++it) { const int q = it * 512 + tid; cr_[it] = *(const v4u*)(CP + (size_t)(128 + (q >> 4)) * 128 + (q & 15) * 8); }
#pragma unroll
    for (int hf = 0; hf < 2; ++hf)
#pragma unroll
        for (int ni = 0; ni < 8; ++ni) mo_[hf][ni] = *(const v2u*)(MOp + 128 * hf + 16 * ni + 4 * (lane >> 4));
    const int fr = lane & 15, fq = lane >> 4, t = 16 * wave + fr;
    f32x4 st[8];
#pragma unroll
    for (int ni = 0; ni < 8; ++ni) st[ni] = (f32x4){0.f, 0.f, 0.f, 0.f};
    bf16x8 qf[4];
#pragma unroll
    for (int ks = 0; ks < 4; ++ks) qf[ks] = *(const LAS bf16x8*)(QL + t * LP + 32 * ks + 8 * fq);
#pragma unroll
    for (int ks = 0; ks < 4; ++ks)
#pragma unroll
        for (int ni = 0; ni < 8; ++ni) { const bf16x8 kf = *(const LAS bf16x8*)(KL + (16 * ni + fr) * LP + 32 * ks + 8 * fq); st[ni] = MFMA16(kf, qf[ks], st[ni]); }
    float qn = 0.f;
#pragma unroll
    for (int j = 0; j < 4; ++j) { const v4u qq = *(const LAS v4u*)(QL + t * LP + 32 * fq + 8 * j);
#pragma unroll
        for (int w = 0; w < 4; ++w) { qn += bflo(qq[w]) * AR[512 + 32 * fq + 8 * j + 2 * w] + bfhi(qq[w]) * AR[512 + 32 * fq + 8 * j + 2 * w + 1]; } }
    qn += __shfl_xor(qn, 16); qn += __shfl_xor(qn, 32);
    const float rc = AR[t], inter = AR[256 + t], emt = AR[384 + t];
    float rs = 0.f;
#pragma unroll
    for (int ni = 0; ni < 8; ++ni) { const f32x4 cc = *(const LAS f32x4*)(AR + 128 + 16 * ni + 4 * fq);
#pragma unroll
        for (int r = 0; r < 4; ++r) { const int s = 16 * ni + 4 * fq + r; const float wgt = (s <= t) ? __expf(rc + cc[r]) : 0.f; const float v = st[ni][r] * wgt; st[ni][r] = v; rs += v; } }
    rs += __shfl_xor(rs, 16); rs += __shfl_xor(rs, 32);
    const float den = rs + inter * qn, inv = __builtin_amdgcn_rcpf(fmaxf(fabsf(den), emt));
    __syncthreads();
#pragma unroll
    for (int ni = 0; ni < 8; ++ni) { v2u o; o.x = cvtpk(st[ni][0], st[ni][1]); o.y = cvtpk(st[ni][2], st[ni][3]); *(LAS v2u*)(KL + t * LP + 16 * ni + 4 * fq) = o; }
    f32x4 hv[2][8];
#pragma unroll
    for (int hf = 0; hf < 2; ++hf) {
        if (hf == 1) {
#pragma unroll
            for (int i = 0; i < 2; ++i) vt_chunk_write(vr_[i][0], vr_[i][1], VTH, 8 * (2 * wave + i), lane);
#pragma unroll
            for (int it = 0; it < 4; ++it) { const int q = it * 512 + tid; *(LAS v4u*)(CTH + (q >> 4) * LP + (q & 15) * 8) = cr_[it]; }
        }
        __syncthreads();
        f32x4 a1[8], a2[8];
#pragma unroll
        for (int ni = 0; ni < 8; ++ni) { a1[ni] = (f32x4){0.f, 0.f, 0.f, 0.f}; a2[ni] = (f32x4){0.f, 0.f, 0.f, 0.f}; }
#pragma unroll
        for (int ks = 0; ks < 4; ++ks) {
            const bf16x8 sf = *(const LAS bf16x8*)(KL + t * LP + 32 * ks + 8 * fq);
#pragma unroll
            for (int ni = 0; ni < 8; ++ni) { const bf16x8 vf = *(const LAS bf16x8*)(VTH + (16 * ni + fr) * LP + 32 * ks + 8 * fq); a1[ni] = MFMA16(vf, sf, a1[ni]);
                const bf16x8 cf = *(const LAS bf16x8*)(CTH + (16 * ni + fr) * LP + 32 * ks + 8 * fq); a2[ni] = MFMA16(cf, qf[ks], a2[ni]); }
        }
#pragma unroll
        for (int ni = 0; ni < 8; ++ni) hv[hf][ni] = (a1[ni] + a2[ni] * inter) * inv;
        __syncthreads();
    }
    const bf16* MO = (const bf16*)(ws + WS_MO) + (size_t)(t0 + t) * 1024 + h * 256;
    float ss = 0.f;
#pragma unroll
    for (int hf = 0; hf < 2; ++hf)
#pragma unroll
        for (int ni = 0; ni < 8; ++ni) { const v2u g = mo_[hf][ni];
            const float g0 = bflo(g.x), g1 = bfhi(g.x), g2 = bflo(g.y), g3 = bfhi(g.y);
            f32x4 v = hv[hf][ni]; v[0] *= __builtin_amdgcn_rcpf(1.f + __expf(-g0)); v[1] *= __builtin_amdgcn_rcpf(1.f + __expf(-g1)); v[2] *= __builtin_amdgcn_rcpf(1.f + __expf(-g2)); v[3] *= __builtin_amdgcn_rcpf(1.f + __expf(-g3));
            hv[hf][ni] = v; ss += (v[0] * v[0] + v[1] * v[1]) + (v[2] * v[2] + v[3] * v[3]); }
    ss += __shfl_xor(ss, 16); ss += __shfl_xor(ss, 32);
    const float rn = __builtin_amdgcn_rsqf(ss * (1.f / 256.f) + NORM_EPS);
    bf16* MX = (bf16*)(ws + WS_MIXED) + (size_t)(t0 + t) * DM + 1024 + h * 256;
#pragma unroll
    for (int hf = 0; hf < 2; ++hf)
#pragma unroll
        for (int ni = 0; ni < 8; ++ni) { const int e = 128 * hf + 16 * ni + 4 * fq; const f32x4 w = *(const f32x4*)(a->ml_nw + h * 256 + e); const f32x4 v = hv[hf][ni];
            v2u o; o.x = cvtpk(v[0] * rn * w[0], v[1] * rn * w[1]); o.y = cvtpk(v[2] * rn * w[2], v[3] * rn * w[3]); *(v2u*)(MX + e) = o; }
}
__device__ __forceinline__ int sord(float f) { const int b = __float_as_int(f); return b ^ ((b >> 31) & 0x7fffffff); }
__device__ __forceinline__ float sdec(int v) { return __int_as_float(v ^ ((v >> 31) & 0x7fffffff)); }
#define PEER_INS(L, xin) do { int x_ = (xin); _Pragma("unroll") for (int i_ = 0; i_ < 16; ++i_) { const int hi_ = max(L[i_], x_); x_ = min(L[i_], x_); L[i_] = hi_; } } while (0)
__device__ __forceinline__ float gelu_erf(float v) { return 0.5f * v * (1.f + erff(v * 0.70710678118654752f)); }

#define CE_DESC(A, i, j) do { const int hi_ = max(A[i], A[j]), lo_ = min(A[i], A[j]); A[i] = hi_; A[j] = lo_; } while (0)
#define CE_ASC(A, i, j)  do { const int hi_ = max(A[i], A[j]), lo_ = min(A[i], A[j]); A[i] = lo_; A[j] = hi_; } while (0)
#define SORT16_DESC(A) do { CE_DESC(A, 0, 1); CE_ASC(A, 2, 3); CE_DESC(A, 4, 5); CE_ASC(A, 6, 7); CE_DESC(A, 8, 9); CE_ASC(A, 10, 11); CE_DESC(A, 12, 13); CE_ASC(A, 14, 15); CE_DESC(A, 0, 2); CE_DESC(A, 1, 3); CE_ASC(A, 4, 6); CE_ASC(A, 5, 7); CE_DESC(A, 8, 10); CE_DESC(A, 9, 11); CE_ASC(A, 12, 14); CE_ASC(A, 13, 15); CE_DESC(A, 0, 1); CE_DESC(A, 2, 3); CE_ASC(A, 4, 5); CE_ASC(A, 6, 7); CE_DESC(A, 8, 9); CE_DESC(A, 10, 11); CE_ASC(A, 12, 13); CE_ASC(A, 14, 15); CE_DESC(A, 0, 4); CE_DESC(A, 1, 5); CE_DESC(A, 2, 6); CE_DESC(A, 3, 7); CE_ASC(A, 8, 12); CE_ASC(A, 9, 13); CE_ASC(A, 10, 14); CE_ASC(A, 11, 15); CE_DESC(A, 0, 2); CE_DESC(A, 1, 3); CE_DESC(A, 4, 6); CE_DESC(A, 5, 7); CE_ASC(A, 8, 10); CE_ASC(A, 9, 11); CE_ASC(A, 12, 14); CE_ASC(A, 13, 15); CE_DESC(A, 0, 1); CE_DESC(A, 2, 3); CE_DESC(A, 4, 5); CE_DESC(A, 6, 7); CE_ASC(A, 8, 9); CE_ASC(A, 10, 11); CE_ASC(A, 12, 13); CE_ASC(A, 14, 15); CE_DESC(A, 0, 8); CE_DESC(A, 1, 9); CE_DESC(A, 2, 10); CE_DESC(A, 3, 11); CE_DESC(A, 4, 12); CE_DESC(A, 5, 13); CE_DESC(A, 6, 14); CE_DESC(A, 7, 15); CE_DESC(A, 0, 4); CE_DESC(A, 1, 5); CE_DESC(A, 2, 6); CE_DESC(A, 3, 7); CE_DESC(A, 8, 12); CE_DESC(A, 9, 13); CE_DESC(A, 10, 14); CE_DESC(A, 11, 15); CE_DESC(A, 0, 2); CE_DESC(A, 1, 3); CE_DESC(A, 4, 6); CE_DESC(A, 5, 7); CE_DESC(A, 8, 10); CE_DESC(A, 9, 11); CE_DESC(A, 12, 14); CE_DESC(A, 13, 15); CE_DESC(A, 0, 1); CE_DESC(A, 2, 3); CE_DESC(A, 4, 5); CE_DESC(A, 6, 7); CE_DESC(A, 8, 9); CE_DESC(A, 10, 11); CE_DESC(A, 12, 13); CE_DESC(A, 14, 15); } while (0)
#define BMERGE16_DESC(A) do { CE_DESC(A, 0, 8); CE_DESC(A, 1, 9); CE_DESC(A, 2, 10); CE_DESC(A, 3, 11); CE_DESC(A, 4, 12); CE_DESC(A, 5, 13); CE_DESC(A, 6, 14); CE_DESC(A, 7, 15); CE_DESC(A, 0, 4); CE_DESC(A, 1, 5); CE_DESC(A, 2, 6); CE_DESC(A, 3, 7); CE_DESC(A, 8, 12); CE_DESC(A, 9, 13); CE_DESC(A, 10, 14); CE_DESC(A, 11, 15); CE_DESC(A, 0, 2); CE_DESC(A, 1, 3); CE_DESC(A, 4, 6); CE_DESC(A, 5, 7); CE_DESC(A, 8, 10); CE_DESC(A, 9, 11); CE_DESC(A, 12, 14); CE_DESC(A, 13, 15); CE_DESC(A, 0, 1); CE_DESC(A, 2, 3); CE_DESC(A, 4, 5); CE_DESC(A, 6, 7); CE_DESC(A, 8, 9); CE_DESC(A, 10, 11); CE_DESC(A, 12, 13); CE_DESC(A, 14, 15); } while (0)
#define PEER_INS_FROM(L, xin, P0) do { int x_ = (xin); _Pragma("unroll") for (int i_ = (P0); i_ < 16; ++i_) { const int hi_ = max(L[i_], x_); x_ = min(L[i_], x_); L[i_] = hi_; } } while (0)

constexpr int KLP = 136;
__device__ __forceinline__ void peer_select(KA a, const LAS bf16* KL, int t0, int lane, int wave) {
    const bf16* PQ = (const bf16*)(a->ws + WS_PQ);
    const int c = lane & 31, hh = lane >> 5;
    int AB[2][16];
#pragma unroll
    for (int p = 0; p < 2; ++p) {
        bf16x8 qf[8];
#pragma unroll
        for (int ks = 0; ks < 8; ++ks) qf[ks] = *(const bf16x8*)(PQ + (size_t)(t0 + c) * DM + wave * 256 + p * 128 + 16 * ks + 8 * hh);
        int L[16];
#pragma unroll
        for (int i = 0; i < 16; ++i) L[i] = (int)0x80000000;
#pragma unroll 1
        for (int nt = 0; nt < 4; ++nt) {
            f32x16 acc;
#pragma unroll
            for (int r = 0; r < 16; ++r) acc[r] = 0.f;
#pragma unroll
            for (int ks = 0; ks < 8; ++ks) { const bf16x8 kf = *(const LAS bf16x8*)(KL + (p * 128 + 32 * nt + c) * KLP + 16 * ks + 8 * hh); acc = MFMA32(kf, qf[ks], acc); }
            int N[16];
#pragma unroll
            for (int r = 0; r < 16; ++r) N[r] = (sord(acc[r]) & ~127) | (32 * nt + (r & 3) + 8 * (r >> 2)) | (4 * hh);
            SORT16_DESC(N);
#pragma unroll
            for (int i = 0; i < 16; ++i) L[i] = max(L[i], N[15 - i]);
            BMERGE16_DESC(L);
        }
#pragma unroll
        for (int i = 0; i < 16; ++i) { const int o = __shfl_xor(L[15 - i], 32); AB[p][i] = max(L[i], o); }
        BMERGE16_DESC(AB[p]);
    }
    float va[16], vb[16];
#pragma unroll
    for (int i = 0; i < 16; ++i) { va[i] = sdec(AB[0][i] & ~127); vb[i] = sdec(AB[1][i] & ~127); }
    int L[16];
#pragma unroll
    for (int j = 0; j < 16; ++j) L[j] = (sord(va[0] + vb[j]) & ~255) | j;
#pragma unroll
    for (int i = 1; i < 16; ++i)
#pragma unroll
        for (int j = 0; j < 16; ++j) if ((i + 1) * (j + 1) <= 16) { const int key = (sord(va[i] + vb[j]) & ~255) | (i * 16 + j); PEER_INS_FROM(L, key, (i + 1) * (j + 1) - 1); }
    float rn2;
    { const f32x4* sp = (const f32x4*)((const float*)(a->ws + WS_SSQP) + (size_t)(t0 + c) * 32); float s_ = 0.f;
#pragma unroll
      for (int i = 0; i < 8; ++i) { const f32x4 v = sp[i]; s_ += (v[0] + v[1]) + (v[2] + v[3]); }
      rn2 = __builtin_amdgcn_rsqf(s_ * (1.f / DM) + NORM_EPS); }
    float sv[16]; float mx = -__builtin_inff();
#pragma unroll
    for (int k = 0; k < 16; ++k) { sv[k] = sdec(L[k] & ~255) * rn2; mx = fmaxf(mx, sv[k]); }
    float den = 0.f;
#pragma unroll
    for (int k = 0; k < 16; ++k) { sv[k] = __expf(sv[k] - mx); den += sv[k]; }
    const float rden = 1.f / den;
    int* PEI = (int*)(a->ws + WS_PEI) + (size_t)(t0 + c) * 128 + wave * 16; float* PEG = (float*)(a->ws + WS_PEG) + (size_t)(t0 + c) * 128 + wave * 16;
    int ev[16];
#pragma unroll
    for (int k = 0; k < 16; ++k) {
        const int id = L[k] & 255, ii = id >> 4, jj = id & 15;
        int ka = 0, kb = 0;
#pragma unroll
        for (int i = 0; i < 16; ++i) { ka = (ii == i) ? AB[0][i] : ka; kb = (jj == i) ? AB[1][i] : kb; }
        ev[k] = (ka & 127) * 128 + (kb & 127);
    }
    if (hh == 0) {
#pragma unroll
        for (int k = 0; k < 16; k += 4) *(v4u*)(PEI + k) = (v4u){(unsigned)ev[k], (unsigned)ev[k + 1], (unsigned)ev[k + 2], (unsigned)ev[k + 3]};
    } else {
#pragma unroll
        for (int k = 0; k < 16; k += 4) *(f32x4*)(PEG + k) = (f32x4){sv[k] * rden, sv[k + 1] * rden, sv[k + 2] * rden, sv[k + 3] * rden};
    }
}
__device__ __forceinline__ void peer_gather_token(KA a, size_t tok, int lane, const float pscale) {
    const bf16* XN = (const bf16*)(a->ws + WS_H); const unsigned char* U8 = a->ws + WS_UB; const unsigned char* V8 = a->ws + WS_VB;
    const float* MSM = (const float*)(a->ws + WS_MSM);
    float rn2;
    { const float pr = lane < 32 ? ((const float*)(a->ws + WS_SSQP))[tok * 32 + lane] : 0.f; rn2 = __builtin_amdgcn_rsqf(wave_sum(pr) * (1.f / DM) + NORM_EPS); }
    float xr[32];
#pragma unroll
    for (int j = 0; j < 2; ++j) { const v4u p0 = *(const v4u*)(XN + tok * DM + 1024 * j + 16 * lane), p1 = *(const v4u*)(XN + tok * DM + 1024 * j + 16 * lane + 8);
#pragma unroll
        for (int w = 0; w < 4; ++w) { xr[16 * j + 2 * w] = bflo(p0[w]) * rn2; xr[16 * j + 2 * w + 1] = bfhi(p0[w]) * rn2; xr[16 * j + 8 + 2 * w] = bflo(p1[w]) * rn2; xr[16 * j + 8 + 2 * w + 1] = bfhi(p1[w]) * rn2; } }
    const v2u ei = *(const v2u*)((const int*)(a->ws + WS_PEI) + tok * 128 + 2 * lane);
    const f32x2 gi = *(const f32x2*)((const float*)(a->ws + WS_PEG) + tok * 128 + 2 * lane);
    float y[32];
#pragma unroll
    for (int i = 0; i < 32; ++i) y[i] = 0.f;
    for (int k0 = 0; k0 < 128; k0 += 4) {
        int e[4]; float g[4];
#pragma unroll
        for (int q = 0; q < 4; ++q) { const int src = (k0 + q) >> 1;
            e[q] = __builtin_amdgcn_readlane((q & 1) ? (int)ei.y : (int)ei.x, src); g[q] = __int_as_float(__builtin_amdgcn_readlane(__float_as_int((q & 1) ? gi.y : gi.x), src)); }
        v4u ur[4][2], vr[4][2];
#pragma unroll
        for (int q = 0; q < 4; ++q)
#pragma unroll
            for (int j = 0; j < 2; ++j) ur[q][j] = *(const v4u*)(U8 + (size_t)e[q] * DM + 1024 * j + 16 * lane);
#pragma unroll
        for (int q = 0; q < 4; ++q)
#pragma unroll
            for (int j = 0; j < 2; ++j) vr[q][j] = *(const v4u*)(V8 + (size_t)e[q] * DM + 1024 * j + 16 * lane);
        float act[4];
#pragma unroll
        for (int q = 0; q < 4; ++q) { float d = 0.f;
#pragma unroll
            for (int j = 0; j < 2; ++j)
#pragma unroll
                for (int w = 0; w < 4; ++w) { const f32x2 lo = __builtin_amdgcn_cvt_pk_f32_fp8((int)ur[q][j][w], false), hi = __builtin_amdgcn_cvt_pk_f32_fp8((int)ur[q][j][w], true);
                    d += lo.x * xr[16 * j + 4 * w] + lo.y * xr[16 * j + 4 * w + 1] + hi.x * xr[16 * j + 4 * w + 2] + hi.y * xr[16 * j + 4 * w + 3]; }
            d = wave_sum(d) * MSM[MS_USC + e[q]]; act[q] = gelu_erf(d) * g[q] * MSM[MS_VSC + e[q]]; }
#pragma unroll
        for (int q = 0; q < 4; ++q)
#pragma unroll
            for (int j = 0; j < 2; ++j)
#pragma unroll
                for (int w = 0; w < 4; ++w) { const f32x2 lo = __builtin_amdgcn_cvt_pk_f32_fp8((int)vr[q][j][w], false), hi = __builtin_amdgcn_cvt_pk_f32_fp8((int)vr[q][j][w], true);
                    y[16 * j + 4 * w] += act[q] * lo.x; y[16 * j + 4 * w + 1] += act[q] * lo.y; y[16 * j + 4 * w + 2] += act[q] * hi.x; y[16 * j + 4 * w + 3] += act[q] * hi.y; }
    }
    float* orow = a->out + tok * DM; float ss = 0.f;
#pragma unroll
    for (int j = 0; j < 2; ++j)
#pragma unroll
        for (int i = 0; i < 4; ++i) { const f32x4 x0 = *(const f32x4*)(orow + 1024 * j + 16 * lane + 4 * i);
            y[16 * j + 4 * i] += x0.x; y[16 * j + 4 * i + 1] += x0.y; y[16 * j + 4 * i + 2] += x0.z; y[16 * j + 4 * i + 3] += x0.w; }
#pragma unroll
    for (int i = 0; i < 32; ++i) ss += y[i] * y[i];
    const float rn = __builtin_amdgcn_rsqf(wave_sum(ss) * (1.f / DM) + NORM_EPS) * pscale;
#pragma unroll
    for (int j = 0; j < 2; ++j)
#pragma unroll
        for (int i = 0; i < 4; ++i) { const f32x4 w0 = *(const f32x4*)(a->final_w + 1024 * j + 16 * lane + 4 * i);
            *(f32x4*)(orow + 1024 * j + 16 * lane + 4 * i) = (f32x4){y[16 * j + 4 * i] * rn * w0.x, y[16 * j + 4 * i + 1] * rn * w0.y, y[16 * j + 4 * i + 2] * rn * w0.z, y[16 * j + 4 * i + 3] * rn * w0.w}; }
}

__device__ __forceinline__ float dpp_sum8(float v) {
    v += __builtin_bit_cast(float, __builtin_amdgcn_update_dpp(0, __builtin_bit_cast(int, v), 0xB1, 0xF, 0xF, true));
    v += __builtin_bit_cast(float, __builtin_amdgcn_update_dpp(0, __builtin_bit_cast(int, v), 0x4E, 0xF, 0xF, true));
    v += __builtin_bit_cast(float, __builtin_amdgcn_update_dpp(0, __builtin_bit_cast(int, v), 0x141, 0xF, 0xF, true));
    return v; }
__device__ __forceinline__ float sum_x8_16_32(float v) {
    v += __builtin_bit_cast(float, __builtin_amdgcn_update_dpp(0, __builtin_bit_cast(int, v), 0x128, 0xF, 0xF, true));
    v += __shfl_xor(v, 16); v += __shfl_xor(v, 32);
    return v; }
__device__ __forceinline__ void peer_group(KA a, LAS unsigned char* lds, int g, int tid, int lane, int wave, const bool fin_, const int t0p_, const bool last_) {
    unsigned char* ws = a->ws;
    LAS float* FW = (LAS float*)(lds + 32768);
    LAS unsigned char* CH = lds + 40960 + wave * 1024;
    LAS float* RNF = (LAS float*)(lds + 156672);
    const GAS unsigned char* U8 = (const GAS unsigned char*)(ws + WS_UB); const GAS unsigned char* V8 = (const GAS unsigned char*)(ws + WS_VB);
    const float* MSM = (const float*)(ws + WS_MSM); const bf16* XW = (const bf16*)(ws + WS_H);
    LAS unsigned short* IDX = (LAS unsigned short*)lds; LAS unsigned short* GAh = (LAS unsigned short*)(lds + 16384); LAS float* DOT = (LAS float*)(lds + 49152);
    LAS float* SSQ = (LAS float*)(lds + 81920); LAS float* RN = (LAS float*)(lds + 82176);
    const int t0 = 64 * g;
    { int pe_[16]; float pg_[16];
#pragma unroll
      for (int i = 0; i < 16; ++i) { pe_[i] = __builtin_nontemporal_load((const GAS int*)(ws + WS_PEI) + (size_t)t0 * 128 + tid + NTHR * i); pg_[i] = __builtin_nontemporal_load((const GAS float*)(ws + WS_PEG) + (size_t)t0 * 128 + tid + NTHR * i); }
#pragma unroll
      for (int i = 0; i < 16; ++i) { const int q = tid + NTHR * i; IDX[q] = (unsigned short)pe_[i]; GAh[q] = (unsigned short)(cvtpk(pg_[i], 0.f) & 0xffffu); DOT[q] = 0.f; } }
    if (tid < 64) { const f32x4* sp = (const f32x4*)((const float*)(ws + WS_SSQP) + (size_t)(t0 + tid) * 32); float s_ = 0.f;
#pragma unroll
        for (int i = 0; i < 8; ++i) { const f32x4 v = sp[i]; s_ += (v[0] + v[1]) + (v[2] + v[3]); }
        RN[tid] = __builtin_amdgcn_rsqf(s_ * (1.f / DM) + NORM_EPS); SSQ[tid] = 0.f; }
    LAS float* XF = (LAS float*)(lds + 82432);
    GAS unsigned char* XQ = (GAS unsigned char*)(ws + WS_MIXED);
    v4u px_[8][4];
#pragma unroll
    for (int tt = 0; tt < 8; ++tt) { const GAS v4u* xp = (const GAS v4u*)((const GAS bf16*)XW + (size_t)(t0 + 8 * wave + tt) * DM + 32 * lane);
#pragma unroll
        for (int j = 0; j < 4; ++j) px_[tt][j] = __builtin_nontemporal_load(xp + j); }
#pragma unroll
    for (int tt = 0; tt < 8; ++tt) { const int tok = 8 * wave + tt;
        v4u p[4]; float am = 0.f;
#pragma unroll
        for (int j = 0; j < 4; ++j) { p[j] = px_[tt][j];
#pragma unroll
            for (int w = 0; w < 4; ++w) am = fmaxf(am, fmaxf(fabsf(bflo(p[j][w])), fabsf(bfhi(p[j][w])))); }
        am = wave_max(am); const float xf = am > 0.f ? 224.f / am : 1.f;
        v4u o[2];
#pragma unroll
        for (int j = 0; j < 4; ++j)
#pragma unroll
            for (int w = 0; w < 2; ++w) { int q_ = __builtin_amdgcn_cvt_pk_fp8_f32(bflo(p[j][2 * w]) * xf, bfhi(p[j][2 * w]) * xf, 0, false);
                q_ = __builtin_amdgcn_cvt_pk_fp8_f32(bflo(p[j][2 * w + 1]) * xf, bfhi(p[j][2 * w + 1]) * xf, q_, true); o[j >> 1][2 * (j & 1) + w] = (unsigned)q_; }
        GAS v4u* qp = (GAS v4u*)(XQ + (size_t)(t0 + tok) * DM + 32 * lane); qp[0] = o[0]; qp[1] = o[1];
        if (lane == 0) XF[tok] = am > 0.f ? am * (1.f / 224.f) : 1.f; }
    VM_WAIT();
    __builtin_amdgcn_fence(__ATOMIC_ACQUIRE, "agent");
    __syncthreads();
    const int el = lane >> 3, pc = lane & 7;
#ifndef PROBE_UREP
#define PROBE_UREP 1
#endif
#pragma unroll 1
    for (int rep_ = 0; rep_ < PROBE_UREP; ++rep_)
    { const int r16 = lane & 15, g4 = lane >> 4;
      if (rep_ > 0) { for (int q = lane; q < 1024; q += 64) DOT[8 * wave * 128 + q] = 0.f; LDS_WAIT(); }
      LAS unsigned char* ring = lds + 82944 + wave * 8192;
      LAS unsigned char* XB = lds + 148480 + wave * 1024;
      const unsigned c0_ = 16u * (unsigned)(pc ^ (el >> 1));
      const int ard_ = r16 * 128 + 16 * (g4 ^ (r16 >> 1));
      const GAS unsigned char* xq_ = XQ + (size_t)(t0 + 8 * wave + el) * DM + 16 * pc;
#define PU_DMA(pass_, tt_, unit_, slot_) do { const int ib_ = (8 * wave + (tt_)) * 128 + 16 * (unit_) + el; const unsigned e0_ = IDX[ib_], e1_ = IDX[ib_ + 8];       \
        const GAS unsigned char* ub_ = U8 + 128 * (pass_);                                                                                                         \
        __builtin_amdgcn_global_load_lds((const GAS unsigned*)(ub_ + (e0_ * 2048u + c0_)), (LAS unsigned*)(ring + (slot_) * 2048), 16, 0, 0);                       \
        __builtin_amdgcn_global_load_lds((const GAS unsigned*)(ub_ + (e1_ * 2048u + (c0_ ^ 64u))), (LAS unsigned*)(ring + (slot_) * 2048 + 1024), 16, 0, 0); } while (0)
#define PU_XDMA(pass_) __builtin_amdgcn_global_load_lds((const GAS unsigned*)(xq_ + 128 * (pass_)), (LAS unsigned*)XB, 16, 0, 0)
#define PU_XREAD(D0, D1, tt_) do { D0 = *(const LAS v4u*)(XB + (tt_) * 128 + 16 * g4); D1 = *(const LAS v4u*)(XB + (tt_) * 128 + 16 * g4 + 64); } while (0)
      v4u xc0, xc1, xn0, xn1; f32x4 pacc = (f32x4){0.f, 0.f, 0.f, 0.f}; LAS f32x4* pdst = (LAS f32x4*)(DOT + 8 * wave * 128 + 4 * g4);
      PU_XDMA(0);
#pragma unroll
      for (int u_ = 0; u_ < 4; ++u_) PU_DMA(0, 0, u_, u_);
      asm volatile("s_waitcnt vmcnt(8)" ::: "memory");
      PU_XREAD(xc0, xc1, 0);
      bool first_ = true;
      for (int pass = 0; pass < 16; ++pass)
#pragma unroll 1
        for (int tt = 0; tt < 8; ++tt) {
            const int ntt = (tt + 1) & 7, npass = (pass + (tt == 7 ? 1 : 0)) & 15;
#pragma unroll
            for (int unit = 0; unit < 8; ++unit) {
                __builtin_amdgcn_sched_barrier(0);
                asm volatile("s_waitcnt vmcnt(6)" ::: "memory");
                __builtin_amdgcn_sched_barrier(0);
                if (unit == 0 && fin_ && !(tt & 1)) { const int c_ = (pass * 8 + tt) >> 1;
                    __builtin_amdgcn_global_load_lds((const GAS unsigned*)((const GAS float*)a->out + (size_t)(t0p_ + 8 * wave + (c_ >> 3)) * DM + 256 * (c_ & 7) + 4 * lane), (LAS unsigned*)CH, 16, 0, 0); }
                if (unit == 6 && fin_ && !(tt & 1)) { const int c_ = (pass * 8 + tt) >> 1;
                    const f32x4 xv_ = *(const LAS f32x4*)(CH + 16 * lane), wv_ = *(const LAS f32x4*)(FW + 256 * (c_ & 7) + 4 * lane); const float rn_ = RNF[8 * wave + (c_ >> 3)];
                    __builtin_nontemporal_store(xv_ * rn_ * wv_, (GAS f32x4*)((GAS float*)a->out + (size_t)(t0p_ + 8 * wave + (c_ >> 3)) * DM + 256 * (c_ & 7) + 4 * lane)); }
                if (unit == 0 && tt == 7) PU_XDMA(npass);
                if (unit == 4) PU_XREAD(xn0, xn1, ntt);
                LAS unsigned char* sl_ = ring + (unit & 3) * 2048;
                const v4u a0_ = *(const LAS v4u*)(sl_ + ard_), a1_ = *(const LAS v4u*)(sl_ + (ard_ ^ 64));
                LAS f32x4* dst_ = (LAS f32x4*)(DOT + (8 * wave + tt) * 128 + 16 * unit + 4 * g4);
                f32x4 acc_ = *dst_;
                typedef int v8i_ __attribute__((ext_vector_type(8)));
                const v8i_ A_ = (v8i_){(int)a0_[0], (int)a0_[1], (int)a0_[2], (int)a0_[3], (int)a1_[0], (int)a1_[1], (int)a1_[2], (int)a1_[3]};
                const v8i_ B_ = (v8i_){(int)xc0[0], (int)xc0[1], (int)xc0[2], (int)xc0[3], (int)xc1[0], (int)xc1[1], (int)xc1[2], (int)xc1[3]};
                acc_ = __builtin_amdgcn_mfma_scale_f32_16x16x128_f8f6f4(A_, B_, acc_, 0, 0, 0, 0, 0, 0);
                __builtin_amdgcn_sched_barrier(0);
                asm volatile("" ::: "memory");
                if (unit < 4) PU_DMA(pass, tt, unit + 4, unit & 3); else PU_DMA(npass, ntt, unit - 4, unit & 3);
                __builtin_amdgcn_sched_barrier(0);
                if (!first_ && r16 == 0) *pdst = pacc;
                first_ = false; pacc = acc_; pdst = dst_;
            }
            xc0 = xn0; xc1 = xn1;
        }
      if (r16 == 0) *pdst = pacc;
      VM_WAIT();
#undef PU_DMA
#undef PU_XDMA
#undef PU_XREAD
    }
    LDS_WAIT();
    LAS float* AS = (LAS float*)(lds + 82688);
    LAS unsigned char* ACT8 = (LAS unsigned char*)DOT + 4096 * wave;
    for (int tt = 0; tt < 8; ++tt) { const int tok = 8 * wave + tt, q0 = tok * 128 + lane, q1 = q0 + 64; const unsigned e0 = IDX[q0], e1 = IDX[q1]; const float xsc_ = RN[tok] * XF[tok];
        const float a0 = gelu_erf(DOT[q0] * (MSM[MS_USC + e0] * xsc_)) * __uint_as_float((unsigned)GAh[q0] << 16) * MSM[MS_VSC + e0], a1 = gelu_erf(DOT[q1] * (MSM[MS_USC + e1] * xsc_)) * __uint_as_float((unsigned)GAh[q1] << 16) * MSM[MS_VSC + e1];
        const float am = wave_max(fmaxf(fabsf(a0), fabsf(a1))); const float sc = am > 0.f ? 224.f / am : 1.f;
        const int h_ = __builtin_amdgcn_cvt_pk_fp8_f32(a0 * sc, a1 * sc, 0, false);
        const float r0 = (a0 * sc - __builtin_amdgcn_cvt_f32_fp8(h_, 0)) * 16.f, r1 = (a1 * sc - __builtin_amdgcn_cvt_f32_fp8(h_, 1)) * 16.f;
        const int l_ = __builtin_amdgcn_cvt_pk_fp8_f32(r0, r1, 0, false);
        LDS_WAIT();
        LAS unsigned char* ap = ACT8 + 256 * tt + lane;
        ap[0] = (unsigned char)(h_ & 0xff); ap[64] = (unsigned char)((h_ >> 8) & 0xff); ap[128] = (unsigned char)(l_ & 0xff); ap[192] = (unsigned char)((l_ >> 8) & 0xff);
        if (lane == 0) AS[tok] = am > 0.f ? am * (1.f / 224.f) : 1.f; }
    LDS_WAIT();
#ifndef PROBE_VREP
#define PROBE_VREP 1
#endif
#pragma unroll 1
    for (int vrep_ = 0; vrep_ < PROBE_VREP; ++vrep_)
    { LAS unsigned char* ring = lds + 82944 + wave * 8192;
      LAS unsigned char* XO = lds + 148480 + wave * 1024;
      const int r16 = lane & 15, g4 = lane >> 4;
      const unsigned c0_ = 16u * (unsigned)(pc ^ (el >> 1));
      GAS float* obase = (GAS float*)(vrep_ == PROBE_VREP - 1 ? (unsigned char*)a->out : ws + WS_MQ) + (size_t)(t0 + 8 * wave) * DM + lane;
#define PV_DMA(pass_, tt_, unit_, slot_) do { const int ib_ = (8 * wave + (tt_)) * 128 + 16 * (unit_) + el; const unsigned e0_ = IDX[ib_], e1_ = IDX[ib_ + 8];       \
        const GAS unsigned char* vb_ = V8 + 128 * (pass_);                                                                                                         \
        __builtin_amdgcn_global_load_lds((const GAS unsigned*)(vb_ + (e0_ * 2048u + c0_)), (LAS unsigned*)(ring + (slot_) * 2048), 16, 0, 0);                       \
        __builtin_amdgcn_global_load_lds((const GAS unsigned*)(vb_ + (e1_ * 2048u + (c0_ ^ 64u))), (LAS unsigned*)(ring + (slot_) * 2048 + 1024), 16, 0, 0); } while (0)
      typedef int v2i_ __attribute__((ext_vector_type(2)));
      const int rr_ = 8 * (g4 & 1) + (r16 >> 1);
      const int trb_ = (int)(unsigned long)(ring + (g4 >> 1) * 2048 + rr_ * 128 + 8 * (r16 & 1));
      int tra_[8];
#pragma unroll
      for (int t = 0; t < 8; ++t) tra_[t] = trb_ + 16 * (t ^ (rr_ >> 1));
      const LAS unsigned char* aab_ = ACT8 + 128 * (r16 & 1) + 8 * g4;
      f32x4 acc[8];
#pragma unroll
      for (int t = 0; t < 8; ++t) acc[t] = (f32x4){0.f, 0.f, 0.f, 0.f};
#pragma unroll
      for (int u_ = 0; u_ < 4; ++u_) PV_DMA(0, 0, u_, u_);
      for (int pass = 0; pass < 16; ++pass)
#pragma unroll 1
        for (int tt = 0; tt < 8; ++tt) {
            const int ntt = (tt + 1) & 7, npass = (pass + (tt == 7 ? 1 : 0)) & 15;
            const bool first_ = (pass | tt) == 0;
#pragma unroll
            for (int c = 0; c < 4; ++c) {
                __builtin_amdgcn_sched_barrier(0);
                if (c == 0) { if (first_) asm volatile("s_waitcnt vmcnt(4)" ::: "memory"); else asm volatile("s_waitcnt vmcnt(6)" ::: "memory"); }
                else if (c == 1) { if (first_) asm volatile("s_waitcnt vmcnt(5)" ::: "memory"); else asm volatile("s_waitcnt vmcnt(7)" ::: "memory"); }
                else asm volatile("s_waitcnt vmcnt(4)" ::: "memory");
                __builtin_amdgcn_sched_barrier(0);
                if (c == 0) __builtin_amdgcn_global_load_lds((const GAS unsigned*)((const GAS float*)a->out + (size_t)(t0 + 8 * wave + tt) * DM + 128 * pass + 4 * (lane & 31)), (LAS unsigned*)XO, 16, 0, 0);
                __builtin_amdgcn_sched_barrier(0);
                const v2i_ av_ = *(const LAS v2i_*)(aab_ + 256 * tt + 32 * c);
                const long A_ = (long)(((unsigned long long)(unsigned)av_[1] << 32) | (unsigned)av_[0]);
                long B_[8];
#pragma unroll
                for (int t = 0; t < 8; ++t) asm volatile("ds_read_b64_tr_b8 %0, %1 offset:%2" : "=&v"(B_[t]) : "v"(tra_[t]), "i"(4096 * (c & 1)) : "memory");
                asm volatile("s_waitcnt lgkmcnt(0)" ::: "memory");
                __builtin_amdgcn_sched_barrier(0);
#pragma unroll
                for (int t = 0; t < 8; ++t) acc[t] = __builtin_amdgcn_mfma_f32_16x16x32_fp8_fp8(A_, B_[t], acc[t], 0, 0, 0);
                __builtin_amdgcn_sched_barrier(0);
                asm volatile("" ::: "memory");
                if (c < 2) { PV_DMA(pass, tt, 2 * c + 4, 2 * (c & 1)); PV_DMA(pass, tt, 2 * c + 5, 2 * (c & 1) + 1); }
                else { PV_DMA(npass, ntt, 2 * c - 4, 2 * (c & 1)); PV_DMA(npass, ntt, 2 * c - 3, 2 * (c & 1) + 1); }
                __builtin_amdgcn_sched_barrier(0);
            }
            { const int tok_ = 8 * wave + tt; float yl_[4], yh_[4];
#pragma unroll
              for (int t = 0; t < 4; ++t) { yl_[t] = acc[t][0] + acc[t][1] * 0.0625f; yh_[t] = acc[t + 4][0] + acc[t + 4][1] * 0.0625f; }
              const float ylo_ = g4 == 0 ? yl_[0] : g4 == 1 ? yl_[1] : g4 == 2 ? yl_[2] : yl_[3], yhi_ = g4 == 0 ? yh_[0] : g4 == 1 ? yh_[1] : g4 == 2 ? yh_[2] : yh_[3];
              const float inv_ = AS[tok_]; const LAS float* xop_ = (const LAS float*)XO + lane;
              const float x0_ = xop_[0] + ylo_ * inv_, x1_ = xop_[64] + yhi_ * inv_;
              GAS float* op = obase + (size_t)tt * DM + 128 * pass; op[0] = x0_; op[64] = x1_;
              float ss = x0_ * x0_ + x1_ * x1_; ss = dpp_sum8(ss); ss = sum_x8_16_32(ss);
              if (lane == 0 && vrep_ == PROBE_VREP - 1) SSQ[tok_] += ss;
#pragma unroll
              for (int t = 0; t < 8; ++t) acc[t] = (f32x4){0.f, 0.f, 0.f, 0.f}; }
        }
      VM_WAIT();
#undef PV_DMA
    }
    VM_WAIT(); LDS_WAIT();
    __builtin_amdgcn_fence(__ATOMIC_ACQUIRE, "agent");
    if (!last_) { if (lane < 8) RNF[8 * wave + lane] = __builtin_amdgcn_rsqf(SSQ[8 * wave + lane] * (1.f / DM) + NORM_EPS); }
    else
    for (int tt = 0; tt < 8; ++tt) { const int tok = 8 * wave + tt; const float rn = __builtin_amdgcn_rsqf(SSQ[tok] * (1.f / DM) + NORM_EPS);
        float* orow = a->out + (size_t)(t0 + tok) * DM;
#pragma unroll
        for (int j = 0; j < 8; ++j) { const f32x4 x = *(const f32x4*)(orow + 256 * j + 4 * lane), w = *(const f32x4*)(a->final_w + 256 * j + 4 * lane);
            __builtin_nontemporal_store((f32x4){x[0] * rn * w[0], x[1] * rn * w[1], x[2] * rn * w[2], x[3] * rn * w[3]}, (f32x4*)(orow + 256 * j + 4 * lane)); } }
    __syncthreads();
}

constexpr int FOX_SEGT = 1024;
__global__ void __launch_bounds__(NTHR, 2) fwd_kernel(Args args) {
    extern __shared__ __attribute__((aligned(16))) unsigned char lds_raw[];
    LAS unsigned char* lds = (LAS unsigned char*)lds_raw;
    volatile LAS unsigned* MISC = (volatile LAS unsigned*)(lds + MISC_OFF);
    const int wave = __builtin_amdgcn_readfirstlane((int)threadIdx.x >> 6) & 7;
#define TIDS() const int lane = mk_lane_id(), tid = wave * 64 + lane
    const int tid0 = wave * 64 + mk_lane_id();
    const int G = gridDim.x; const int bx = blockIdx.x; const int vcu = (G % 8 == 0) ? (bx % 8) * (G / 8) + bx / 8 : bx;
    KA ka = (KA)__builtin_amdgcn_kernarg_segment_ptr();
#define KARGS(name) KA name = ka; asm volatile("" : "+s"(name))
    gu32* ctl; { KARGS(a_); ctl = (gu32*)(a_->ws + WS_CTL); }
    if (tid0 < 64) MISC[tid0] = 0u;
    __syncthreads();
    (void)xcd_barrier_post((unsigned*)ctl + CW_BAR + args.li * XCD_BAR_WORDS, MISC + 8, tid0);
#if MK_N_LAUNCHES == 1
    constexpr int lo = 0, hi = 10;
#else
    const int lo = args.ph_lo, hi = args.ph_hi;
#endif
#ifndef PH_MASK
#define PH_MASK 0x3ff
#endif
#define IN(k) (((PH_MASK >> (k)) & 1) && lo <= (k) && (k) < hi)
#define BOTH(k) (IN(k) && IN((k) + 1))
#ifdef PROBE_K
    int n_stamp = 1; unsigned long long* stamps = (unsigned long long*)(args.ws + WS_CTL + 32768);
    if (bx == 0 && tid0 == 0) stamps[0] = __builtin_amdgcn_s_memrealtime();
#define GRID_BAR() do { xcd_barrier(bar, wave * 64 + mk_lane_id()); if (bx == 0 && wave == 0 && mk_lane_id() == 0) { stamps[n_stamp] = __builtin_amdgcn_s_memrealtime(); } ++n_stamp; } while (0)
#else
#define GRID_BAR() do { KARGS(b_); XcdBarrier bb_; bb_.bar = (unsigned*)(b_->ws + WS_CTL) + CW_BAR + b_->li * XCD_BAR_WORDS; bb_.x = xb_xcc_id(); bb_.st = MISC + 8; xcd_barrier(bb_, wave * 64 + mk_lane_id()); } while (0)
#endif

    if (IN(0)) { KARGS(a_); TIDS(); p0_prologue(a_, lds, tid, lane, wave, vcu, G); if (BOTH(0)) GRID_BAR(); }

    if (IN(1)) {
        KARGS(a_); unsigned char* ws = a_->ws;
        pg8::Gemm g{(const pg8::bf16_t*)(ws + WS_H), (const pg8::bf16_t*)(ws + WS_WINT), T, NZ, DM}; pg8::StaticOrder S; S.init(T, NZ, G, bx);
        static_assert(WS_FK - WS_FQ == (1u << 26) && WS_FV - WS_FK == (1u << 26) && WS_MK - WS_MQ == (1u << 25) && WS_MO - WS_MV == (1u << 26), "EpiZ strides");
        pg8::EpiZ E{ws, WS_FQ, WS_MQ, WS_MV, WS_GATES};
        pg8::gemm_phase<pg8::EpiZ, pg8::StaticOrder, true, true>(lds, g, S, E, wave);
        if (BOTH(1)) GRID_BAR();
    }

    if (IN(2)) {
        KARGS(a_); TIDS();
        for (int s = bx; s < 16; s += G) fox_cumsum(a_, lds, s, tid, lane, wave);
        for (int w = bx; w < 128; w += G) fox_qk_norm_max(a_, w & 15, w >> 4, lane, wave);
        { unsigned* q2 = (unsigned*)(a_->ws + WS_CTL) + CW_QUEUE + 64;
          for (int u = vcu; u < 8 * NCH;) { mlstm_a_unit(a_, lds, u, tid, lane, wave);
              if (tid == 0) MISC[24] = __hip_atomic_fetch_add(q2, 1u, RLX_AGENT) + (unsigned)G;
              __syncthreads(); u = __builtin_amdgcn_readfirstlane((int)MISC[24]); } }
        if (BOTH(2)) GRID_BAR();
    }

    if (IN(3)) { KARGS(a_); TIDS(); { const int gid = bx * NTHR + tid; if (gid < 1024) fox_jlo(a_, gid); } mlstm_scan(a_, vcu, G, tid); if (BOTH(3)) GRID_BAR(); }

    if (IN(4)) {
        KARGS(a_); unsigned char* ws = a_->ws;
        unsigned* qhead = (unsigned*)(ws + WS_CTL) + CW_QUEUE;
        const int p4mode = args.pad;
        int i_cur = bx;
#ifndef NO_ATT
        if (p4mode != 2) {
            using namespace fox;
            typedef __hip_bfloat16 hb;
            static_assert(WS_FK - WS_FQ == (size_t)2 << 25 && WS_FV - WS_FK == (size_t)2 << 25 && WS_FK == FOX_WS_K && WS_MIXED == FOX_WS_O && WS_CTL == 0 && CW_SEGDONE == FOX_CW_DONE && WS_H == SLOT_LO_OFF && WS_END == SLOT_HI_OFF, "the attention body's view of the d_ws map");
            const FoxBases fb{(const float*)(ws + WS_FCUM), a_->fox_nw, ws};
            volatile LAS int* PT = (volatile LAS int*)(lds + 143360);
            if (FOX_SEGT < 260) {
                const int lane = mk_lane_id(), tid = wave * 64 + lane; const int* JLO = (const int*)(ws + WS_MSM) + MS_JLO;
                int ns[2], sl[2];
#pragma unroll
                for (int e = 0; e < 2; ++e) { const int i = 2 * tid + e, h_ = 7 - (i >> 7), b_ = i & 1, qb_ = 63 - ((i & 127) >> 1); const int nt_ = 4 * qb_ + 4 - JLO[(b_ * 8 + h_) * 64 + qb_];
                    ns[e] = (nt_ + FOX_SEGT - 1) / FOX_SEGT; sl[e] = ns[e] > 1 ? ns[e] : 0; }
                int sc = ns[0] + ns[1], sc2 = sl[0] + sl[1];
#pragma unroll
                for (int o = 1; o < 64; o <<= 1) { const int n = __shfl_up(sc, o), n2 = __shfl_up(sc2, o); if (lane >= o) { sc += n; sc2 += n2; } }
                if (lane == 63) { PT[2060 + wave] = sc; PT[2070 + wave] = sc2; }
                __syncthreads();
                int off = sc - ns[0] - ns[1], off2 = sc2 - sl[0] - sl[1];
                for (int w = 0; w < wave; ++w) { off += PT[2060 + w]; off2 += PT[2070 + w]; }
                PT[2 * tid + 1] = off + ns[0]; PT[2 * tid + 2] = off + ns[0] + ns[1]; if (tid == 0) PT[0] = 0;
                PT[1030 + 2 * tid + 1] = off2 + sl[0]; PT[1030 + 2 * tid + 2] = off2 + sl[0] + sl[1]; if (tid == 0) PT[1030] = 0;
                __syncthreads();
            }
            const int n_att = FOX_SEGT < 260 ? __builtin_amdgcn_readfirstlane(PT[1024]) : 1024;
            struct FoxNext {
                unsigned* qhead; volatile LAS unsigned* slots; volatile LAS int* PT; unsigned char* ws; int G, wave, par, n_att, p4m;
                __device__ __forceinline__ void decode(BlockRef<hb, hb>& r, int it) const {
                    int i = it, p0 = it, nseg = 1;
                    if (FOX_SEGT < 260) { int lo = 0, hi2 = 1024;
                        while (hi2 - lo > 1) { const int mid = (lo + hi2) >> 1; if (__builtin_amdgcn_readfirstlane(PT[mid]) <= it) lo = mid; else hi2 = mid; }
                        i = lo; p0 = __builtin_amdgcn_readfirstlane(PT[i]); nseg = __builtin_amdgcn_readfirstlane(PT[i + 1]) - p0; }
                    const int sg = it - p0;
                    const int h_ = 7 - (i >> 7), b_ = i & 1, qb_ = 63 - ((i & 127) >> 1), bh_ = b_ * 8 + h_;
                    const int jl = ((const int*)(ws + WS_MSM))[MS_JLO + bh_ * 64 + qb_], jh = 4 * qb_ + 4, L = (jh - jl + nseg - 1) / nseg;
                    r.P0 = qb_ * QB; r.bh = bh_; r.kvbh = p4m == 5 ? 0 : bh_; r.omib = p4m == 5 ? 128 : 0; r.jlo = jl + sg * L; r.jhi = (r.jlo + L < jh) ? r.jlo + L : jh;
                    r.kind = nseg == 1 ? 0 : (sg == nseg - 1 ? 2 : 1); r.nprev = nseg - 1; r.slot0 = FOX_SEGT < 260 ? __builtin_amdgcn_readfirstlane(PT[1030 + i]) + sg : 0; r.bi = i; }
                __device__ __forceinline__ void claim() const { if (wave == 0 && mk_lane_id() == 0) slots[par] = __hip_atomic_fetch_add(qhead, 1u, RLX_AGENT) + (unsigned)G; }
                __device__ __forceinline__ int resolve(BlockRef<hb, hb>& nxt, const BlockRef<hb, hb>& cur) const {
                    const int idx = __builtin_amdgcn_readfirstlane((int)slots[par]); if (idx < n_att) decode(nxt, idx); else nxt = cur; return idx; }
            };
            FoxNext NX{qhead, MISC + 18, PT, ws, G, wave, 0, n_att, p4mode};
            BlockRef<hb, hb> cur; NX.decode(cur, i_cur);
            Seam<hb> Sm;
            causal_swa_prime<hb, hb>(cur, fb, SEQ, (char*)lds_raw, Sm, wave);
            for (;;) {
                BlockRef<hb, hb> nxt; int nidx;
                causal_swa_block<hb, hb, FoxNext>(cur, nxt, nidx, NX, fb, SEQ, SEQ, (char*)lds_raw, Sm, wave);
                NX.par ^= 1;
                i_cur = nidx - n_att;
                if (nidx >= n_att) break;
                cur = nxt;
            }
        }
#endif
        VM_WAIT(); __syncthreads();
        if (p4mode == 2) i_cur = vcu;
        const int n_att2 = FOX_SEGT < 260 ? __builtin_amdgcn_readfirstlane(((volatile LAS int*)(lds + 143360))[1024]) : 1024;
#ifndef NO_MLC
        for (int par = 0; i_cur < 1024 && p4mode != 1 && p4mode != 5; par ^= 1) {
            const int lane = mk_lane_id(), tid = wave * 64 + lane;
            mlstm_c_unit(a_, lds, i_cur, tid, lane, wave);
            if (tid == 0) MISC[20 + par] = __hip_atomic_fetch_add(qhead, 1u, RLX_AGENT) + (unsigned)G;
            __syncthreads();
            i_cur = p4mode == 2 ? i_cur + G : __builtin_amdgcn_readfirstlane((int)MISC[20 + par]) - n_att2;
        }
#endif
        if (BOTH(4)) GRID_BAR();
    }

    if (IN(5)) {
        KARGS(a_); unsigned char* ws = a_->ws;
        pg8::Gemm g{(const pg8::bf16_t*)(ws + WS_MIXED), (const pg8::bf16_t*)(ws + WS_WOUTT), T, DM, DM}; pg8::StaticOrder S; S.init(T, DM, G, bx);
        pg8::EpiRes E{a_->x, a_->out, DM, a_->norm2_w, (pg8::bf16_t*)(ws + WS_H), (float*)(ws + WS_SSQP)};
        pg8::gemm_phase<pg8::EpiRes, pg8::StaticOrder, true, true>(lds, g, S, E, wave);
        if (BOTH(5)) GRID_BAR();
    }


    if (IN(7)) {
        KARGS(a_); unsigned char* ws = a_->ws;
        pg8::Gemm g{(const pg8::bf16_t*)(ws + WS_H), (const pg8::bf16_t*)(ws + WS_WQT), T, DM, DM}; pg8::StaticOrder S; S.init(T, DM, G, bx);
        pg8::EpiBf16<0> E{(pg8::bf16_t*)(ws + WS_PQ), DM, nullptr, 0, 0, 1.f};
        pg8::gemm_phase<pg8::EpiBf16<0>, pg8::StaticOrder, true, true>(lds, g, S, E, wave);
        if (BOTH(7)) GRID_BAR();
    }

    if (IN(8)) {
        KARGS(a_); TIDS();
        { const bf16* KEYS = (const bf16*)(a_->ws + WS_KEYS);
          for (int q = tid; q < 2 * 128 * 16; q += NTHR) { const int row = q >> 4, ch = q & 15; *(LAS v4u*)(lds + (row * KLP + ch * 8) * 2) = *(const v4u*)(KEYS + row * 128 + ch * 8); } }
        __syncthreads();
        for (int g = vcu; g < T / 64; g += G) { peer_select(a_, (const LAS bf16*)lds, g * 64, lane, wave); peer_select(a_, (const LAS bf16*)lds, g * 64 + 32, lane, wave); }
        if (BOTH(8)) { VM_WAIT(); __syncthreads(); __builtin_amdgcn_fence(__ATOMIC_ACQUIRE, "agent"); }
    }

    if (IN(9)) {
        KARGS(a_); TIDS();
#ifndef PEER_ROWGATHER
        for (int q = tid; q < 512; q += NTHR) ((LAS f32x4*)(lds + 32768))[q] = ((const GAS f32x4*)a_->final_w)[q];
        for (int g = vcu; g < T / 64; g += G) peer_group(a_, lds, g, tid, lane, wave, g != vcu, 64 * (g - G), g + G >= T / 64);
#else
        for (int tok = vcu * NWAVES + wave; tok < T; tok += G * NWAVES) peer_gather_token(a_, (size_t)tok, lane, 1.f);
#endif
    }
#ifdef PROBE_TILESUM
    if (IN(9) && bx == 0 && wave == 0) { KARGS(a_); const unsigned nt_ = __hip_atomic_load((unsigned*)(a_->ws + WS_CTL) + 3200, RLX_AGENT);
        const unsigned long long t0_ = __builtin_amdgcn_s_memrealtime(); while (__builtin_amdgcn_s_memrealtime() - t0_ < (unsigned long long)nt_) __builtin_amdgcn_s_sleep(8); }
#endif
#undef IN
#undef BOTH
#undef GRID_BAR
}

extern "C" void kernel_launch(void* const* d_in, const int* in_sizes, int n_in, void* d_out, int out_size, void* d_ws, size_t ws_size, hipStream_t stream) {
    static int grid = 0;
    constexpr int NPH = 10;
    if (grid == 0) {
        if (n_in != 17 || in_sizes[0] != T * DM || out_size != T * DM || ws_size < WS_NEED) { fprintf(stderr, "kernel_launch: shape/workspace mismatch (n_in %d, in0 %d, out %d, ws %zu)\n", n_in, n_in > 0 ? in_sizes[0] : -1, out_size, ws_size); grid = -1; return; }
        int dev = 0, cus = 0, per_cu = 0;
        if (hipGetDevice(&dev) != hipSuccess || hipDeviceGetAttribute(&cus, hipDeviceAttributeMultiprocessorCount, dev) != hipSuccess) { grid = -1; return; }
        if (hipFuncSetAttribute((const void*)fwd_kernel, hipFuncAttributeMaxDynamicSharedMemorySize, LDS_BYTES) != hipSuccess) { fprintf(stderr, "kernel_launch: hipFuncSetAttribute failed\n"); grid = -1; return; }
        if (hipOccupancyMaxActiveBlocksPerMultiprocessor(&per_cu, (const void*)fwd_kernel, NTHR, LDS_BYTES) != hipSuccess || per_cu < 1) { fprintf(stderr, "kernel_launch: occupancy query says %d blocks per CU\n", per_cu); (void)hipGetLastError(); grid = -1; return; }
        grid = cus;
    }
    if (grid < 0) return;
    if (hipMemsetAsync((char*)d_ws + WS_CTL, 0, CTL_ZERO_BYTES, stream) != hipSuccess) return;
    Args a{};
    a.x = (const float*)d_in[0]; a.norm1_w = (const float*)d_in[1]; a.w_in = (const float*)d_in[2]; a.fox_f_bias = (const float*)d_in[3];
    a.conv_w = (const float*)d_in[4]; a.conv_b = (const float*)d_in[5]; a.i_bias = (const float*)d_in[6]; a.f_bias = (const float*)d_in[7];
    a.fox_nw = (const float*)d_in[8]; a.ml_nw = (const float*)d_in[9]; a.w_out = (const float*)d_in[10]; a.norm2_w = (const float*)d_in[11];
    a.w_q = (const float*)d_in[12]; a.keys = (const float*)d_in[13]; a.pu = (const float*)d_in[14]; a.pv = (const float*)d_in[15]; a.final_w = (const float*)d_in[16];
    a.out = (float*)d_out; a.ws = (unsigned char*)d_ws;
#if MK_N_LAUNCHES == 1
    a.ph_lo = 0; a.ph_hi = NPH; a.li = 0; a.pad = 0;
    hipLaunchKernelGGL(fwd_kernel, dim3(grid), dim3(NTHR), LDS_BYTES, stream, a);
#elif MK_N_LAUNCHES == 2 || MK_N_LAUNCHES == 3
    { const int cuts[4] = {0, PROBE_CUT1, MK_N_LAUNCHES == 3 ? PROBE_CUT2 : NPH, NPH};
      for (int l = 0; l < MK_N_LAUNCHES; ++l) { a.ph_lo = cuts[l]; a.ph_hi = cuts[l + 1]; a.li = l; a.pad = 0; hipLaunchKernelGGL(fwd_kernel, dim3(grid), dim3(NTHR), LDS_BYTES, stream, a); } }
#else
#ifndef PROBE_MASK
#define PROBE_MASK 0
#endif
#ifndef PROBE_P4MODE
#define PROBE_P4MODE 0
#endif
    for (int p = 0; p < NPH; ++p) for (int rep = 0; rep < (((PROBE_MASK >> p) & 1) ? 2 : 1); ++rep) {
        if (p == 4) (void)hipMemsetAsync((char*)d_ws + WS_CTL + CW_QUEUE * 4, 0, 256, stream);
        a.ph_lo = p; a.ph_hi = p + 1; a.li = 0; a.pad = (p == 4 && rep == 1) ? PROBE_P4MODE : 0; hipLaunchKernelGGL(fwd_kernel, dim3(grid), dim3(NTHR), LDS_BYTES, stream, a); }
#ifdef PROBE_CUTS
#endif
#endif
}
```

```cpp
#include <hip/hip_runtime.h>
#include <hip/hip_bf16.h>
#include <cstdio>
#include <cstdint>
__device__ __forceinline__ int mk_lane_id() { unsigned l_; asm volatile("v_mbcnt_lo_u32_b32 %0, -1, 0\n\tv_mbcnt_hi_u32_b32 %0, -1, %0" : "=v"(l_)); return (int)(l_ & 63u); }
namespace pg8 {
#define PG8_LAS __attribute__((address_space(3)))
typedef unsigned short bf16_t;
typedef short bf16x8 __attribute__((ext_vector_type(8)));
typedef float f32x4 __attribute__((ext_vector_type(4)));
typedef unsigned u32x4 __attribute__((ext_vector_type(4)));
constexpr int BM = 256, BK = 64, HALF = 128, HTB = HALF * BK * 2  , STAGE_BYTES = 8 * HTB, NXCD = 8, WGM = 8;

__host__ __device__ __forceinline__ int lds_byte(int r, int c) { const int st = (r >> 4) * 2 + (c >> 5), rr = r & 15, cc = c & 31, ob = rr * 64 + cc * 2; return st * 1024 + (ob ^ (((ob >> 9) & 1) << 5)); }
__host__ __device__ __forceinline__ void stage_rc(int b, int& R, int& C) { const int st = b / 1024, sb = b % 1024, swz = sb ^ (((sb >> 9) & 1) << 5); R = (st >> 1) * 16 + swz / 64; C = (st & 1) * 32 + (swz % 64) / 2; }
__host__ __device__ __forceinline__ int perm32(int rho) { const int n = rho >> 4, i = rho & 15; return 8 * (i >> 2) + 4 * n + (i & 3); }

struct Unit { int pm, pn; };
struct Gemm { const bf16_t* A; const bf16_t* Bt; int M, N, K; };

struct StaticOrder {
    int nM, nN, nwg, G, c;
    __host__ __device__ void init(int M, int N, int G_, int c_) { nM = M / BM; nN = N / BM; nwg = nM * nN; G = G_; c = c_; }
    __host__ __device__ bool next(int i, Unit& u) const {
        const long L = (long)i * G + c; if (L >= nwg) return false;
        int wgid = (int)L; { const int q = nwg / NXCD, r = nwg % NXCD, xcd = wgid % NXCD, off = wgid / NXCD; wgid = (xcd < r ? xcd * (q + 1) : r * (q + 1) + (xcd - r) * q) + off; }
        const int nig = WGM * nN, gid = wgid / nig, fm = gid * WGM, gsz = (nM - fm) < WGM ? (nM - fm) : WGM;
        u.pm = fm + ((wgid % nig) % gsz); u.pn = (wgid % nig) / gsz; return true;
    }
    __device__ __forceinline__ void a_ready(const Unit&) const {}
    __device__ __forceinline__ void done(const Unit&) const {}
};

__device__ __forceinline__ unsigned cvt_pk_bf16(float lo, float hi) { unsigned r; asm volatile("v_cvt_pk_bf16_f32 %0, %1, %2" : "=v"(r) : "v"(lo), "v"(hi)); return r; }
typedef float f32x2 __attribute__((ext_vector_type(2)));
__device__ __forceinline__ f32x2 gelu_pk(f32x2 v) {
    const f32x2 av = __builtin_elementwise_abs(v), d = av * 0.2316418882f + 1.0f;
    f32x2 t; t.x = __builtin_amdgcn_rcpf(d.x); t.y = __builtin_amdgcn_rcpf(d.y);
    f32x2 q = t * 0.5307027145f + (-0.7265760135f); q = q * t + 0.7107068705f; q = q * t + (-0.142248368f); q = q * t + 0.127414796f; q = q * t;
    const f32x2 s = (v * v) * (-0.72134752044f);
    f32x2 e; e.x = __builtin_amdgcn_exp2f(s.x); e.y = __builtin_amdgcn_exp2f(s.y);
    const f32x2 m = v * (q * e), r = v - m;
    f32x2 o; o.x = v.x < 0.f ? m.x : r.x; o.y = v.y < 0.f ? m.y : r.y; return o;
}

template <int ACT  > struct EpiBf16 {
    static constexpr bool PERM = true, AFTER_DRAIN = false; static_assert(ACT == 0 || ACT == 1, "EpiBf16: ACT is 0 (none) or 1 (gelu_pk)");
    bf16_t* O; int ldc; const float* bias; int split_cols; size_t split_stride; float scale0;
    __device__ __forceinline__ void operator()(const f32x4 (&acc)[2][2][4][2], const Unit& u, int wr, int wc, int fr, int fq) const {
        const int row0 = u.pm * BM + wr * 64 + fr; int colt = u.pn * BM; bf16_t* base = O;
        float sc = 1.f; if (split_cols) { const int t = colt / split_cols; base += (size_t)t * split_stride; colt -= t * split_cols; if (t == 0) sc = scale0; }
        const int col0 = colt + wc * 32 + 8 * fq, bcol0 = u.pn * BM + wc * 32 + 8 * fq;
        f32x4 bv[2][2];
#pragma unroll
        for (int bj = 0; bj < 2; ++bj)
#pragma unroll
            for (int n = 0; n < 2; ++n) bv[bj][n] = bias ? *(const f32x4*)(bias + bcol0 + bj * HALF + 4 * n) : (f32x4){0.f, 0.f, 0.f, 0.f};
#pragma unroll
        for (int ai = 0; ai < 2; ++ai)
#pragma unroll
            for (int m = 0; m < 4; ++m) { bf16_t* rowp = base + (size_t)(row0 + ai * HALF + m * 16) * ldc + col0;
#pragma unroll
                for (int bj = 0; bj < 2; ++bj) { f32x4 v0 = acc[ai][bj][m][0] + bv[bj][0], v1 = acc[ai][bj][m][1] + bv[bj][1];
                    if (ACT == 1) { f32x2 a = gelu_pk((f32x2){v0[0], v0[1]}), b = gelu_pk((f32x2){v0[2], v0[3]}), c = gelu_pk((f32x2){v1[0], v1[1]}), d = gelu_pk((f32x2){v1[2], v1[3]});
                        v0 = (f32x4){a.x, a.y, b.x, b.y}; v1 = (f32x4){c.x, c.y, d.x, d.y}; }
                    v0 = v0 * sc; v1 = v1 * sc; u32x4 w; w.x = cvt_pk_bf16(v0[0], v0[1]); w.y = cvt_pk_bf16(v0[2], v0[3]); w.z = cvt_pk_bf16(v1[0], v1[1]); w.w = cvt_pk_bf16(v1[2], v1[3]);
                    *(u32x4*)(rowp + bj * HALF) = w; } }
    }
};

struct EpiZ {
    static constexpr bool PERM = true, AFTER_DRAIN = false;
    unsigned char* ws; size_t off_fq, off_mq, off_mv, off_gates;
    __device__ __forceinline__ void operator()(const f32x4 (&acc)[2][2][4][2], const Unit& u, int wr, int wc, int fr, int fq) const {
        const int pn = u.pn, row0 = u.pm * BM + wr * 64 + fr;
        if (pn < 12) {
            bf16_t* base = (bf16_t*)(ws + off_fq + ((size_t)(pn >> 2) << 26)); const int hp = (pn & 3) * 2, d = wc * 32 + 8 * fq;
#pragma unroll
            for (int ai = 0; ai < 2; ++ai)
#pragma unroll
                for (int m = 0; m < 4; ++m) { const int row = row0 + ai * HALF + m * 16, b = row >> 14, s = row & 16383;
#pragma unroll
                    for (int bj = 0; bj < 2; ++bj) { const f32x4 v0 = acc[ai][bj][m][0], v1 = acc[ai][bj][m][1];
                        u32x4 w; w.x = cvt_pk_bf16(v0[0], v0[1]); w.y = cvt_pk_bf16(v0[2], v0[3]); w.z = cvt_pk_bf16(v1[0], v1[1]); w.w = cvt_pk_bf16(v1[2], v1[3]);
                        *(u32x4*)(base + ((size_t)(b * 8 + hp + bj) * 16384 + s) * 128 + d) = w; } }
        } else if (pn < 24) {
            const bool isqk = pn < 16;
            const size_t boff = isqk ? off_mq + ((size_t)((pn - 12) >> 1) << 25) : off_mv + ((size_t)((pn - 16) >> 2) << 26);
            bf16_t* base = (bf16_t*)(ws + boff); const int ld = isqk ? 512 : 1024, cb = isqk ? ((pn - 12) & 1) * 256 : ((pn - 16) & 3) * 256;
            const int col0 = cb + wc * 32 + 8 * fq;
#pragma unroll
            for (int ai = 0; ai < 2; ++ai)
#pragma unroll
                for (int m = 0; m < 4; ++m) { bf16_t* rowp = base + (size_t)(row0 + ai * HALF + m * 16) * ld + col0;
#pragma unroll
                    for (int bj = 0; bj < 2; ++bj) { const f32x4 v0 = acc[ai][bj][m][0], v1 = acc[ai][bj][m][1];
                        u32x4 w; w.x = cvt_pk_bf16(v0[0], v0[1]); w.y = cvt_pk_bf16(v0[2], v0[3]); w.z = cvt_pk_bf16(v1[0], v1[1]); w.w = cvt_pk_bf16(v1[2], v1[3]);
                        *(u32x4*)(rowp + bj * HALF) = w; } }
        } else {
            if (wc == 0 && fq < 2) {
#pragma unroll
                for (int ai = 0; ai < 2; ++ai)
#pragma unroll
                    for (int m = 0; m < 4; ++m) { float* rowp = (float*)(ws + off_gates) + (size_t)(row0 + ai * HALF + m * 16) * 16 + 8 * fq;
                        *(f32x4*)rowp = acc[ai][0][m][0]; *(f32x4*)(rowp + 4) = acc[ai][0][m][1]; }
            }
        }
    }
};
struct EpiRes {
    static constexpr bool PERM = true, AFTER_DRAIN = false;
    const float* res; float* O; int ldc; const float* w2; bf16_t* XW; float* SSQP;
    __device__ __forceinline__ void operator()(const f32x4 (&acc)[2][2][4][2], const Unit& u, int wr, int wc, int fr, int fq) const {
        const int row0 = u.pm * BM + wr * 64 + fr, col0 = u.pn * BM + wc * 32 + 8 * fq;
        f32x4 wv[2][2];
#pragma unroll
        for (int bj = 0; bj < 2; ++bj) { wv[bj][0] = *(const f32x4*)(w2 + col0 + bj * HALF); wv[bj][1] = *(const f32x4*)(w2 + col0 + bj * HALF + 4); }
#pragma unroll
        for (int ai = 0; ai < 2; ++ai)
#pragma unroll
            for (int m = 0; m < 4; ++m) { const int row = row0 + ai * HALF + m * 16; const size_t off = (size_t)row * ldc + col0; float ss = 0.f;
#pragma unroll
                for (int bj = 0; bj < 2; ++bj) { const f32x4 r0 = __builtin_nontemporal_load((const f32x4*)(res + off + bj * HALF)), r1 = __builtin_nontemporal_load((const f32x4*)(res + off + bj * HALF + 4));
                    const f32x4 v0 = acc[ai][bj][m][0] + r0, v1 = acc[ai][bj][m][1] + r1;
                    __builtin_nontemporal_store(v0, (f32x4*)(O + off + bj * HALF)); __builtin_nontemporal_store(v1, (f32x4*)(O + off + bj * HALF + 4));
                    ss += (v0[0] * v0[0] + v0[1] * v0[1]) + (v0[2] * v0[2] + v0[3] * v0[3]) + (v1[0] * v1[0] + v1[1] * v1[1]) + (v1[2] * v1[2] + v1[3] * v1[3]);
                    const f32x4 x0 = v0 * wv[bj][0], x1 = v1 * wv[bj][1];
                    u32x4 w; w.x = cvt_pk_bf16(x0[0], x0[1]); w.y = cvt_pk_bf16(x0[2], x0[3]); w.z = cvt_pk_bf16(x1[0], x1[1]); w.w = cvt_pk_bf16(x1[2], x1[3]);
                    *(u32x4*)(XW + off + bj * HALF) = w; }
                ss += __shfl_xor(ss, 16); ss += __shfl_xor(ss, 32);
                if (fq == 0) SSQP[(size_t)row * 32 + u.pn * 4 + wc] = ss; }
    }
};
template <class Epi, class Sched, bool ALIGN_EPI = false, bool SP2 = false>
__device__ __forceinline__ void gemm_phase(PG8_LAS unsigned char* lds, const Gemm g, const Sched& S, const Epi& E, const int wid_in) {
    const int wid = wid_in, lane = mk_lane_id(), tid = wid * 64 + lane, wr = wid >> 2, wc = wid & 3, fr = lane & 15, fq = lane >> 4;
    const int K = g.K, nt = K / BK;
    unsigned voffA[2], voffB[2];
#pragma unroll
    for (int i = 0; i < 2; ++i) { int R, C; stage_rc(tid * 16 + i * 8192, R, C); const int Rb = Epi::PERM ? ((R & ~31) + perm32(R & 31)) : R;
        voffA[i] = (unsigned)(R * K + C) * 2u; voffB[i] = (unsigned)(Rb * K + C) * 2u; }
    const size_t kstep = (size_t)(BK * 2);
    const size_t hstep = (size_t)HALF * K * 2;
    const size_t tstep = 2 * hstep;
    const unsigned ldsw = (unsigned)wid * 1024u;
    const int aoff = lds_byte(wr * 64 + fr, fq * 8), boff = lds_byte(wc * 32 + fr, fq * 8);
#define PG8_SA(b, h) (((b) * 2 + (h)) * HTB)
#define PG8_SB(b, h) ((4 + (b) * 2 + (h)) * HTB)
#define PG8_STAGE(bufoff, gbase, voff) do { _Pragma("unroll") for (int _i = 0; _i < 2; ++_i) \
        __builtin_amdgcn_global_load_lds((const unsigned*)((const char*)(gbase) + (voff)[_i]), (PG8_LAS unsigned*)(lds + (bufoff) + ldsw + _i * 8192), 16, 0, 0); } while (0)
#define PG8_LDA(dst, b, h) do { _Pragma("unroll") for (int m = 0; m < 4; ++m) _Pragma("unroll") for (int k = 0; k < 2; ++k) dst[m][k] = *(const PG8_LAS bf16x8*)(lds + PG8_SA(b, h) + aoff + m * 2048 + k * 1024); } while (0)
#define PG8_LDB(dst, b, h) do { _Pragma("unroll") for (int n = 0; n < 2; ++n) _Pragma("unroll") for (int k = 0; k < 2; ++k) dst[n][k] = *(const PG8_LAS bf16x8*)(lds + PG8_SB(b, h) + boff + n * 2048 + k * 1024); } while (0)
#define PG8_MMA(ai, bj, At, Bt) do { __builtin_amdgcn_s_setprio(1); _Pragma("unroll") for (int m = 0; m < 4; ++m) _Pragma("unroll") for (int n = 0; n < 2; ++n) _Pragma("unroll") for (int k = 0; k < 2; ++k) \
        acc[ai][bj][m][n] = __builtin_amdgcn_mfma_f32_16x16x32_bf16(Bt[n][k], At[m][k], acc[ai][bj][m][n], 0, 0, 0); __builtin_amdgcn_s_setprio(0); } while (0)
#define PG8_WAIT_V(n) asm volatile("s_waitcnt vmcnt(" #n ")" ::: "memory")
#define PG8_WAIT_L(n) asm volatile("s_waitcnt lgkmcnt(" #n ")" ::: "memory")
#define PG8_BAR __builtin_amdgcn_s_barrier()
#define PG8_SCHED __builtin_amdgcn_sched_barrier(0)
    Unit cur, nxt; int ui = 0;
    if (!S.next(0, cur)) return;
    f32x4 acc[2][2][4][2];
#pragma unroll
    for (int a = 0; a < 2; ++a)
#pragma unroll
        for (int b = 0; b < 2; ++b)
#pragma unroll
            for (int m = 0; m < 4; ++m)
#pragma unroll
                for (int n = 0; n < 2; ++n) acc[a][b][m][n] = (f32x4){0.f, 0.f, 0.f, 0.f};
    bf16x8 At[4][2], B0[2][2], B1[2][2];
    const char* cA = (const char*)g.A + (size_t)cur.pm * tstep; const char* cB = (const char*)g.Bt + (size_t)cur.pn * tstep;
    S.a_ready(cur);
    if constexpr (SP2) {
        PG8_STAGE(PG8_SB(0, 0), cB, voffB); PG8_STAGE(PG8_SB(0, 1), cB + hstep, voffB); PG8_STAGE(PG8_SA(0, 0), cA, voffA); PG8_STAGE(PG8_SA(0, 1), cA + hstep, voffA);
        if (wr == 1) PG8_BAR;
        PG8_WAIT_V(2); PG8_BAR;
        PG8_STAGE(PG8_SB(1, 0), cB + kstep, voffB); PG8_STAGE(PG8_SA(1, 0), cA + kstep, voffA); PG8_STAGE(PG8_SB(1, 1), cB + hstep + kstep, voffB);
        PG8_WAIT_V(6); PG8_BAR;
    } else {
        PG8_STAGE(PG8_SB(0, 0), cB, voffB); PG8_STAGE(PG8_SA(0, 0), cA, voffA); PG8_STAGE(PG8_SB(0, 1), cB + hstep, voffB); PG8_STAGE(PG8_SA(0, 1), cA + hstep, voffA);
        if (wr == 1) PG8_BAR;
        PG8_WAIT_V(4); PG8_BAR;
        PG8_STAGE(PG8_SB(1, 0), cB + kstep, voffB); PG8_STAGE(PG8_SA(1, 0), cA + kstep, voffA); PG8_STAGE(PG8_SB(1, 1), cB + hstep + kstep, voffB);
        PG8_WAIT_V(6); PG8_BAR;
    }
    for (;;) {
        const bool has_next = S.next(ui + 1, nxt);
        const char* nA = has_next ? (const char*)g.A + (size_t)nxt.pm * tstep : cA; const char* nB = has_next ? (const char*)g.Bt + (size_t)nxt.pn * tstep : cB;
        for (int t = 0; t < nt; t += 2) {
            const bool last = (t == nt - 2);
            const char* a1 = cA + (size_t)(t + 1) * kstep;
            const char* a2 = last ? nA : cA + (size_t)(t + 2) * kstep; const char* b2 = last ? nB : cB + (size_t)(t + 2) * kstep;
            const char* a3 = a2 + kstep; const char* b3 = b2 + kstep;
            if (last && has_next) S.a_ready(nxt);
            if constexpr (SP2) {
            PG8_LDB(B0, 0, 0); PG8_LDB(B1, 0, 1); PG8_SCHED; PG8_LDA(At, 0, 0); PG8_STAGE(PG8_SA(1, 1), a1 + hstep, voffA);
            PG8_WAIT_V(8); PG8_WAIT_L(0); PG8_BAR; PG8_MMA(0, 0, At, B0); PG8_MMA(0, 1, At, B1); PG8_BAR; PG8_SCHED;
            PG8_LDA(At, 0, 1); PG8_STAGE(PG8_SB(0, 0), b2, voffB); PG8_STAGE(PG8_SB(0, 1), b2 + hstep, voffB); PG8_STAGE(PG8_SA(0, 0), a2, voffA);
            PG8_WAIT_V(8); PG8_WAIT_L(0); PG8_BAR; PG8_MMA(1, 0, At, B0); PG8_MMA(1, 1, At, B1); PG8_BAR; PG8_SCHED;
            PG8_LDB(B0, 1, 0); PG8_LDB(B1, 1, 1); PG8_SCHED; PG8_LDA(At, 1, 0); PG8_STAGE(PG8_SA(0, 1), a2 + hstep, voffA);
            PG8_WAIT_V(8); PG8_WAIT_L(0); PG8_BAR; PG8_MMA(0, 0, At, B0); PG8_MMA(0, 1, At, B1); PG8_BAR; PG8_SCHED;
            PG8_LDA(At, 1, 1); PG8_STAGE(PG8_SB(1, 0), b3, voffB); PG8_STAGE(PG8_SB(1, 1), b3 + hstep, voffB); PG8_STAGE(PG8_SA(1, 0), a3, voffA);
            PG8_WAIT_V(8); PG8_WAIT_L(0); PG8_BAR; PG8_MMA(1, 0, At, B0); PG8_MMA(1, 1, At, B1); PG8_BAR; PG8_SCHED;
            } else {
            PG8_LDB(B0, 0, 0); PG8_SCHED; PG8_LDA(At, 0, 0); PG8_STAGE(PG8_SA(1, 1), a1 + hstep, voffA);
            PG8_WAIT_L(8); PG8_BAR; PG8_WAIT_L(0); PG8_MMA(0, 0, At, B0); PG8_BAR; PG8_SCHED;
            PG8_LDB(B1, 0, 1); PG8_STAGE(PG8_SB(0, 0), b2, voffB);
            PG8_BAR; PG8_WAIT_L(0); PG8_MMA(0, 1, At, B1); PG8_BAR;
            PG8_LDA(At, 0, 1); PG8_STAGE(PG8_SA(0, 0), a2, voffA);
            PG8_BAR; PG8_WAIT_L(0); PG8_MMA(1, 0, At, B0); PG8_BAR; PG8_SCHED;
            PG8_STAGE(PG8_SB(0, 1), b2 + hstep, voffB);
            PG8_WAIT_V(6); PG8_BAR; PG8_MMA(1, 1, At, B1); PG8_BAR;
            PG8_LDB(B0, 1, 0); PG8_SCHED; PG8_LDA(At, 1, 0); PG8_STAGE(PG8_SA(0, 1), a2 + hstep, voffA);
            PG8_WAIT_L(8); PG8_BAR; PG8_WAIT_L(0); PG8_MMA(0, 0, At, B0); PG8_BAR; PG8_SCHED;
            PG8_LDB(B1, 1, 1); PG8_STAGE(PG8_SB(1, 0), b3, voffB);
            PG8_BAR; PG8_WAIT_L(0); PG8_MMA(0, 1, At, B1); PG8_BAR;
            PG8_LDA(At, 1, 1); PG8_STAGE(PG8_SA(1, 0), a3, voffA);
            PG8_BAR; PG8_WAIT_L(0); PG8_MMA(1, 0, At, B0); PG8_BAR; PG8_SCHED;
            PG8_STAGE(PG8_SB(1, 1), b3 + hstep, voffB);
            PG8_WAIT_V(6); PG8_BAR; PG8_MMA(1, 1, At, B1); PG8_BAR;
            }
        }
        if constexpr (ALIGN_EPI) { if (wr == 0) PG8_BAR; }
        if constexpr (!Epi::AFTER_DRAIN) { E(acc, cur, wr, wc, fr, fq); S.done(cur); }
        if (!has_next) break;
#pragma unroll
        for (int a = 0; a < 2; ++a)
#pragma unroll
            for (int b = 0; b < 2; ++b)
#pragma unroll
                for (int m = 0; m < 4; ++m)
#pragma unroll
                    for (int n = 0; n < 2; ++n) acc[a][b][m][n] = (f32x4){0.f, 0.f, 0.f, 0.f};
        cur = nxt; cA = nA; cB = nB; ++ui;
        if constexpr (ALIGN_EPI) { if (wr == 1) PG8_BAR; }
    }
    PG8_WAIT_V(0);
    if constexpr (!ALIGN_EPI) { if (wr == 0) PG8_BAR; }
    PG8_BAR;
    if constexpr (Epi::AFTER_DRAIN) { E.fused(acc, cur, wr, wc, fr, fq, lds, wid, lane); S.done(cur); }
#undef PG8_SA
#undef PG8_SB
#undef PG8_STAGE
#undef PG8_LDA
#undef PG8_LDB
#undef PG8_MMA
#undef PG8_WAIT_V
#undef PG8_WAIT_L
#undef PG8_BAR
#undef PG8_SCHED
}
}
namespace fox {
constexpr int D = 128, OPITCH = 2048;
constexpr size_t FOX_WS_K = (size_t)368 << 20, FOX_WS_O = (size_t)752 << 20;
constexpr int FOX_CW_DONE = 8192;
constexpr bool WSKIP = false;
constexpr float THR = 8.f;
constexpr float SCALE = 0.08838834764831845f;
constexpr float INV_SCALE = 11.313708498984761f;
constexpr int NW = 8, QBLK = 32, KVBLK = 64, QB = NW * QBLK;
constexpr int SHM_V = KVBLK * D * 2, SHM_K = KVBLK * D * 2;
constexpr int LDS_BIAS = 2 * SHM_V + 2 * SHM_K + NW * 64 * 4;
constexpr int LDS_BYTES = LDS_BIAS + 2 * 64 * 4;

using bf16 = __hip_bfloat16;
typedef short bf16x8 __attribute__((ext_vector_type(8)));
typedef short s16x4 __attribute__((ext_vector_type(4)));
typedef float f32x16 __attribute__((ext_vector_type(16)));
typedef float f32x4 __attribute__((ext_vector_type(4)));
typedef float f32x2v __attribute__((ext_vector_type(2)));
typedef unsigned u32x4 __attribute__((ext_vector_type(4)));
template <class A, class Bt> struct same_t { static constexpr bool v = false; };
template <class A> struct same_t<A, A> { static constexpr bool v = true; };

#define KSWZ(row, colB) ((row) * 256 + ((colB) ^ (((row) & 7) << 4)))
#define SBAR() __builtin_amdgcn_sched_barrier(0)
#define WGBAR() do { asm volatile("s_waitcnt lgkmcnt(0)" ::: "memory"); __builtin_amdgcn_s_barrier(); asm volatile("" ::: "memory"); } while (0)
__device__ __forceinline__ int v_st(int k, int c) { const int kk = (k & ~0xC) | ((k & 4) << 1) | ((k & 8) >> 1); return ((kk >> 3) * 4 + (c >> 5)) * 512 + ((kk & 7) * 32 + (c & 31)) * 2; }
__device__ __forceinline__ int v_rd_base(int lane) { return ((lane & 3) << 3) | (((lane >> 2) & 3) << 6) | (((lane >> 4) & 1) << 5) | (((lane >> 5) & 1) << 8); }
constexpr int v_rd_off(int d0, int ks, int half) { return d0 * 512 + ks * 4096 + half * 2048; }
__device__ __forceinline__ int crow(int r, int hi) { return (r & 3) + 8 * (r >> 2) + 4 * hi; }
__device__ __forceinline__ unsigned cvtpk(float lo, float hi) {
    unsigned r; asm volatile("v_cvt_pk_bf16_f32 %0, %1, %2" : "=v"(r) : "v"(lo), "v"(hi)); return r;
}
__device__ __forceinline__ bf16x8 pack8(f32x4 a, f32x4 b) {
    u32x4 w = {cvtpk(a[0], a[1]), cvtpk(a[2], a[3]), cvtpk(b[0], b[1]), cvtpk(b[2], b[3])};
    return *reinterpret_cast<bf16x8*>(&w);
}
template <class T> __device__ __forceinline__ bf16x8 load8(const T* p) {
    if constexpr (same_t<T, float>::v) { return pack8(*(const f32x4*)p, *(const f32x4*)(p + 4)); }
    else { return *reinterpret_cast<const bf16x8*>(p); }
}
__device__ __forceinline__ void mask_tile(f32x16& p0, f32x16& p1, int dq, unsigned W) {
    const float NEG = -__builtin_inff();
#pragma unroll
    for (int r = 0; r < 16; ++r) {
        const int c = (r & 3) + 8 * (r >> 2);
        if ((unsigned)(dq - c) >= W) p0[r] = NEG;
        if ((unsigned)(dq - c - 32) >= W) p1[r] = NEG;
    }
}
__device__ __forceinline__ void partialSM(f32x16& p0, f32x16& p1, float& m_reg, float& mn, float& alpha) {
    float pmax = p0[0]; for (int r = 1; r < 16; ++r) pmax = fmaxf(pmax, p0[r]); for (int r = 0; r < 16; ++r) pmax = fmaxf(pmax, p1[r]);
    { auto rr = __builtin_amdgcn_permlane32_swap(__float_as_uint(pmax), __float_as_uint(pmax), false, false);
      pmax = fmaxf(__uint_as_float(rr[0]), __uint_as_float(rr[1])); }
    constexpr float C2 = 1.4426950408889634f * SCALE;
    if (__builtin_expect(__all((pmax - m_reg) * SCALE <= THR), 1)) { mn = m_reg; alpha = 1.f; }
    else { mn = fmaxf(m_reg, pmax); alpha = __builtin_amdgcn_exp2f((m_reg - mn) * C2); m_reg = mn; }
    const float mnL = -mn * C2;
    for (int r = 0; r < 16; ++r) p0[r] = fmaf(p0[r], C2, mnL); for (int r = 0; r < 16; ++r) p1[r] = fmaf(p1[r], C2, mnL);
    for (int r = 0; r < 16; ++r) p0[r] = __builtin_amdgcn_exp2f(p0[r]);
}
__device__ __forceinline__ void finishSM(f32x16& p0, f32x16& p1, float alpha, float& l_reg, bf16x8& pa0, bf16x8& pa1, bf16x8& pa2, bf16x8& pa3) {
    for (int r = 0; r < 16; ++r) p1[r] = __builtin_amdgcn_exp2f(p1[r]);
    float ps = 0; for (int r = 0; r < 16; ++r) ps += p0[r]; for (int r = 0; r < 16; ++r) ps += p1[r];
    { auto rr = __builtin_amdgcn_permlane32_swap(__float_as_uint(ps), __float_as_uint(ps), false, false);
      ps = __uint_as_float(rr[0]) + __uint_as_float(rr[1]); }
    l_reg = l_reg * alpha + ps;
#define PK4(P, B_, OUT) do { unsigned a0 = cvtpk(P[B_+0], P[B_+1]), a1 = cvtpk(P[B_+2], P[B_+3]);                          \
        unsigned b0 = cvtpk(P[B_+4], P[B_+5]), b1 = cvtpk(P[B_+6], P[B_+7]);                                             \
        auto r0 = __builtin_amdgcn_permlane32_swap(a0, b0, false, false); auto r1 = __builtin_amdgcn_permlane32_swap(a1, b1, false, false); \
        u32x4 w = {r0[0], r1[0], r0[1], r1[1]}; OUT = *reinterpret_cast<bf16x8*>(&w); } while (0)
    PK4(p0, 0, pa0); PK4(p0, 8, pa1); PK4(p1, 0, pa2); PK4(p1, 8, pa3);
#undef PK4
}
template <int KB, bool SK>
__device__ __forceinline__ void qkt(f32x16& p0, f32x16& p1, const char* K_lds, int r32, int hi, const bf16x8* qr, bool act) {
    const float* bl_ = (const float*)(K_lds + 2 * SHM_K + NW * 64 * 4) + KB * 64 + 4 * hi;
    if (SK && !act) { const float NEG = -__builtin_inff();
#pragma unroll
        for (int r = 0; r < 16; ++r) { p0[r] = NEG; p1[r] = NEG; } return; }
#pragma unroll
    for (int g = 0; g < 4; ++g) { const f32x4 v0_ = *(const f32x4*)(bl_ + 8 * g), v1_ = *(const f32x4*)(bl_ + 32 + 8 * g);
        p0[4 * g] = v0_[0]; p0[4 * g + 1] = v0_[1]; p0[4 * g + 2] = v0_[2]; p0[4 * g + 3] = v0_[3];
        p1[4 * g] = v1_[0]; p1[4 * g + 1] = v1_[1]; p1[4 * g + 2] = v1_[2]; p1[4 * g + 3] = v1_[3]; }
    const char* kb[4];
#pragma unroll
    for (int dd = 0; dd < 4; ++dd) kb[dd] = K_lds + KB * SHM_K + KSWZ(r32, (dd * 16 + hi * 8) * 2);
#pragma unroll
    for (int d0 = 0; d0 < 8; ++d0) { const char* a = kb[d0 & 3] + (d0 >> 2) * 128;
        bf16x8 b0 = *reinterpret_cast<const bf16x8*>(a);
        bf16x8 b1 = *reinterpret_cast<const bf16x8*>(a + 32 * 256);
        p0 = __builtin_amdgcn_mfma_f32_32x32x16_bf16(b0, qr[d0], p0, 0, 0, 0);
        p1 = __builtin_amdgcn_mfma_f32_32x32x16_bf16(b1, qr[d0], p1, 0, 0, 0); }
}
template <int VB, bool SK>
__device__ __forceinline__ void pv_tile(f32x16* o, int vb0, bf16x8 pa0, bf16x8 pa1, bf16x8 pa2, bf16x8 pa3, bool act) {
    if (SK && !act) return;
#define TRRD(dst, off) asm volatile("ds_read_b64_tr_b16 %0, %1 offset:%2" : "=&v"(dst) : "v"(vb0), "i"(off) : "memory")
#define PV_D0(d0) do { s16x4 l0, l1, l2, l3, h0, h1, h2, h3; constexpr int b_ = VB * SHM_V + v_rd_off(d0, 0, 0);     \
        TRRD(l0, b_); TRRD(h0, b_ + 2048); TRRD(l1, b_ + 4096); TRRD(h1, b_ + 6144); TRRD(l2, b_ + 8192); TRRD(h2, b_ + 10240); TRRD(l3, b_ + 12288); TRRD(h3, b_ + 14336); \
        asm volatile("s_waitcnt lgkmcnt(0)" ::: "memory"); SBAR();                 \
        o[d0] = __builtin_amdgcn_mfma_f32_32x32x16_bf16(pa0, (bf16x8){l0[0], l0[1], l0[2], l0[3], h0[0], h0[1], h0[2], h0[3]}, o[d0], 0, 0, 0);   \
        o[d0] = __builtin_amdgcn_mfma_f32_32x32x16_bf16(pa1, (bf16x8){l1[0], l1[1], l1[2], l1[3], h1[0], h1[1], h1[2], h1[3]}, o[d0], 0, 0, 0);   \
        o[d0] = __builtin_amdgcn_mfma_f32_32x32x16_bf16(pa2, (bf16x8){l2[0], l2[1], l2[2], l2[3], h2[0], h2[1], h2[2], h2[3]}, o[d0], 0, 0, 0);   \
        o[d0] = __builtin_amdgcn_mfma_f32_32x32x16_bf16(pa3, (bf16x8){l3[0], l3[1], l3[2], l3[3], h3[0], h3[1], h3[2], h3[3]}, o[d0], 0, 0, 0); } while (0)
    PV_D0(0); PV_D0(1); PV_D0(2); PV_D0(3);
#undef PV_D0
#undef TRRD
}

template <class TIn, class TOut> struct BlockRef {
    int bh, P0, jlo, jhi;
    int kvbh, omib;
    int kind, nprev, slot0, bi;
    __device__ __forceinline__ const TIn* Kp(unsigned char* ws) const { return (const TIn*)(ws + FOX_WS_K) + (size_t)kvbh * 16384 * D; }
    __device__ __forceinline__ const TIn* Vp(unsigned char* ws) const { return Kp(ws) + (1 << 25); }
    __device__ __forceinline__ const TIn* Qp(unsigned char* ws) const { return Kp(ws) - (1 << 25) + (size_t)P0 * D; }
    __device__ __forceinline__ TOut* Op(unsigned char* ws) const { return (TOut*)(ws + FOX_WS_O + ((size_t)omib << 20)) + ((size_t)(bh >> 3) * 16384 + (size_t)P0) * OPITCH + (bh & 7) * D; }
    __device__ __forceinline__ unsigned* donep(unsigned char* ws) const { return (unsigned*)ws + FOX_CW_DONE + bi; }
};
struct FoxBases { const float* F; const float* NW; unsigned char* ws; };
#define BR_F(r) (fb.F + (size_t)(r).bh * 16384)
constexpr int SLOT_FLOATS = 256 * 128 + 256 * 2;
constexpr int SLOTS_LO = 1008;
constexpr size_t SLOT_LO_OFF = (size_t)176 << 20, SLOT_HI_OFF = (size_t)880 << 20;
__device__ __forceinline__ float* fox_slot(unsigned char* ws, int k) { return (float*)(ws + (k < SLOTS_LO ? SLOT_LO_OFF + (size_t)k * (SLOT_FLOATS * 4) : SLOT_HI_OFF + (size_t)(k - SLOTS_LO) * (SLOT_FLOATS * 4))); }
constexpr float C2G = 1.4426950408889634f * SCALE;
template <class TIn> struct Seam {
    bf16x8 qr[8];
    bf16x8 st_v0, st_v1, st_k0, st_k1; f32x4 sf0, sf1, sf2, sf3;
    f32x4 tq[16];
};
__device__ __forceinline__ int swa_jlo(int P0, int W) { const int lowk = P0 - W + 1; return lowk > 0 ? lowk / KVBLK : 0; }
#define ROW(p, k0, rr) ((p) + (size_t)((k0) + ((rr) - sr)) * D + lofs_)
#define VMW() asm volatile("s_waitcnt vmcnt(0)" ::: "memory")
#define VMWN(n) asm volatile("s_waitcnt vmcnt(%0)" :: "i"(n) : "memory")
#define SLOAD_H(Kp, Vp, Fp, k0, bfb) do { S.st_v0 = load8<TIn>(ROW(Vp, k0, sr)); S.st_v1 = load8<TIn>(ROW(Vp, k0, 32 + sr));              \
                         S.st_k0 = load8<TIn>(ROW(Kp, k0, sr)); S.st_k1 = load8<TIn>(ROW(Kp, k0, 32 + sr));                         \
                         if (wid == 0) __builtin_amdgcn_global_load_lds((const unsigned*)((Fp) + (k0) + lane),                          \
                             (__attribute__((address_space(3))) unsigned*)(bias_las + (bfb) * 256), 4, 0, 0); } while (0)
#define SWRITE_HK(bf) do { *(bf16x8*)(K_lds + (bf) * SHM_K + kws) = S.st_k0; *(bf16x8*)(K_lds + (bf) * SHM_K + kws + 32 * 256) = S.st_k1; } while (0)
#define SWRITE_HV(bf) do { *(bf16x8*)(V_lds + (bf) * SHM_V + vst0) = S.st_v0; *(bf16x8*)(V_lds + (bf) * SHM_V + vst1) = S.st_v1; } while (0)
#define SWRITE_H(bf) do { SWRITE_HV(bf); SWRITE_HK(bf); } while (0)
#define SLOAD_F(p, k0) do { S.sf0 = *(const f32x4*)ROW(p, k0, sr); S.sf1 = *(const f32x4*)(ROW(p, k0, sr) + 4);                \
                            S.sf2 = *(const f32x4*)ROW(p, k0, 32 + sr); S.sf3 = *(const f32x4*)(ROW(p, k0, 32 + sr) + 4); } while (0)
#define SWRITE_KF(bf) do { *(bf16x8*)(K_lds + (bf) * SHM_K + kws) = pack8(S.sf0, S.sf1); *(bf16x8*)(K_lds + (bf) * SHM_K + kws + 32 * 256) = pack8(S.sf2, S.sf3); } while (0)
#define SWRITE_VF(bf) do { *(bf16x8*)(V_lds + (bf) * SHM_V + vst0) = pack8(S.sf0, S.sf1); *(bf16x8*)(V_lds + (bf) * SHM_V + vst1) = pack8(S.sf2, S.sf3); } while (0)
template <class TIn, class TOut>
__device__ __forceinline__ void causal_swa_prime(const BlockRef<TIn, TOut>& cur, const FoxBases& fb, int W, char* lds, Seam<TIn>& S, const int wid_in) {
    constexpr bool F32 = same_t<TIn, float>::v;
    const int wid = wid_in, lane = mk_lane_id(), tid = wid * 64 + lane, r32 = lane & 31, hi = lane >> 5;
    const int sr = tid >> 4, sc = (tid & 15) * 8, kws = KSWZ(sr, sc * 2); char* K_lds = lds + 2 * SHM_V;
    const unsigned lofs_ = (unsigned)(sr * D + sc);
    __attribute__((address_space(3))) unsigned char* bias_las = (__attribute__((address_space(3))) unsigned char*)lds + LDS_BIAS;
    const int kb0 = cur.jlo * KVBLK;
    for (int d0 = 0; d0 < 8; ++d0) S.qr[d0] = load8<TIn>(cur.Qp(fb.ws) + (size_t)(wid * QBLK) * D + (unsigned)(r32 * D + hi * 8) + d0 * 16);
    if constexpr (F32) { SLOAD_F((const float*)cur.Kp(fb.ws), kb0); VMW(); SWRITE_KF(0); SBAR(); SLOAD_F((const float*)cur.Vp(fb.ws), kb0); }
    else { SLOAD_H(cur.Kp(fb.ws), cur.Vp(fb.ws), BR_F(cur), kb0, 0); VMW(); SWRITE_HK(0); }
    WGBAR();
}
template <class TIn, class TOut, class Next>
__device__ __forceinline__ void causal_swa_block(const BlockRef<TIn, TOut>& cur, BlockRef<TIn, TOut>& nxt, int& nidx, const Next& NX, const FoxBases& fb, int skv, int W, char* lds, Seam<TIn>& S, const int wid_in) {
    constexpr bool F32 = same_t<TIn, float>::v;
    const int wid = wid_in, lane = mk_lane_id(), tid = wid * 64 + lane, r32 = lane & 31, hi = lane >> 5;
    const int j_lo = cur.jlo;
    const int j_hi = cur.jhi;
    const int NT = j_hi - j_lo;
    const int tc_ = NT > 10 ? ((NT - 10) | 1) : -1;
    if (tc_ < 0) NX.claim();
    const int qlo = cur.P0 + wid * QBLK, qm = qlo + r32 - 4 * hi;
    char* V_lds = lds; char* K_lds = lds + 2 * SHM_V;
    __attribute__((address_space(3))) unsigned char* bias_las = (__attribute__((address_space(3))) unsigned char*)lds + LDS_BIAS;
    float* ws = (float*)(lds + 2 * SHM_V + 2 * SHM_K) + wid * 64; float* li_l = ws, * al_l = ws + 32;
    float m_reg = -1e30f, l_reg = 0; f32x16 o[4] = {};
    const unsigned lofs_ = (unsigned)((tid >> 4) * D + (tid & 15) * 8);
    const int sr = tid >> 4, sc = (tid & 15) * 8, vst0 = v_st(sr, sc), vst1 = v_st(32 + sr, sc), kws = KSWZ(sr, sc * 2);
    const int vb0 = (int)(uintptr_t)V_lds + v_rd_base(lane);
    const TIn* Kh = cur.Kp(fb.ws); const TIn* Vh = cur.Vp(fb.ws); const float* Fh = BR_F(cur);
#define RESC(a) do { if (__any((a) < 1.f)) { if (hi == 0) al_l[r32] = (a); asm volatile("s_waitcnt lgkmcnt(0)" ::: "memory");              \
                     for (int d_ = 0; d_ < 4; ++d_) for (int r = 0; r < 16; ++r) o[d_][r] *= al_l[crow(r, hi)]; } } while (0)
#define KBASE(t) ((j_lo + (t)) * KVBLK)
#define ACT(t) (KBASE(t) <= qlo + QBLK - 1 && KBASE(t) + KVBLK - 1 >= qlo - W + 1)
#define MASKT(P0_, P1_, t) do { const int kb_ = KBASE(t); if ((!SK || ACT(t)) && (kb_ + KVBLK - 1 > qlo || kb_ <= qlo + QBLK - 1 - W)) mask_tile(P0_, P1_, qm - kb_, (unsigned)W); } while (0)
    constexpr int NQL = F32 ? 16 : 8;
    constexpr bool SK = WSKIP && !F32;
#define SEAM_K0() do { VMWN(NQL); if constexpr (F32) { SWRITE_KF(0); SBAR(); SLOAD_F((const float*)nxt.Vp(fb.ws), kbn); } else { SWRITE_HK(0); } SBAR(); } while (0)
    f32x16 pA0, pA1, pB0, pB1; float mnA, mnB, alA, alB; bf16x8 pa0, pa1, pa2, pa3;
    if constexpr (F32) { VMW(); SWRITE_VF(0); SBAR(); } else { SWRITE_HV(0); SBAR(); }
    if (NT > 1) { if constexpr (F32) SLOAD_F((const float*)Kh, KBASE(1)); else SLOAD_H(Kh, Vh, Fh, KBASE(1), 1); }
    SBAR(); qkt<0, SK>(pA0, pA1, K_lds, r32, hi, S.qr, ACT(0));
    if constexpr (F32) { if (NT > 1) { VMW(); SWRITE_KF(1); SBAR(); SLOAD_F((const float*)Vh, KBASE(1)); } }
    MASKT(pA0, pA1, 0); partialSM(pA0, pA1, m_reg, mnA, alA);
    if (NT > 1) { VMW(); if constexpr (F32) { SWRITE_VF(1); SBAR(); if (NT > 2) SLOAD_F((const float*)Kh, KBASE(2)); } else SWRITE_H(1); }
    WGBAR();
#define HALF_STEP(PX0, PX1, mnX, alX, PY0, PY1, alY, t, KB, VB, SB) do {                                                      \
        SBAR(); qkt<KB, SK>(PX0, PX1, K_lds, r32, hi, S.qr, ACT(t));                                             \
        finishSM(PY0, PY1, alY, l_reg, pa0, pa1, pa2, pa3); SBAR();                                                           \
        if ((t) + 1 < NT) { if constexpr (F32) { VMW(); SWRITE_KF(SB); SBAR(); SLOAD_F((const float*)Vh, KBASE((t) + 1)); }  \
                            else { SLOAD_H(Kh, Vh, Fh, KBASE((t) + 1), SB); } SBAR(); }                                       \
        pv_tile<VB, SK>(o, vb0, pa0, pa1, pa2, pa3, ACT((t) - 1)); MASKT(PX0, PX1, (t)); partialSM(PX0, PX1, m_reg, mnX, alX);                                        \
        WGBAR();                                                                                                      \
        if ((t) + 1 < NT) { VMW(); if constexpr (F32) { SWRITE_VF(SB); SBAR(); if ((t) + 2 < NT) SLOAD_F((const float*)Kh, KBASE((t) + 2)); } \
                            else { SWRITE_H(SB); } }                                                                          \
        RESC(alX); WGBAR(); } while (0)
    for (int t = 1; t + 1 < NT; t += 2) {
        if (t == tc_) NX.claim();
        HALF_STEP(pB0, pB1, mnB, alB, pA0, pA1, alA, t, 1, 0, 0);
        HALF_STEP(pA0, pA1, mnA, alA, pB0, pB1, alB, t + 1, 0, 1, 1);
    }
    nidx = NX.resolve(nxt, cur);
    const int kbn = nxt.jlo * KVBLK;
    const bool even = (NT & 1) == 0;
    if (even) { SBAR(); qkt<1, SK>(pB0, pB1, K_lds, r32, hi, S.qr, ACT(NT - 1)); SBAR(); }
#define QROW(e) (nxt.Qp(fb.ws) + (size_t)(wid * QBLK + r32) * D + ((e) >> 1) * 16 + hi * 8 + ((e) & 1) * 4)
    if constexpr (F32) { SLOAD_F((const float*)nxt.Kp(fb.ws), kbn); SBAR();
#pragma unroll
        for (int e = 0; e < 8; ++e) S.tq[e] = *(const f32x4*)QROW(e); }
    else { SLOAD_H(nxt.Kp(fb.ws), nxt.Vp(fb.ws), BR_F(nxt), kbn, 0); SBAR();
#pragma unroll
        for (int d0 = 0; d0 < 8; ++d0) S.qr[d0] = load8<TIn>(nxt.Qp(fb.ws) + (size_t)(wid * QBLK) * D + (unsigned)(r32 * D + hi * 8) + d0 * 16); }
    SBAR();
    finishSM(pA0, pA1, alA, l_reg, pa0, pa1, pa2, pa3); SBAR();
    if constexpr (F32) {
#pragma unroll
        for (int e = 8; e < 16; ++e) S.tq[e] = *(const f32x4*)QROW(e); SBAR(); }
#undef QROW
    pv_tile<0, SK>(o, vb0, pa0, pa1, pa2, pa3, ACT(even ? NT - 2 : NT - 1));
    if (even) { MASKT(pB0, pB1, NT - 1); partialSM(pB0, pB1, m_reg, mnB, alB); WGBAR(); RESC(alB);
        finishSM(pB0, pB1, alB, l_reg, pa0, pa1, pa2, pa3); SBAR(); pv_tile<1, SK>(o, vb0, pa0, pa1, pa2, pa3, ACT(NT - 1)); }
    SBAR(); SEAM_K0();
    if (cur.kind != 0) {
        float* Os = fox_slot(fb.ws, cur.slot0) + (size_t)(wid * QBLK) * 128 + (unsigned)(4 * hi * 128 + r32);
#pragma unroll
        for (int g = 0; g < 4; ++g) { SBAR(); float* Og = Os + 8 * g * 128;
#pragma unroll
            for (int i = 0; i < 4; ++i)
#pragma unroll
                for (int d0 = 0; d0 < 4; ++d0) Og[i * 128 + d0 * 32] = o[d0][4 * g + i]; }
        SBAR();
        if (hi == 0) *(f32x2v*)(fox_slot(fb.ws, cur.slot0) + 256 * 128 + (wid * QBLK + r32) * 2) = (f32x2v){m_reg, l_reg};
        asm volatile("s_waitcnt vmcnt(0)" ::: "memory");
        WGBAR();
        if (cur.kind == 1) {
            if (tid == 0) { __builtin_amdgcn_fence(__ATOMIC_RELEASE, "agent"); asm volatile("s_waitcnt vmcnt(0)" ::: "memory");
                (void)__hip_atomic_fetch_add(cur.donep(fb.ws), 1u, __ATOMIC_RELAXED, __HIP_MEMORY_SCOPE_AGENT); }
        } else {
            if (tid == 0) { unsigned sp_ = 0; while (__hip_atomic_load(cur.donep(fb.ws), __ATOMIC_RELAXED, __HIP_MEMORY_SCOPE_AGENT) < (unsigned)cur.nprev) { __builtin_amdgcn_s_sleep(2); if (++sp_ > (1u << 21)) break; }
                __builtin_amdgcn_fence(__ATOMIC_ACQUIRE, "agent"); asm volatile("s_waitcnt vmcnt(0)" ::: "memory"); }
            WGBAR();
            const int lane2 = 2 * lane; const f32x2v wv_ = *(const f32x2v*)(fb.NW + (cur.bh & 7) * 128 + lane2);
            TOut* Orow = cur.Op(fb.ws) + (size_t)(wid * QBLK) * OPITCH + lane2;
            for (int rr = 0; rr < QBLK; ++rr) {
                const int row = wid * QBLK + rr;
                float M_ = -1e30f;
                for (int sg = 0; sg <= cur.nprev; ++sg) M_ = fmaxf(M_, fox_slot(fb.ws, cur.slot0 - cur.nprev + sg)[256 * 128 + row * 2]);
                float lsum = 0.f; f32x2v acc_ = (f32x2v){0.f, 0.f};
                for (int sg = 0; sg <= cur.nprev; ++sg) { const float* Ps = fox_slot(fb.ws, cur.slot0 - cur.nprev + sg);
                    const f32x2v ml_ = *(const f32x2v*)(Ps + 256 * 128 + row * 2); const float w_ = __builtin_amdgcn_exp2f((ml_[0] - M_) * C2G);
                    lsum += ml_[1] * w_; acc_ += *(const f32x2v*)(Ps + row * 128 + lane2) * w_; }
                acc_ = acc_ * __builtin_amdgcn_rcpf(lsum);
                float ss_ = acc_[0] * acc_[0] + acc_[1] * acc_[1];
#pragma unroll
                for (int of = 1; of < 64; of <<= 1) ss_ += __shfl_xor(ss_, of);
                const float rn_ = __builtin_amdgcn_rsqf(ss_ * (1.0f / 128.0f) + 1e-6f);
                *(unsigned*)(Orow + (size_t)rr * OPITCH) = cvtpk(acc_[0] * rn_ * wv_[0], acc_[1] * rn_ * wv_[1]);
            }
        }
    } else {
    if (hi == 0) li_l[r32] = l_reg; asm volatile("s_waitcnt lgkmcnt(0)" ::: "memory");
    {
        typedef __attribute__((address_space(3))) float lasf;
        lasf* ssq_l = (lasf*)(__attribute__((address_space(3))) unsigned char*)lds + (LDS_BIAS - NW * 64 * 4) / 4 + wid * 64 + 32;
        float rli[16];
#pragma unroll
        for (int r = 0; r < 16; ++r) rli[r] = __builtin_amdgcn_rcpf(li_l[crow(r, hi)]);
        if (hi == 0) al_l[r32] = 0.f;
        asm volatile("s_waitcnt lgkmcnt(0)" ::: "memory");
#pragma unroll
        for (int r = 0; r < 16; ++r) { float ss_ = 0.f;
#pragma unroll
            for (int d0 = 0; d0 < 4; ++d0) { const float v = o[d0][r] * rli[r]; ss_ += v * v; }
            (void)__hip_atomic_fetch_add(ssq_l + crow(r, hi), ss_, __ATOMIC_RELAXED, __HIP_MEMORY_SCOPE_WORKGROUP); }
        asm volatile("s_waitcnt lgkmcnt(0)" ::: "memory");
#pragma unroll
        for (int r = 0; r < 16; ++r) rli[r] *= __builtin_amdgcn_rsqf(al_l[crow(r, hi)] * (1.0f / 128.0f) + 1e-6f);
        float wn_[4];
#pragma unroll
        for (int d0 = 0; d0 < 4; ++d0) wn_[d0] = fb.NW[(cur.bh & 7) * 128 + d0 * 32 + r32];
        TOut* Ow = cur.Op(fb.ws) + (size_t)(wid * QBLK) * OPITCH;
        char* os_ = lds + 73728 + wid * 10240;
        const bool odd_ = (r32 & 1) != 0;
#pragma unroll
        for (int rp = 0; rp < 8; ++rp) { const int r = 2 * rp; char* orow_ = os_ + (crow(r, hi) + (odd_ ? 1 : 0)) * 320 + 2 * (r32 & ~1);
#pragma unroll
            for (int d0 = 0; d0 < 4; ++d0) { const float va = o[d0][r] * rli[r] * wn_[d0], vb = o[d0][r + 1] * rli[r + 1] * wn_[d0];
                const float snd = odd_ ? va : vb;
                const float rcv = __builtin_bit_cast(float, __builtin_amdgcn_update_dpp(0, __builtin_bit_cast(int, snd), 0xB1, 0xF, 0xF, true));
                *(unsigned*)(orow_ + 64 * d0) = cvtpk(odd_ ? rcv : va, odd_ ? vb : rcv); } }
        asm volatile("s_waitcnt lgkmcnt(0)" ::: "memory");
#pragma unroll
        for (int i = 0; i < 8; ++i) { const int q_ = 64 * i + lane, row_ = q_ >> 4, ch_ = q_ & 15;
            const u32x4 w_ = *(const u32x4*)(os_ + row_ * 320 + ch_ * 16);
            *(u32x4*)(Ow + (size_t)row_ * OPITCH + ch_ * 8) = w_; }
    }
    if constexpr (F32) {
#pragma unroll
        for (int d0 = 0; d0 < 8; ++d0) S.qr[d0] = pack8(S.tq[2 * d0], S.tq[2 * d0 + 1]); }
    }
    if (cur.kind == 0) WGBAR();
#undef RESC
#undef KBASE
#undef ACT
#undef MASKT
#undef SEAM_K0
#undef HALF_STEP
}
#undef ROW
#undef VMW
#undef VMWN
#undef SLOAD_H
#undef SWRITE_HK
#undef SWRITE_HV
#undef SWRITE_H
#undef SLOAD_F
#undef SWRITE_KF
#undef SWRITE_VF
}
constexpr int NWAVES = 8;
constexpr int NTHR = NWAVES * 64;
#ifndef MK_N_LAUNCHES
#define MK_N_LAUNCHES 1
#endif
constexpr int NPHASE = 8;
constexpr int BATCH = 2, SEQ = 16384, DM = 2048, T = BATCH * SEQ;
constexpr int NZ = 6144;
constexpr int NCH = SEQ / 128;
constexpr float NORM_EPS = 1e-6f;
constexpr size_t MiB = 1u << 20;
constexpr size_t WS_CTL = 0, CTL_ZERO_BYTES = 64 * 1024;
constexpr size_t WS_WINT = 1 * MiB;
constexpr size_t WS_WOUTT = 26 * MiB;
constexpr size_t WS_WQT = 34 * MiB;
constexpr size_t WS_KEYS = 42 * MiB;
constexpr size_t WS_FCUM = 43 * MiB;
constexpr size_t WS_MSM = 44 * MiB;
constexpr size_t WS_GATES = 46 * MiB;
constexpr size_t WS_UB = 48 * MiB;
constexpr size_t WS_VB = 80 * MiB;
constexpr size_t WS_SSQP = 464 * MiB;
constexpr size_t WS_PEI = 432 * MiB;
constexpr size_t WS_PEG = 448 * MiB;
constexpr size_t WS_H = 176 * MiB;
constexpr size_t WS_FQ = 304 * MiB, WS_FK = 368 * MiB, WS_FV = 432 * MiB;
constexpr size_t WS_MQ = 496 * MiB, WS_MK = 528 * MiB;
constexpr size_t WS_MV = 560 * MiB, WS_MO = 624 * MiB;
constexpr size_t WS_PQ = 304 * MiB;
constexpr size_t WS_CPREV = 688 * MiB;
constexpr size_t WS_MIXED = 752 * MiB;
constexpr size_t WS_END = 880 * MiB;
constexpr size_t WS_NEED = 1024 * MiB;
constexpr int MS_MLOC = 0, MS_BLAST = 1024, MS_MPREV = 2048, MS_NLOC = 4096, MS_NPREV = 4096 + 131072;
constexpr int MS_QBF = 348400;
constexpr float QF_K0 = 12.f, QF_K1 = 13.25f, QF_K2 = 14.5f;
constexpr int MS_KTMAX = 344200;
constexpr int MS_QBDMIN = 343100;
constexpr int MS_QBMAX = 342000;
constexpr int MS_JLO = 340000;
constexpr int MS_USC = 300000, MS_VSC = 320000;
constexpr int CW_QKMAX = 2048;
constexpr int CW_QUEUE = 3072;
constexpr int CW_SEGDONE = 8192;
constexpr int CW_BAR = 4096;

constexpr int LDS_BYTES = 160 * 1024;
constexpr int MISC_OFF = LDS_BYTES - 256;
constexpr int SCR_BYTES = MISC_OFF;

#define GAS __attribute__((address_space(1)))
#define LAS __attribute__((address_space(3)))
typedef unsigned short bf16;
typedef unsigned v4u __attribute__((ext_vector_type(4)));
typedef unsigned v2u __attribute__((ext_vector_type(2)));
typedef float f32x4 __attribute__((ext_vector_type(4)));
typedef float f32x2 __attribute__((ext_vector_type(2)));
typedef float f32x16 __attribute__((ext_vector_type(16)));
typedef short bf16x8 __attribute__((ext_vector_type(8)));
typedef GAS unsigned gu32;
#define RLX_AGENT __ATOMIC_RELAXED, __HIP_MEMORY_SCOPE_AGENT
#define LDS_WAIT() asm volatile("s_waitcnt lgkmcnt(0)" ::: "memory")
#define VM_WAIT() asm volatile("s_waitcnt vmcnt(0)" ::: "memory")
__device__ __forceinline__ unsigned cvtpk(float lo, float hi) { unsigned r; asm volatile("v_cvt_pk_bf16_f32 %0, %1, %2" : "=v"(r) : "v"(lo), "v"(hi)); return r; }
typedef __bf16 bf16x2c_t __attribute__((ext_vector_type(2)));
__device__ __forceinline__ unsigned cvtpk_c(float lo, float hi) { typedef float f2c_ __attribute__((ext_vector_type(2))); return __builtin_bit_cast(unsigned, __builtin_convertvector((f2c_){lo, hi}, bf16x2c_t)); }
__device__ __forceinline__ float bflo(unsigned w) { return __uint_as_float(w << 16); }
__device__ __forceinline__ float bfhi(unsigned w) { return __uint_as_float(w & 0xffff0000u); }
__device__ __forceinline__ float logsig(float x) { return fminf(x, 0.f) - log1pf(__expf(-fabsf(x))); }
#define WDPP_(v, ctl) __builtin_bit_cast(float, __builtin_amdgcn_update_dpp(0, __builtin_bit_cast(int, (v)), (ctl), 0xF, 0xF, true))
__device__ __forceinline__ float wave_sum(float v) {
    v += WDPP_(v, 0xB1); v += WDPP_(v, 0x4E); v += WDPP_(v, 0x141); v += WDPP_(v, 0x128);
    v += __shfl_xor(v, 16); v += __shfl_xor(v, 32);
    return v;
}
__device__ __forceinline__ float row16_sum(float v) { v += WDPP_(v, 0xB1); v += WDPP_(v, 0x4E); v += WDPP_(v, 0x141); v += WDPP_(v, 0x128); return v; }
__device__ __forceinline__ float wave_max(float v) {
    v = fmaxf(v, WDPP_(v, 0xB1)); v = fmaxf(v, WDPP_(v, 0x4E)); v = fmaxf(v, WDPP_(v, 0x141)); v = fmaxf(v, WDPP_(v, 0x128));
    v = fmaxf(v, __shfl_xor(v, 16)); v = fmaxf(v, __shfl_xor(v, 32));
    return v;
}
#define XB_TMO      128
#define XB_XCNT(j)  (256  + 64 * (j))
#define XB_XSUB(j)  (1280 + 64 * (j))
#define XB_XGEN(j)  (2304 + 64 * (j))
#define XB_TOP      3328
#define XB_TOPGEN   3392
#define XCD_BAR_WORDS 3456
#define XB_SPIN_CAP (1u << 18)

__device__ __forceinline__ unsigned xb_ld(unsigned* p)              { return __hip_atomic_load(p, __ATOMIC_RELAXED, __HIP_MEMORY_SCOPE_AGENT); }
__device__ __forceinline__ unsigned xb_add(unsigned* p, unsigned v) { return __hip_atomic_fetch_add(p, v, __ATOMIC_RELAXED, __HIP_MEMORY_SCOPE_AGENT); }
__device__ __forceinline__ unsigned xb_xcc_id() { return (unsigned)__builtin_amdgcn_s_getreg((3 << 11) | 20) & 0xFu; }
#define XB_SPIN(cond, bar) do { unsigned _sp = 0; while (cond) { __builtin_amdgcn_s_sleep(1); \
    if ((++_sp & 255u) == 0u) { if (xb_ld(&(bar)[XB_TMO])) break; if (_sp > XB_SPIN_CAP) { atomicAdd(&(bar)[XB_TMO], 1u); break; } } } } while (0)

struct XcdBarrier {
    unsigned* bar; unsigned x;
    volatile LAS unsigned* st;
};

__device__ __forceinline__ XcdBarrier xcd_barrier_post(unsigned* bar, volatile LAS unsigned* st, const int tid_) {
    XcdBarrier b; b.bar = bar; b.x = xb_xcc_id(); b.st = st;
    if (tid_ == 0) (void)xb_add(&bar[XB_XCNT(b.x)], 1u);
    return b;
}
__device__ __forceinline__ void xcd_barrier_complete(unsigned* bar, unsigned x, unsigned& nloc, unsigned& nx) {
    const unsigned G = gridDim.x * gridDim.y * gridDim.z;
    unsigned sum, cnt, mine, sp = 0u;
    for (;;) {
        sum = 0u; cnt = 0u; mine = 0u;
#pragma unroll
        for (unsigned j = 0; j < 16; ++j) { const unsigned c = xb_ld(&bar[XB_XCNT(j)]); sum += c; cnt += (c > 0u) ? 1u : 0u; mine = (j == x) ? c : mine; }
        if (sum == G) break;
        __builtin_amdgcn_s_sleep(1);
        if ((++sp & 255u) == 0u) { if (xb_ld(&bar[XB_TMO])) break; if (sp > XB_SPIN_CAP) { atomicAdd(&bar[XB_TMO], 1u); break; } }
    }
    nloc = mine > 0u ? mine : 1u; nx = cnt > 0u ? cnt : 1u;
}

__device__ __forceinline__ void xcd_barrier(const XcdBarrier& b, const int tid_) {
    asm volatile("s_waitcnt vmcnt(0)" ::: "memory");
    __syncthreads();
    if (tid_ == 0) {
        unsigned* bar = b.bar;
        __builtin_amdgcn_s_waitcnt(0);
        unsigned nloc = b.st[0], nx = b.st[1];
        if (nloc == 0u) { xcd_barrier_complete(bar, b.x, nloc, nx); b.st[0] = nloc; b.st[1] = nx; }
        const unsigned old = xb_add(&bar[XB_XSUB(b.x)], 1u);
        const unsigned gen = old / nloc;
        if (old + 1u == (gen + 1u) * nloc) {
            __builtin_amdgcn_fence(__ATOMIC_RELEASE, "agent");
            asm volatile("s_waitcnt vmcnt(0)" ::: "memory");
            const unsigned og = xb_add(&bar[XB_TOP], 1u);
            const unsigned tg = og / nx;
            if (og + 1u == (tg + 1u) * nx) xb_add(&bar[XB_TOPGEN], 1u);
            else XB_SPIN(xb_ld(&bar[XB_TOPGEN]) == tg, bar);
            __builtin_amdgcn_fence(__ATOMIC_ACQUIRE, "agent");
            xb_add(&bar[XB_XGEN(b.x)], 1u);
            asm volatile("s_waitcnt vmcnt(0)" ::: "memory");
        } else {
            XB_SPIN(xb_ld(&bar[XB_XGEN(b.x)]) == gen, bar);
            __builtin_amdgcn_fence(__ATOMIC_ACQUIRE, "agent");
            asm volatile("s_waitcnt vmcnt(0)" ::: "memory");
        }
    }
    __syncthreads();
}

struct Args {
    const float* x; const float* norm1_w; const float* w_in; const float* fox_f_bias; const float* conv_w; const float* conv_b;
    const float* i_bias; const float* f_bias; const float* fox_nw; const float* ml_nw; const float* w_out; const float* norm2_w;
    const float* w_q; const float* keys; const float* pu; const float* pv; const float* final_w;
    float* out; unsigned char* ws; int ph_lo, ph_hi, li, pad;
};
typedef const __attribute__((address_space(4))) Args* KA;
typedef __bf16 bf2_t __attribute__((ext_vector_type(2)));
__device__ __forceinline__ float dot2bf(unsigned a, unsigned b, float c) { return __builtin_amdgcn_fdot2_f32_bf16(__builtin_bit_cast(bf2_t, a), __builtin_bit_cast(bf2_t, b), c, false); }
#define MFMA16(a, b, c) __builtin_amdgcn_mfma_f32_16x16x32_bf16((a), (b), (c), 0, 0, 0)
#define MFMA32(a, b, c) __builtin_amdgcn_mfma_f32_32x32x16_bf16((a), (b), (c), 0, 0, 0)

__device__ __forceinline__ void p0_transpose_item(const float* W, int ldw, int src_col, bf16* WT, int dst_row, int Kp, int k0, LAS float* scr, int lane) {
#pragma unroll 8
    for (int i = 0; i < 32; ++i) { const int kk = 2 * i + (lane >> 5); scr[kk * 33 + (lane & 31)] = W[(size_t)(k0 + kk) * ldw + src_col + (lane & 31)]; }
    LDS_WAIT(); asm volatile("" ::: "memory");
    const int c = lane & 7;
#pragma unroll
    for (int j = 0; j < 4; ++j) { const int n = (lane >> 3) + 8 * j; const LAS float* s = scr + (8 * c) * 33 + n;
        v4u o; o.x = cvtpk(s[0 * 33], s[1 * 33]); o.y = cvtpk(s[2 * 33], s[3 * 33]); o.z = cvtpk(s[4 * 33], s[5 * 33]); o.w = cvtpk(s[6 * 33], s[7 * 33]);
        *(GAS v4u*)(WT + (size_t)(dst_row + n) * Kp + k0 + 8 * c) = o; }
    LDS_WAIT(); asm volatile("" ::: "memory");
}
__device__ __forceinline__ void rms_row_to_bf16(const float* xrow, const f32x4 (&w)[8], bf16* orow, int lane) {
    const GAS f32x4* xr = (const GAS f32x4*)xrow + lane;
    f32x4 v[8]; float s = 0.f;
#pragma unroll
    for (int j = 0; j < 8; ++j) { v[j] = xr[64 * j]; s += (v[j].x * v[j].x + v[j].y * v[j].y) + (v[j].z * v[j].z + v[j].w * v[j].w); }
    const float rn = __builtin_amdgcn_rsqf(wave_sum(s) * (1.f / DM) + NORM_EPS);
    GAS v2u* o8 = (GAS v2u*)orow + lane;
#pragma unroll
    for (int j = 0; j < 8; ++j) { v2u o; o.x = cvtpk(v[j].x * rn * w[j].x, v[j].y * rn * w[j].y); o.y = cvtpk(v[j].z * rn * w[j].z, v[j].w * rn * w[j].w); o8[64 * j] = o; }
}
__device__ __forceinline__ void rms_phase(const float* X, const float* wv, bf16* O, int gw, int NGW, int lane) {
    f32x4 w[8];
#pragma unroll
    for (int j = 0; j < 8; ++j) w[j] = ((const f32x4*)wv)[64 * j + lane];
    for (int m = gw; m < T; m += NGW) rms_row_to_bf16(X + (size_t)m * DM, w, O + (size_t)m * DM, lane);
}
__device__ __forceinline__ void rms_gate_phase(const float* X, const float* wv, bf16* O, float* GATES, const LAS f32x4* WG, int gw, int NGW, int lane) {
    f32x4 w[8];
#pragma unroll
    for (int j = 0; j < 8; ++j) w[j] = ((const f32x4*)wv)[64 * j + lane];
    for (int m = gw; m < T; m += NGW) {
        const GAS f32x4* xr = (const GAS f32x4*)(X + (size_t)m * DM) + lane;
        f32x4 v[8]; float s = 0.f;
#pragma unroll
        for (int j = 0; j < 8; ++j) { v[j] = __builtin_nontemporal_load(xr + 64 * j); s += (v[j].x * v[j].x + v[j].y * v[j].y) + (v[j].z * v[j].z + v[j].w * v[j].w); }
        const float rn = __builtin_amdgcn_rsqf(wave_sum(s) * (1.f / DM) + NORM_EPS);
        GAS v2u* o8 = (GAS v2u*)(O + (size_t)m * DM) + lane;
        f32x4 acc[4];
#pragma unroll
        for (int c = 0; c < 4; ++c) acc[c] = (f32x4){0.f, 0.f, 0.f, 0.f};
#pragma unroll
        for (int j = 0; j < 8; ++j) { const f32x4 h = v[j] * rn * w[j];
            v2u o; o.x = cvtpk(h.x, h.y); o.y = cvtpk(h.z, h.w); o8[64 * j] = o;
#pragma unroll
            for (int i = 0; i < 4; ++i)
#pragma unroll
                for (int c = 0; c < 4; ++c) acc[c] += WG[((j * 4 + i) * 4 + c) * 64 + lane] * h[i]; }
        float k8[8], k4[4], k2[2], k1;
        const bool b5 = (lane & 32) != 0, b4 = (lane & 16) != 0, b3 = (lane & 8) != 0, b2 = (lane & 4) != 0;
#pragma unroll
        for (int i = 0; i < 8; ++i) { const float keep = b5 ? acc[2 + (i >> 2)][i & 3] : acc[i >> 2][i & 3], send = b5 ? acc[i >> 2][i & 3] : acc[2 + (i >> 2)][i & 3]; k8[i] = keep + __shfl_xor(send, 32); }
#pragma unroll
        for (int i = 0; i < 4; ++i) { const float keep = b4 ? k8[4 + i] : k8[i], send = b4 ? k8[i] : k8[4 + i]; k4[i] = keep + __shfl_xor(send, 16); }
#pragma unroll
        for (int i = 0; i < 2; ++i) { const float keep = b3 ? k4[2 + i] : k4[i], send = b3 ? k4[i] : k4[2 + i]; k2[i] = keep + __shfl_xor(send, 8); }
        { const float keep = b2 ? k2[1] : k2[0], send = b2 ? k2[0] : k2[1]; k1 = keep + __shfl_xor(send, 4); }
        k1 += __shfl_xor(k1, 2); k1 += __shfl_xor(k1, 1);
        if ((lane & 3) == 0) GATES[(size_t)m * 16 + (lane >> 2)] = k1;
    }
}
__device__ __forceinline__ void cvt_stream(const float* src, bf16* dst, size_t ngroups8, size_t gid, size_t nthr) {
    for (size_t g = gid; g < ngroups8; g += nthr) { const f32x4 a = ((const f32x4*)src)[2 * g], b = ((const f32x4*)src)[2 * g + 1];
        v4u o; o.x = cvtpk(a.x, a.y); o.y = cvtpk(a.z, a.w); o.z = cvtpk(b.x, b.y); o.w = cvtpk(b.z, b.w); ((v4u*)dst)[g] = o; }
}
__device__ __forceinline__ void quant_row_fp8(const float* src, unsigned char* dst, float* sc_out, int lane) {
    f32x4 v[2][4]; float am = 0.f;
#pragma unroll
    for (int j = 0; j < 2; ++j)
#pragma unroll
        for (int i = 0; i < 4; ++i) { v[j][i] = __builtin_nontemporal_load((const f32x4*)(src + 1024 * j + 16 * lane + 4 * i));
            am = fmaxf(am, fmaxf(fmaxf(fabsf(v[j][i].x), fabsf(v[j][i].y)), fmaxf(fabsf(v[j][i].z), fabsf(v[j][i].w)))); }
    am = wave_max(am);
    const float s = am > 0.f ? 224.f / am : 1.f;
#pragma unroll
    for (int j = 0; j < 2; ++j) { v4u o;
#pragma unroll
        for (int i = 0; i < 4; ++i) { int p = __builtin_amdgcn_cvt_pk_fp8_f32(v[j][i].x * s, v[j][i].y * s, 0, false); p = __builtin_amdgcn_cvt_pk_fp8_f32(v[j][i].z * s, v[j][i].w * s, p, true); o[i] = (unsigned)p; }
        __builtin_nontemporal_store(o, (v4u*)(dst + 1024 * j + 16 * lane)); }
    if (lane == 0) *sc_out = am > 0.f ? am * (1.f / 224.f) : 1.f;
}
__device__ __forceinline__ void p0_prologue(KA a, LAS unsigned char* lds, int tid, int lane, int wave, int vcu, int G) {
    unsigned char* ws = a->ws;
    bf16* WINT = (bf16*)(ws + WS_WINT); bf16* WOUTT = (bf16*)(ws + WS_WOUTT); bf16* WQT = (bf16*)(ws + WS_WQT);
    LAS float* scr = (LAS float*)(lds + wave * 16384);
    const int gw = vcu * NWAVES + wave, NGW = G * NWAVES;
    constexpr int I_IN = 32 * 192, I_SQ = 32 * 64;
    for (int it = gw; it < I_IN + 2 * I_SQ; it += NGW) {
        int r = it;
        if (r < I_IN) { const int kb = r / 192, nb = r % 192, n0 = nb * 32; const int src = n0 < 3072 ? n0 : (n0 < 5120 ? n0 + 8 : n0 + 16);
            p0_transpose_item(a->w_in, 6160, src, WINT, n0, DM, kb * 64, scr, lane); continue; }
        r -= I_IN;
        if (r < I_SQ) { p0_transpose_item(a->w_out, DM, (r % 64) * 32, WOUTT, (r % 64) * 32, DM, (r / 64) * 64, scr, lane); continue; }
        r -= I_SQ;
        p0_transpose_item(a->w_q, DM, (r % 64) * 32, WQT, (r % 64) * 32, DM, (r / 64) * 64, scr, lane);
    }
    const size_t gid = (size_t)vcu * NTHR + tid, nthr = (size_t)G * NTHR;
    cvt_stream(a->keys, (bf16*)(ws + WS_KEYS), 2 * 128 * 128 / 8, gid, nthr);
    { float* MSM = (float*)(ws + WS_MSM);
      for (int r = gw; r < 2 * 16384; r += NGW) { const int t = r >> 14, row = r & 16383;
          quant_row_fp8((t ? a->pv : a->pu) + (size_t)row * DM, ws + (t ? WS_VB : WS_UB) + (size_t)row * DM, MSM + (t ? MS_VSC : MS_USC) + row, lane); } }
    __syncthreads();
    { LAS float* WGf = (LAS float*)lds;
      for (int q = tid; q < 8 * 4 * 4 * 64 * 4; q += NTHR) { const int e4 = q & 3, ln = (q >> 2) & 63, c = (q >> 8) & 3, i = (q >> 10) & 3, j = q >> 12;
          const int k = 256 * j + 4 * ln + i, gt = 4 * c + e4, src = gt < 8 ? 3072 + gt : (gt < 12 ? 5128 + (gt - 8) : 5132 + (gt - 12));
          WGf[q] = a->w_in[(size_t)k * 6160 + src]; } }
    __syncthreads();
    rms_gate_phase(a->x, a->norm1_w, (bf16*)(ws + WS_H), (float*)(ws + WS_GATES), (const LAS f32x4*)lds, gw, NGW, lane);
}

__device__ __forceinline__ void fox_cumsum(KA a, LAS unsigned char* lds, int bh, int tid, int lane, int wave) {
    const float* GATES = (const float*)(a->ws + WS_GATES); float* F = (float*)(a->ws + WS_FCUM) + (size_t)bh * SEQ;
    const int b = bh >> 3, h = bh & 7; const float bias = a->fox_f_bias[h];
    LAS float* wt = (LAS float*)lds;
    float v[32]; float run = 0.f;
#pragma unroll
    for (int i = 0; i < 32; ++i) { run += logsig(GATES[((size_t)b * SEQ + tid * 32 + i) * 16 + h] + bias); v[i] = run; }
    float sc = run;
#pragma unroll
    for (int o = 1; o < 64; o <<= 1) { const float n = __shfl_up(sc, o); if (lane >= o) sc += n; }
    if (lane == 63) wt[wave] = sc;
    __syncthreads();
    float off = sc - run;
    for (int w = 0; w < wave; ++w) off += wt[w];
#pragma unroll
    for (int i = 0; i < 32; i += 4) *(f32x4*)(F + tid * 32 + i) = (f32x4){v[i] + off, v[i + 1] + off, v[i + 2] + off, v[i + 3] + off} * (-11.313708498984761f);
    __syncthreads();
}

__device__ __forceinline__ void fox_qk_norm_max(KA a, int bh, int part, int lane, int wave) {
    const bf16* base = (const bf16*)(a->ws + WS_FQ) + ((size_t)bh * SEQ + (size_t)part * 2048 + wave * 256) * 128;
    float qmx = 0.f, kmx = 0.f, dmn = 3.0e38f, tmx[4], fa = -3.0e38f, fb = -3.0e38f, fc = -3.0e38f;
#pragma unroll
    for (int tl = 0; tl < 4; ++tl) { float m4 = 0.f;
#pragma unroll 4
      for (int i16 = 0; i16 < 16; ++i16) { const int it = 16 * tl + i16; const v4u p = *(const v4u*)(base + (size_t)it * 512 + 8 * lane), kq = *(const v4u*)(base + ((size_t)1 << 25) + (size_t)it * 512 + 8 * lane);
        float s = 0.f, sk = 0.f, d = 0.f;
#pragma unroll
        for (int w = 0; w < 4; ++w) { const float lo = bflo(p[w]), hi = bfhi(p[w]), kl = bflo(kq[w]), kh = bfhi(kq[w]); s += lo * lo + hi * hi; sk += kl * kl + kh * kh; d += lo * kl + hi * kh; }
        s = row16_sum(s); sk = row16_sum(sk); d = row16_sum(d);
        qmx = fmaxf(qmx, s); m4 = fmaxf(m4, sk); dmn = fminf(dmn, d);
        const float qn = sqrtf(s); fa = fmaxf(fa, qn * QF_K0 - d); fb = fmaxf(fb, qn * QF_K1 - d); fc = fmaxf(fc, qn * QF_K2 - d); }
      tmx[tl] = wave_max(m4); kmx = fmaxf(kmx, tmx[tl]); }
    qmx = wave_max(qmx); dmn = -wave_max(-dmn); fa = wave_max(fa); fb = wave_max(fb); fc = wave_max(fc);
    if (lane == 0) { unsigned* qk = (unsigned*)(a->ws + WS_CTL) + CW_QKMAX + 2 * bh; atomicMax(qk, __float_as_uint(qmx)); atomicMax(qk + 1, __float_as_uint(kmx));
        float* M_ = (float*)(a->ws + WS_MSM); M_[MS_QBMAX + bh * 64 + part * 8 + wave] = qmx; M_[MS_QBDMIN + bh * 64 + part * 8 + wave] = dmn;
        *(f32x4*)(M_ + MS_QBF + 4 * (bh * 64 + part * 8 + wave)) = (f32x4){fa, fb, fc, 0.f};
        *(f32x4*)(M_ + MS_KTMAX + bh * 256 + (part * 8 + wave) * 4) = (f32x4){tmx[0], tmx[1], tmx[2], tmx[3]}; }
}
__device__ __forceinline__ void fox_jlo(KA a, int gid) {
    const int bh = gid >> 6, qb = gid & 63, P0 = qb * 256;
    const float* Fs = (const float*)(a->ws + WS_FCUM) + (size_t)bh * SEQ;
    const unsigned* qk = (const unsigned*)(a->ws + WS_CTL) + CW_QKMAX + 2 * bh;
    const float* M_ = (const float*)(a->ws + WS_MSM);
    const float qn = sqrtf(M_[MS_QBMAX + gid]), dmin = M_[MS_QBDMIN + gid]; const f32x4 qf = *(const f32x4*)(M_ + MS_QBF + 4 * gid);
    auto FB = [&](float K) { float v = qn * K - dmin;
        if (K >= QF_K0 && K <= QF_K1) v = fminf(v, qf[0] + (qf[1] - qf[0]) * ((K - QF_K0) * (1.f / (QF_K1 - QF_K0))));
        else if (K > QF_K1 && K <= QF_K2) v = fminf(v, qf[1] + (qf[2] - qf[1]) * ((K - QF_K1) * (1.f / (QF_K2 - QF_K1))));
        return 0.08838834764831845f * v; };
    const float thr = FB(sqrtf(__uint_as_float(qk[1]))) + 22.f, f0 = Fs[P0];
    int lo = 0, hi = P0 / 64;
    while (lo < hi) { const int mid = (lo + hi) >> 1; const float D = (f0 - Fs[64 * mid + 63]) * 0.08838834764831845f;
        if (D < thr) hi = mid; else lo = mid + 1; }
    { const float* KT = M_ + MS_KTMAX + bh * 256; float S_ = 4.6e-6f;
      const int nt_ = P0 / 64; bool stop_ = false;
      while (lo < nt_ && !stop_) { float fv_[8], kv_[8];
#pragma unroll
          for (int k = 0; k < 8; ++k) { const int j = lo + k < nt_ ? lo + k : nt_ - 1; fv_[k] = Fs[64 * j + 63]; kv_[k] = KT[j]; }
          const int lo0_ = lo;
#pragma unroll
          for (int k = 0; k < 8; ++k) if (!stop_ && lo0_ + k < nt_) { const float D = (f0 - fv_[k]) * 0.08838834764831845f, w_ = 64.f * __expf(FB(sqrtf(kv_[k])) - D);
              if (S_ + w_ > 2.5e-4f) stop_ = true; else { S_ += w_; ++lo; } } } }
    ((int*)(a->ws + WS_MSM))[MS_JLO + gid] = lo;
#ifdef PROBE_TILESUM
    atomicAdd((unsigned*)(a->ws + WS_CTL) + 3200, (unsigned)(P0 / 64 + 4 - lo));
#endif
}

constexpr int LP = 136;
__device__ __forceinline__ float silu(float x) { return x * __builtin_amdgcn_rcpf(1.f + __expf(-x)); }
__device__ __forceinline__ void chunk_gates(KA a, int t0, int h, int lane, float& b0, float& b1, float& i0, float& i1) {
    const float* GATES = (const float*)(a->ws + WS_GATES);
    const float* g0 = GATES + (size_t)(t0 + 2 * lane) * 16; const float ib = a->i_bias[h], fb = a->f_bias[h];
    i0 = g0[8 + h] + ib; i1 = g0[16 + 8 + h] + ib;
    const float l0 = logsig(g0[12 + h] + fb), l1 = logsig(g0[16 + 12 + h] + fb);
    float sc = l0 + l1;
#pragma unroll
    for (int o = 1; o < 64; o <<= 1) { const float n = __shfl_up(sc, o); if (lane >= o) sc += n; }
    b1 = sc; b0 = sc - l1;
}
__device__ __forceinline__ void stage_vt_chunk(const bf16* MV, int t0, int col, LAS bf16* VT, int erow, int lane) {
    const bf16* p = MV + (size_t)(t0 + 2 * lane) * 1024 + col;
    const v4u r0 = *(const v4u*)p, r1 = *(const v4u*)(p + 1024);
#pragma unroll
    for (int j = 0; j < 8; ++j) { const unsigned lo = (j & 1) ? (r0[j >> 1] >> 16) : (r0[j >> 1] & 0xffffu), hi = (j & 1) ? (r1[j >> 1] >> 16) : (r1[j >> 1] & 0xffffu);
        *(LAS unsigned*)(VT + (erow + j) * LP + 2 * lane) = lo | (hi << 16); }
}

__device__ __forceinline__ void mlstm_a_unit(KA a, LAS unsigned char* lds, int u, int tid, int lane, int wave) {
    const int bh = u >> 7, c = u & 127, b = bh >> 2, h = bh & 3, t0 = b * SEQ + c * 128;
    unsigned char* ws = a->ws; float* MSM = (float*)(ws + WS_MSM);
    LAS bf16* VT = (LAS bf16*)lds;
    LAS bf16* AKT = (LAS bf16*)(lds + 256 * LP * 2);
    LAS float* AE = (LAS float*)(lds + 384 * LP * 2);
    if (wave == 0) {
        float b0, b1, i0, i1; chunk_gates(a, t0, h, lane, b0, b1, i0, i1);
        const float bl = __shfl(b1, 63);
        const float w0 = bl - b0 + i0, w1 = bl - b1 + i1;
        const float ml = wave_max(fmaxf(w0, w1));
        AE[2 * lane] = __expf(w0 - ml); AE[2 * lane + 1] = __expf(w1 - ml);
        if (lane == 0) { MSM[MS_MLOC + u] = ml; MSM[MS_BLAST + u] = bl; }
    }
    __syncthreads();
    const bf16* MV = (const bf16*)(ws + WS_MV); const bf16* MK = (const bf16*)(ws + WS_MK);
#pragma unroll
    for (int i = 0; i < 4; ++i) { const int e0 = 8 * (4 * wave + i); stage_vt_chunk(MV, t0, h * 256 + e0, VT, e0, lane); }
    const float a0 = AE[2 * lane], a1 = AE[2 * lane + 1];
#pragma unroll
    for (int i = 0; i < 2; ++i) {
        const int d0 = 8 * (2 * wave + i), ch = 512 + h * 128 + d0;
        const bf16* p = MK + (size_t)(t0 + 2 * lane - 3) * 512 + h * 128 + d0;
        v4u rr[5];
#pragma unroll
        for (int r = 0; r < 5; ++r) { if (c * 128 + 2 * lane - 3 + r >= 0) rr[r] = *(const v4u*)(p + r * 512); else rr[r] = (v4u){0u, 0u, 0u, 0u}; }
#pragma unroll
        for (int jj = 0; jj < 8; ++jj) {
            float xv[5];
#pragma unroll
            for (int r = 0; r < 5; ++r) xv[r] = (jj & 1) ? bfhi(rr[r][jj >> 1]) : bflo(rr[r][jj >> 1]);
            const float cw0 = a->conv_w[ch + jj], cw1 = a->conv_w[1024 + ch + jj], cw2 = a->conv_w[2048 + ch + jj], cw3 = a->conv_w[3072 + ch + jj], cb = a->conv_b[ch + jj];
            const float y0 = cb + cw0 * xv[0] + cw1 * xv[1] + cw2 * xv[2] + cw3 * xv[3];
            const float y1 = cb + cw0 * xv[1] + cw1 * xv[2] + cw2 * xv[3] + cw3 * xv[4];
            const float k0 = silu(y0) * 0.08838834764831845f * a0, k1 = silu(y1) * 0.08838834764831845f * a1;
            *(LAS unsigned*)(AKT + (d0 + jj) * LP + 2 * lane) = cvtpk(k0, k1);
            const float ns = wave_sum(k0 + k1);
            if (lane == 0) MSM[MS_NLOC + u * 128 + d0 + jj] = ns;
        }
    }
    __syncthreads();
    f32x4 acc[2][8];
#pragma unroll
    for (int mi = 0; mi < 2; ++mi)
#pragma unroll
        for (int ni = 0; ni < 8; ++ni) acc[mi][ni] = (f32x4){0.f, 0.f, 0.f, 0.f};
    const int fr = lane & 15, fq = lane >> 4;
#pragma unroll
    for (int ks = 0; ks < 4; ++ks) {
        bf16x8 af[2], bf_[8];
#pragma unroll
        for (int mi = 0; mi < 2; ++mi) af[mi] = *(const LAS bf16x8*)(VT + (32 * wave + 16 * mi + fr) * LP + 32 * ks + 8 * fq);
#pragma unroll
        for (int ni = 0; ni < 8; ++ni) bf_[ni] = *(const LAS bf16x8*)(AKT + (16 * ni + fr) * LP + 32 * ks + 8 * fq);
#pragma unroll
        for (int mi = 0; mi < 2; ++mi)
#pragma unroll
            for (int ni = 0; ni < 8; ++ni) acc[mi][ni] = MFMA16(bf_[ni], af[mi], acc[mi][ni]);
    }
    bf16* Cout = (bf16*)(ws + WS_MIXED) + (size_t)u * 32768;
#pragma unroll
    for (int mi = 0; mi < 2; ++mi)
#pragma unroll
        for (int ni = 0; ni < 8; ++ni) { v2u o_; o_.x = cvtpk_c(acc[mi][ni][0], acc[mi][ni][1]); o_.y = cvtpk_c(acc[mi][ni][2], acc[mi][ni][3]);
            *(GAS v2u*)(Cout + (32 * wave + 16 * mi + fr) * 128 + 16 * ni + 4 * fq) = o_; }
    __syncthreads();
}

__device__ __forceinline__ void mlstm_scan(KA a, int vcu, int G, int tid) {
    unsigned char* ws = a->ws; float* MSM = (float*)(ws + WS_MSM);
    const unsigned* __restrict__ CL = (const unsigned*)(ws + WS_MIXED); unsigned* __restrict__ CP = (unsigned*)(ws + WS_CPREV);
    const float* __restrict__ MLp = MSM + MS_MLOC; const float* __restrict__ BLp = MSM + MS_BLAST; float* __restrict__ MPp = MSM + MS_MPREV;
    const int gid = vcu * NTHR + tid, nthr = G * NTHR;
    for (int pi = gid; pi < 8 * 16384; pi += nthr) {
        const int bh = pi >> 14, i2 = pi & 16383;
        float c0 = 0.f, c1 = 0.f, m = 0.f;
        const size_t ob = (size_t)bh * 128 * 16384 + i2;
#pragma unroll 1
        for (int cb = 0; cb < NCH; cb += 8) {
            unsigned clw[8]; float mlv[8], blv[8];
#pragma unroll
            for (int k = 0; k < 8; ++k) { clw[k] = CL[ob + (size_t)(cb + k) * 16384]; mlv[k] = MLp[bh * 128 + cb + k]; blv[k] = BLp[bh * 128 + cb + k]; }
#pragma unroll
            for (int k = 0; k < 8; ++k) { const int c = cb + k;
                CP[ob + (size_t)c * 16384] = cvtpk(c0, c1);
                if (i2 == 0) MPp[bh * 128 + c] = m;
                const float mn = fmaxf(blv[k] + m, mlv[k]), ap = __expf(blv[k] + m - mn), al = __expf(mlv[k] - mn);
                c0 = ap * c0 + al * bflo(clw[k]); c1 = ap * c1 + al * bfhi(clw[k]); m = mn; }
        }
    }
    if (gid < 1024) {
        const int bh = gid >> 7, d = gid & 127; float n = 0.f, m = 0.f;
        const float* __restrict__ NLp = MSM + MS_NLOC; float* __restrict__ NPp = MSM + MS_NPREV;
#pragma unroll 1
        for (int cb = 0; cb < NCH; cb += 8) { float nlv[8], mlv[8], blv[8];
#pragma unroll
            for (int k = 0; k < 8; ++k) { nlv[k] = NLp[(bh * 128 + cb + k) * 128 + d]; mlv[k] = MLp[bh * 128 + cb + k]; blv[k] = BLp[bh * 128 + cb + k]; }
#pragma unroll
            for (int k = 0; k < 8; ++k) { NPp[(bh * 128 + cb + k) * 128 + d] = n;
                const float mn = fmaxf(blv[k] + m, mlv[k]), ap = __expf(blv[k] + m - mn), al = __expf(mlv[k] - mn);
                n = ap * n + al * nlv[k]; m = mn; } }
    }
}

__device__ __forceinline__ void vt_chunk_load(const bf16* MV, int t0, int col, int lane, v4u& r0, v4u& r1) { const bf16* p = MV + (size_t)(t0 + 2 * lane) * 1024 + col; r0 = *(const v4u*)p; r1 = *(const v4u*)(p + 1024); }
__device__ __forceinline__ void vt_chunk_write(const v4u& r0, const v4u& r1, LAS bf16* VT, int erow, int lane) {
#pragma unroll
    for (int j = 0; j < 8; ++j) { const unsigned lo = (j & 1) ? (r0[j >> 1] >> 16) : (r0[j >> 1] & 0xffffu), hi = (j & 1) ? (r1[j >> 1] >> 16) : (r1[j >> 1] & 0xffffu);
        *(LAS unsigned*)(VT + (erow + j) * LP + 2 * lane) = lo | (hi << 16); }
}
__device__ __forceinline__ void stage_conv_rows(KA a, const bf16* src, int chbase, float scale, int t0, int c, int h, LAS bf16* dst, int tid) {
    const int d0 = (tid & 15) * 8, ch = chbase + h * 128 + d0;
    float cw[4][8], cb[8];
#pragma unroll
    for (int j = 0; j < 4; ++j) { const f32x4 w0 = *(const f32x4*)(a->conv_w + j * 1024 + ch), w1 = *(const f32x4*)(a->conv_w + j * 1024 + ch + 4);
        cw[j][0] = w0.x; cw[j][1] = w0.y; cw[j][2] = w0.z; cw[j][3] = w0.w; cw[j][4] = w1.x; cw[j][5] = w1.y; cw[j][6] = w1.z; cw[j][7] = w1.w; }
    { const f32x4 w0 = *(const f32x4*)(a->conv_b + ch), w1 = *(const f32x4*)(a->conv_b + ch + 4);
      cb[0] = w0.x; cb[1] = w0.y; cb[2] = w0.z; cb[3] = w0.w; cb[4] = w1.x; cb[5] = w1.y; cb[6] = w1.z; cb[7] = w1.w; }
#pragma unroll
    for (int it = 0; it < 4; ++it) {
        const int l = (it * 512 + tid) >> 4;
        const bf16* p = src + (size_t)(t0 + l - 3) * 512 + h * 128 + d0;
        v4u rr[4];
#pragma unroll
        for (int r = 0; r < 4; ++r) { if (c * 128 + l - 3 + r >= 0) rr[r] = *(const v4u*)(p + r * 512); else rr[r] = (v4u){0u, 0u, 0u, 0u}; }
        float y[8];
#pragma unroll
        for (int jj = 0; jj < 8; ++jj) { float s = cb[jj];
#pragma unroll
            for (int r = 0; r < 4; ++r) s += cw[r][jj] * ((jj & 1) ? bfhi(rr[r][jj >> 1]) : bflo(rr[r][jj >> 1]));
            y[jj] = silu(s) * scale; }
        v4u o; o.x = cvtpk(y[0], y[1]); o.y = cvtpk(y[2], y[3]); o.z = cvtpk(y[4], y[5]); o.w = cvtpk(y[6], y[7]);
        *(LAS v4u*)(dst + l * LP + d0) = o;
    }
}
__device__ __forceinline__ void mlstm_c_unit(KA a, LAS unsigned char* lds, int u, int tid, int lane, int wave) {
    const int bh = u >> 7, c = u & 127, b = bh >> 2, h = bh & 3, t0 = b * SEQ + c * 128;
    unsigned char* ws = a->ws; const float* MSM = (const float*)(ws + WS_MSM);
    LAS bf16* QL = (LAS bf16*)lds;
    LAS bf16* KL = (LAS bf16*)(lds + 128 * LP * 2);
    LAS bf16* VTH = (LAS bf16*)(lds + 256 * LP * 2);
    LAS bf16* CTH = (LAS bf16*)(lds + 384 * LP * 2);
    LAS float* AR = (LAS float*)(lds + 512 * LP * 2);
    if (wave == 0) {
        float b0, b1, i0, i1; chunk_gates(a, t0, h, lane, b0, b1, i0, i1);
        const float c0 = i0 - b0, c1 = i1 - b1, pmx = fmaxf(c0, c1);
        float sc = pmx;
#pragma unroll
        for (int o = 1; o < 64; o <<= 1) { const float n = __shfl_up(sc, o); if (lane >= o) sc = fmaxf(sc, n); }
        float ex = __shfl_up(sc, 1); if (lane == 0) ex = -__builtin_inff();
        const float pm0 = fmaxf(ex, c0), pm1 = sc;
        const float mp = MSM[MS_MPREV + u];
        const float g0 = b0 + mp, g1 = b1 + mp, mt0 = fmaxf(g0, b0 + pm0), mt1 = fmaxf(g1, b1 + pm1);
        AR[2 * lane] = b0 - mt0; AR[2 * lane + 1] = b1 - mt1;
        AR[128 + 2 * lane] = c0; AR[128 + 2 * lane + 1] = c1;
        AR[256 + 2 * lane] = __expf(g0 - mt0); AR[256 + 2 * lane + 1] = __expf(g1 - mt1);
        AR[384 + 2 * lane] = __expf(-mt0); AR[384 + 2 * lane + 1] = __expf(-mt1);
    }
    if (tid >= 64 && tid < 192) AR[512 + tid - 64] = MSM[MS_NPREV + u * 128 + tid - 64];
    const bf16* MV = (const bf16*)(ws + WS_MV); const bf16* CP = (const bf16*)(ws + WS_CPREV) + (size_t)u * 32768;
    v4u vr_[2][2], cr_[4];
#pragma unroll
    for (int i = 0; i < 2; ++i) vt_chunk_load(MV, t0, h * 256 + 8 * (2 * wave + i), lane, vr_[i][0], vr_[i][1]);
#pragma unroll
    for (int it = 0; it < 4; ++it) { const int q = it * 512 + tid; cr_[it] = *(const v4u*)(CP + (size_t)(q >> 4) * 128 + (q & 15) * 8); }
    stage_conv_rows(a, (const bf16*)(ws + WS_MQ), 0, 1.0f, t0, c, h, QL, tid);
    stage_conv_rows(a, (const bf16*)(ws + WS_MK), 512, 0.08838834764831845f, t0, c, h, KL, tid);
#pragma unroll
    for (int i = 0; i < 2; ++i) vt_chunk_write(vr_[i][0], vr_[i][1], VTH, 8 * (2 * wave + i), lane);
#pragma unroll
    for (int it = 0; it < 4; ++it) { const int q = it * 512 + tid; *(LAS v4u*)(CTH + (q >> 4) * LP + (q & 15) * 8) = cr_[it]; }
    __syncthreads();
    const bf16* MOp = (const bf16*)(ws + WS_MO) + (size_t)(t0 + 16 * wave + (lane & 15)) * 1024 + h * 256;
    v2u mo_[2][8];
#pragma unroll
    for (int i = 0; i < 2; ++i) vt_chunk_load(MV, t0, h * 256 + 128 + 8 * (2 * wave + i), lane, vr_[i][0], vr_[i][1]);
#pragma unroll
    for (int it = 0; it < 4; ++it) { const int q = it * 512 + tid; cr_[it] = *(const v4u*)(CP + (size_t)(128 + (q >> 4)) * 128 + (q & 15) * 8); }
#pragma unroll
    for (int hf = 0; hf < 2; ++hf)
#pragma unroll
        for (int ni = 0; ni < 8; ++ni) mo_[hf][ni] = *(const v2u*)(MOp + 128 * hf + 16 * ni + 4 * (lane >> 4));
    const int fr = lane & 15, fq = lane >> 4, t = 16 * wave + fr;
    f32x4 st[8];
#pragma unroll
    for (int ni = 0; ni < 8; ++ni) st[ni] = (f32x4){0.f, 0.f, 0.f, 0.f};
    bf16x8 qf[4];
#pragma unroll
    for (int ks = 0; ks < 4; ++ks) qf[ks] = *(const LAS bf16x8*)(QL + t * LP + 32 * ks + 8 * fq);
#pragma unroll
    for (int ks = 0; ks < 4; ++ks)
#pragma unroll
        for (int ni = 0; ni < 8; ++ni) { const bf16x8 kf = *(const LAS bf16x8*)(KL + (16 * ni + fr) * LP + 32 * ks + 8 * fq); st[ni] = MFMA16(kf, qf[ks], st[ni]); }
    float qn = 0.f;
#pragma unroll
    for (int j = 0; j < 4; ++j) { const v4u qq = *(const LAS v4u*)(QL + t * LP + 32 * fq + 8 * j);
#pragma unroll
        for (int w = 0; w < 4; ++w) { qn += bflo(qq[w]) * AR[512 + 32 * fq + 8 * j + 2 * w] + bfhi(qq[w]) * AR[512 + 32 * fq + 8 * j + 2 * w + 1]; } }
    qn += __shfl_xor(qn, 16); qn += __shfl_xor(qn, 32);
    const float rc = AR[t], inter = AR[256 + t], emt = AR[384 + t];
    float rs = 0.f;
#pragma unroll
    for (int ni = 0; ni < 8; ++ni) { const f32x4 cc = *(const LAS f32x4*)(AR + 128 + 16 * ni + 4 * fq);
#pragma unroll
        for (int r = 0; r < 4; ++r) { const int s = 16 * ni + 4 * fq + r; const float wgt = (s <= t) ? __expf(rc + cc[r]) : 0.f; const float v = st[ni][r] * wgt; st[ni][r] = v; rs += v; } }
    rs += __shfl_xor(rs, 16); rs += __shfl_xor(rs, 32);
    const float den = rs + inter * qn, inv = __builtin_amdgcn_rcpf(fmaxf(fabsf(den), emt));
    __syncthreads();
#pragma unroll
    for (int ni = 0; ni < 8; ++ni) { v2u o; o.x = cvtpk(st[ni][0], st[ni][1]); o.y = cvtpk(st[ni][2], st[ni][3]); *(LAS v2u*)(KL + t * LP + 16 * ni + 4 * fq) = o; }
    f32x4 hv[2][8];
#pragma unroll
    for (int hf = 0; hf < 2; ++hf) {
        if (hf == 1) {
#pragma unroll
            for (int i = 0; i < 2; ++i) vt_chunk_write(vr_[i][0], vr_[i][1], VTH, 8 * (2 * wave + i), lane);
#pragma unroll
            for (int it = 0; it < 4; ++it) { const int q = it * 512 + tid; *(LAS v4u*)(CTH + (q >> 4) * LP + (q & 15) * 8) = cr_[it]; }
        }
        __syncthreads();
        f32x4 a1[8], a2[8];
#pragma unroll
        for (int ni = 0; ni < 8; ++ni) { a1[ni] = (f32x4){0.f, 0.f, 0.f, 0.f}; a2[ni] = (f32x4){0.f, 0.f, 0.f, 0.f}; }
#pragma unroll
        for (int ks = 0; ks < 4; ++ks) {
            const bf16x8 sf = *(const LAS bf16x8*)(KL + t * LP + 32 * ks + 8 * fq);
#pragma unroll
            for (int ni = 0; ni < 8; ++ni) { const bf16x8 vf = *(const LAS bf16x8*)(VTH + (16 * ni + fr) * LP + 32 * ks + 8 * fq); a1[ni] = MFMA16(vf, sf, a1[ni]);
                const bf16x8 cf = *(const LAS bf16x8*)(CTH + (16 * ni + fr) * LP + 32 * ks + 8 * fq); a2[ni] = MFMA16(cf, qf[ks], a2[ni]); }
        }
#pragma unroll
        for (int ni = 0; ni < 8; ++ni) hv[hf][ni] = (a1[ni] + a2[ni] * inter) * inv;
        __syncthreads();
    }
    const bf16* MO = (const bf16*)(ws + WS_MO) + (size_t)(t0 + t) * 1024 + h * 256;
    float ss = 0.f;
#pragma unroll
    for (int hf = 0; hf < 2; ++hf)
#pragma unroll
        for (int ni = 0; ni < 8; ++ni) { const v2u g = mo_[hf][ni];
            const float g0 = bflo(g.x), g1 = bfhi(g.x), g2 = bflo(g.y), g3 = bfhi(g.y);
            f32x4 v = hv[hf][ni]; v[0] *= __builtin_amdgcn_rcpf(1.f + __expf(-g0)); v[1] *= __builtin_amdgcn_rcpf(1.f + __expf(-g1)); v[2] *= __builtin_amdgcn_rcpf(1.f + __expf(-g2)); v[3] *= __builtin_amdgcn_rcpf(1.f + __expf(-g3));
            hv[hf][ni] = v; ss += (v[0] * v[0] + v[1] * v[1]) + (v[2] * v[2] + v[3] * v[3]); }
    ss += __shfl_xor(ss, 16); ss += __shfl_xor(ss, 32);
    const float rn = __builtin_amdgcn_rsqf(ss * (1.f / 256.f) + NORM_EPS);
    bf16* MX = (bf16*)(ws + WS_MIXED) + (size_t)(t0 + t) * DM + 1024 + h * 256;
#pragma unroll
    for (int hf = 0; hf < 2; ++hf)
#pragma unroll
        for (int ni = 0; ni < 8; ++ni) { const int e = 128 * hf + 16 * ni + 4 * fq; const f32x4 w = *(const f32x4*)(a->ml_nw + h * 256 + e); const f32x4 v = hv[hf][ni];
            v2u o; o.x = cvtpk(v[0] * rn * w[0], v[1] * rn * w[1]); o.y = cvtpk(v[2] * rn * w[2], v[3] * rn * w[3]); *(v2u*)(MX + e) = o; }
}
__device__ __forceinline__ int sord(float f) { const int b = __float_as_int(f); return b ^ ((b >> 31) & 0x7fffffff); }
__device__ __forceinline__ float sdec(int v) { return __int_as_float(v ^ ((v >> 31) & 0x7fffffff)); }
#define PEER_INS(L, xin) do { int x_ = (xin); _Pragma("unroll") for (int i_ = 0; i_ < 16; ++i_) { const int hi_ = max(L[i_], x_); x_ = min(L[i_], x_); L[i_] = hi_; } } while (0)
__device__ __forceinline__ float gelu_erf(float v) { return 0.5f * v * (1.f + erff(v * 0.70710678118654752f)); }

#define CE_DESC(A, i, j) do { const int hi_ = max(A[i], A[j]), lo_ = min(A[i], A[j]); A[i] = hi_; A[j] = lo_; } while (0)
#define CE_ASC(A, i, j)  do { const int hi_ = max(A[i], A[j]), lo_ = min(A[i], A[j]); A[i] = lo_; A[j] = hi_; } while (0)
#define SORT16_DESC(A) do { CE_DESC(A, 0, 1); CE_ASC(A, 2, 3); CE_DESC(A, 4, 5); CE_ASC(A, 6, 7); CE_DESC(A, 8, 9); CE_ASC(A, 10, 11); CE_DESC(A, 12, 13); CE_ASC(A, 14, 15); CE_DESC(A, 0, 2); CE_DESC(A, 1, 3); CE_ASC(A, 4, 6); CE_ASC(A, 5, 7); CE_DESC(A, 8, 10); CE_DESC(A, 9, 11); CE_ASC(A, 12, 14); CE_ASC(A, 13, 15); CE_DESC(A, 0, 1); CE_DESC(A, 2, 3); CE_ASC(A, 4, 5); CE_ASC(A, 6, 7); CE_DESC(A, 8, 9); CE_DESC(A, 10, 11); CE_ASC(A, 12, 13); CE_ASC(A, 14, 15); CE_DESC(A, 0, 4); CE_DESC(A, 1, 5); CE_DESC(A, 2, 6); CE_DESC(A, 3, 7); CE_ASC(A, 8, 12); CE_ASC(A, 9, 13); CE_ASC(A, 10, 14); CE_ASC(A, 11, 15); CE_DESC(A, 0, 2); CE_DESC(A, 1, 3); CE_DESC(A, 4, 6); CE_DESC(A, 5, 7); CE_ASC(A, 8, 10); CE_ASC(A, 9, 11); CE_ASC(A, 12, 14); CE_ASC(A, 13, 15); CE_DESC(A, 0, 1); CE_DESC(A, 2, 3); CE_DESC(A, 4, 5); CE_DESC(A, 6, 7); CE_ASC(A, 8, 9); CE_ASC(A, 10, 11); CE_ASC(A, 12, 13); CE_ASC(A, 14, 15); CE_DESC(A, 0, 8); CE_DESC(A, 1, 9); CE_DESC(A, 2, 10); CE_DESC(A, 3, 11); CE_DESC(A, 4, 12); CE_DESC(A, 5, 13); CE_DESC(A, 6, 14); CE_DESC(A, 7, 15); CE_DESC(A, 0, 4); CE_DESC(A, 1, 5); CE_DESC(A, 2, 6); CE_DESC(A, 3, 7); CE_DESC(A, 8, 12); CE_DESC(A, 9, 13); CE_DESC(A, 10, 14); CE_DESC(A, 11, 15); CE_DESC(A, 0, 2); CE_DESC(A, 1, 3); CE_DESC(A, 4, 6); CE_DESC(A, 5, 7); CE_DESC(A, 8, 10); CE_DESC(A, 9, 11); CE_DESC(A, 12, 14); CE_DESC(A, 13, 15); CE_DESC(A, 0, 1); CE_DESC(A, 2, 3); CE_DESC(A, 4, 5); CE_DESC(A, 6, 7); CE_DESC(A, 8, 9); CE_DESC(A, 10, 11); CE_DESC(A, 12, 13); CE_DESC(A, 14, 15); } while (0)
#define BMERGE16_DESC(A) do { CE_DESC(A, 0, 8); CE_DESC(A, 1, 9); CE_DESC(A, 2, 10); CE_DESC(A, 3, 11); CE_DESC(A, 4, 12); CE_DESC(A, 5, 13); CE_DESC(A, 6, 14); CE_DESC(A, 7, 15); CE_DESC(A, 0, 4); CE_DESC(A, 1, 5); CE_DESC(A, 2, 6); CE_DESC(A, 3, 7); CE_DESC(A, 8, 12); CE_DESC(A, 9, 13); CE_DESC(A, 10, 14); CE_DESC(A, 11, 15); CE_DESC(A, 0, 2); CE_DESC(A, 1, 3); CE_DESC(A, 4, 6); CE_DESC(A, 5, 7); CE_DESC(A, 8, 10); CE_DESC(A, 9, 11); CE_DESC(A, 12, 14); CE_DESC(A, 13, 15); CE_DESC(A, 0, 1); CE_DESC(A, 2, 3); CE_DESC(A, 4, 5); CE_DESC(A, 6, 7); CE_DESC(A, 8, 9); CE_DESC(A, 10, 11); CE_DESC(A, 12, 13); CE_DESC(A, 14, 15); } while (0)
#define PEER_INS_FROM(L, xin, P0) do { int x_ = (xin); _Pragma("unroll") for (int i_ = (P0); i_ < 16; ++i_) { const int hi_ = max(L[i_], x_); x_ = min(L[i_], x_); L[i_] = hi_; } } while (0)

constexpr int KLP = 136;
__device__ __forceinline__ void peer_select(KA a, const LAS bf16* KL, int t0, int lane, int wave) {
    const bf16* PQ = (const bf16*)(a->ws + WS_PQ);
    const int c = lane & 31, hh = lane >> 5;
    int AB[2][16];
#pragma unroll
    for (int p = 0; p < 2; ++p) {
        bf16x8 qf[8];
#pragma unroll
        for (int ks = 0; ks < 8; ++ks) qf[ks] = *(const bf16x8*)(PQ + (size_t)(t0 + c) * DM + wave * 256 + p * 128 + 16 * ks + 8 * hh);
        int L[16];
#pragma unroll
        for (int i = 0; i < 16; ++i) L[i] = (int)0x80000000;
#pragma unroll 1
        for (int nt = 0; nt < 4; ++nt) {
            f32x16 acc;
#pragma unroll
            for (int r = 0; r < 16; ++r) acc[r] = 0.f;
#pragma unroll
            for (int ks = 0; ks < 8; ++ks) { const bf16x8 kf = *(const LAS bf16x8*)(KL + (p * 128 + 32 * nt + c) * KLP + 16 * ks + 8 * hh); acc = MFMA32(kf, qf[ks], acc); }
            int N[16];
#pragma unroll
            for (int r = 0; r < 16; ++r) N[r] = (sord(acc[r]) & ~127) | (32 * nt + (r & 3) + 8 * (r >> 2)) | (4 * hh);
            SORT16_DESC(N);
#pragma unroll
            for (int i = 0; i < 16; ++i) L[i] = max(L[i], N[15 - i]);
            BMERGE16_DESC(L);
        }
#pragma unroll
        for (int i = 0; i < 16; ++i) { const int o = __shfl_xor(L[15 - i], 32); AB[p][i] = max(L[i], o); }
        BMERGE16_DESC(AB[p]);
    }
    float va[16], vb[16];
#pragma unroll
    for (int i = 0; i < 16; ++i) { va[i] = sdec(AB[0][i] & ~127); vb[i] = sdec(AB[1][i] & ~127); }
    int L[16];
#pragma unroll
    for (int j = 0; j < 16; ++j) L[j] = (sord(va[0] + vb[j]) & ~255) | j;
#pragma unroll
    for (int i = 1; i < 16; ++i)
#pragma unroll
        for (int j = 0; j < 16; ++j) if ((i + 1) * (j + 1) <= 16) { const int key = (sord(va[i] + vb[j]) & ~255) | (i * 16 + j); PEER_INS_FROM(L, key, (i + 1) * (j + 1) - 1); }
    float rn2;
    { const f32x4* sp = (const f32x4*)((const float*)(a->ws + WS_SSQP) + (size_t)(t0 + c) * 32); float s_ = 0.f;
#pragma unroll
      for (int i = 0; i < 8; ++i) { const f32x4 v = sp[i]; s_ += (v[0] + v[1]) + (v[2] + v[3]); }
      rn2 = __builtin_amdgcn_rsqf(s_ * (1.f / DM) + NORM_EPS); }
    float sv[16]; float mx = -__builtin_inff();
#pragma unroll
    for (int k = 0; k < 16; ++k) { sv[k] = sdec(L[k] & ~255) * rn2; mx = fmaxf(mx, sv[k]); }
    float den = 0.f;
#pragma unroll
    for (int k = 0; k < 16; ++k) { sv[k] = __expf(sv[k] - mx); den += sv[k]; }
    const float rden = 1.f / den;
    int* PEI = (int*)(a->ws + WS_PEI) + (size_t)(t0 + c) * 128 + wave * 16; float* PEG = (float*)(a->ws + WS_PEG) + (size_t)(t0 + c) * 128 + wave * 16;
    int ev[16];
#pragma unroll
    for (int k = 0; k < 16; ++k) {
        const int id = L[k] & 255, ii = id >> 4, jj = id & 15;
        int ka = 0, kb = 0;
#pragma unroll
        for (int i = 0; i < 16; ++i) { ka = (ii == i) ? AB[0][i] : ka; kb = (jj == i) ? AB[1][i] : kb; }
        ev[k] = (ka & 127) * 128 + (kb & 127);
    }
    if (hh == 0) {
#pragma unroll
        for (int k = 0; k < 16; k += 4) *(v4u*)(PEI + k) = (v4u){(unsigned)ev[k], (unsigned)ev[k + 1], (unsigned)ev[k + 2], (unsigned)ev[k + 3]};
    } else {
#pragma unroll
        for (int k = 0; k < 16; k += 4) *(f32x4*)(PEG + k) = (f32x4){sv[k] * rden, sv[k + 1] * rden, sv[k + 2] * rden, sv[k + 3] * rden};
    }
}
__device__ __forceinline__ void peer_gather_token(KA a, size_t tok, int lane, const float pscale) {
    const bf16* XN = (const bf16*)(a->ws + WS_H); const unsigned char* U8 = a->ws + WS_UB; const unsigned char* V8 = a->ws + WS_VB;
    const float* MSM = (const float*)(a->ws + WS_MSM);
    float rn2;
    { const float pr = lane < 32 ? ((const float*)(a->ws + WS_SSQP))[tok * 32 + lane] : 0.f; rn2 = __builtin_amdgcn_rsqf(wave_sum(pr) * (1.f / DM) + NORM_EPS); }
    float xr[32];
#pragma unroll
    for (int j = 0; j < 2; ++j) { const v4u p0 = *(const v4u*)(XN + tok * DM + 1024 * j + 16 * lane), p1 = *(const v4u*)(XN + tok * DM + 1024 * j + 16 * lane + 8);
#pragma unroll
        for (int w = 0; w < 4; ++w) { xr[16 * j + 2 * w] = bflo(p0[w]) * rn2; xr[16 * j + 2 * w + 1] = bfhi(p0[w]) * rn2; xr[16 * j + 8 + 2 * w] = bflo(p1[w]) * rn2; xr[16 * j + 8 + 2 * w + 1] = bfhi(p1[w]) * rn2; } }
    const v2u ei = *(const v2u*)((const int*)(a->ws + WS_PEI) + tok * 128 + 2 * lane);
    const f32x2 gi = *(const f32x2*)((const float*)(a->ws + WS_PEG) + tok * 128 + 2 * lane);
    float y[32];
#pragma unroll
    for (int i = 0; i < 32; ++i) y[i] = 0.f;
    for (int k0 = 0; k0 < 128; k0 += 4) {
        int e[4]; float g[4];
#pragma unroll
        for (int q = 0; q < 4; ++q) { const int src = (k0 + q) >> 1;
            e[q] = __builtin_amdgcn_readlane((q & 1) ? (int)ei.y : (int)ei.x, src); g[q] = __int_as_float(__builtin_amdgcn_readlane(__float_as_int((q & 1) ? gi.y : gi.x), src)); }
        v4u ur[4][2], vr[4][2];
#pragma unroll
        for (int q = 0; q < 4; ++q)
#pragma unroll
            for (int j = 0; j < 2; ++j) ur[q][j] = *(const v4u*)(U8 + (size_t)e[q] * DM + 1024 * j + 16 * lane);
#pragma unroll
        for (int q = 0; q < 4; ++q)
#pragma unroll
            for (int j = 0; j < 2; ++j) vr[q][j] = *(const v4u*)(V8 + (size_t)e[q] * DM + 1024 * j + 16 * lane);
        float act[4];
#pragma unroll
        for (int q = 0; q < 4; ++q) { float d = 0.f;
#pragma unroll
            for (int j = 0; j < 2; ++j)
#pragma unroll
                for (int w = 0; w < 4; ++w) { const f32x2 lo = __builtin_amdgcn_cvt_pk_f32_fp8((int)ur[q][j][w], false), hi = __builtin_amdgcn_cvt_pk_f32_fp8((int)ur[q][j][w], true);
                    d += lo.x * xr[16 * j + 4 * w] + lo.y * xr[16 * j + 4 * w + 1] + hi.x * xr[16 * j + 4 * w + 2] + hi.y * xr[16 * j + 4 * w + 3]; }
            d = wave_sum(d) * MSM[MS_USC + e[q]]; act[q] = gelu_erf(d) * g[q] * MSM[MS_VSC + e[q]]; }
#pragma unroll
        for (int q = 0; q < 4; ++q)
#pragma unroll
            for (int j = 0; j < 2; ++j)
#pragma unroll
                for (int w = 0; w < 4; ++w) { const f32x2 lo = __builtin_amdgcn_cvt_pk_f32_fp8((int)vr[q][j][w], false), hi = __builtin_amdgcn_cvt_pk_f32_fp8((int)vr[q][j][w], true);
                    y[16 * j + 4 * w] += act[q] * lo.x; y[16 * j + 4 * w + 1] += act[q] * lo.y; y[16 * j + 4 * w + 2] += act[q] * hi.x; y[16 * j + 4 * w + 3] += act[q] * hi.y; }
    }
    float* orow = a->out + tok * DM; float ss = 0.f;
#pragma unroll
    for (int j = 0; j < 2; ++j)
#pragma unroll
        for (int i = 0; i < 4; ++i) { const f32x4 x0 = *(const f32x4*)(orow + 1024 * j + 16 * lane + 4 * i);
            y[16 * j + 4 * i] += x0.x; y[16 * j + 4 * i + 1] += x0.y; y[16 * j + 4 * i + 2] += x0.z; y[16 * j + 4 * i + 3] += x0.w; }
#pragma unroll
    for (int i = 0; i < 32; ++i) ss += y[i] * y[i];
    const float rn = __builtin_amdgcn_rsqf(wave_sum(ss) * (1.f / DM) + NORM_EPS) * pscale;
#pragma unroll
    for (int j = 0; j < 2; ++j)
#pragma unroll
        for (int i = 0; i < 4; ++i) { const f32x4 w0 = *(const f32x4*)(a->final_w + 1024 * j + 16 * lane + 4 * i);
            *(f32x4*)(orow + 1024 * j + 16 * lane + 4 * i) = (f32x4){y[16 * j + 4 * i] * rn * w0.x, y[16 * j + 4 * i + 1] * rn * w0.y, y[16 * j + 4 * i + 2] * rn * w0.z, y[16 * j + 4 * i + 3] * rn * w0.w}; }
}

__device__ __forceinline__ float dpp_sum8(float v) {
    v += __builtin_bit_cast(float, __builtin_amdgcn_update_dpp(0, __builtin_bit_cast(int, v), 0xB1, 0xF, 0xF, true));
    v += __builtin_bit_cast(float, __builtin_amdgcn_update_dpp(0, __builtin_bit_cast(int, v), 0x4E, 0xF, 0xF, true));
    v += __builtin_bit_cast(float, __builtin_amdgcn_update_dpp(0, __builtin_bit_cast(int, v), 0x141, 0xF, 0xF, true));
    return v; }
__device__ __forceinline__ float sum_x8_16_32(float v) {
    v += __builtin_bit_cast(float, __builtin_amdgcn_update_dpp(0, __builtin_bit_cast(int, v), 0x128, 0xF, 0xF, true));
    v += __shfl_xor(v, 16); v += __shfl_xor(v, 32);
    return v; }
__device__ __forceinline__ void peer_group(KA a, LAS unsigned char* lds, int g, int tid, int lane, int wave, const bool fin_, const int t0p_, const bool last_) {
    unsigned char* ws = a->ws;
    LAS float* FW = (LAS float*)(lds + 32768);
    LAS unsigned char* CH = lds + 40960 + wave * 1024;
    LAS float* RNF = (LAS float*)(lds + 156672);
    const GAS unsigned char* U8 = (const GAS unsigned char*)(ws + WS_UB); const GAS unsigned char* V8 = (const GAS unsigned char*)(ws + WS_VB);
    const float* MSM = (const float*)(ws + WS_MSM); const bf16* XW = (const bf16*)(ws + WS_H);
    LAS unsigned short* IDX = (LAS unsigned short*)lds; LAS unsigned short* GAh = (LAS unsigned short*)(lds + 16384); LAS float* DOT = (LAS float*)(lds + 49152);
    LAS float* SSQ = (LAS float*)(lds + 81920); LAS float* RN = (LAS float*)(lds + 82176);
    const int t0 = 64 * g;
    { int pe_[16]; float pg_[16];
#pragma unroll
      for (int i = 0; i < 16; ++i) { pe_[i] = __builtin_nontemporal_load((const GAS int*)(ws + WS_PEI) + (size_t)t0 * 128 + tid + NTHR * i); pg_[i] = __builtin_nontemporal_load((const GAS float*)(ws + WS_PEG) + (size_t)t0 * 128 + tid + NTHR * i); }
#pragma unroll
      for (int i = 0; i < 16; ++i) { const int q = tid + NTHR * i; IDX[q] = (unsigned short)pe_[i]; GAh[q] = (unsigned short)(cvtpk(pg_[i], 0.f) & 0xffffu); DOT[q] = 0.f; } }
    if (tid < 64) { const f32x4* sp = (const f32x4*)((const float*)(ws + WS_SSQP) + (size_t)(t0 + tid) * 32); float s_ = 0.f;
#pragma unroll
        for (int i = 0; i < 8; ++i) { const f32x4 v = sp[i]; s_ += (v[0] + v[1]) + (v[2] + v[3]); }
        RN[tid] = __builtin_amdgcn_rsqf(s_ * (1.f / DM) + NORM_EPS); SSQ[tid] = 0.f; }
    LAS float* XF = (LAS float*)(lds + 82432);
    GAS unsigned char* XQ = (GAS unsigned char*)(ws + WS_MIXED);
    v4u px_[8][4];
#pragma unroll
    for (int tt = 0; tt < 8; ++tt) { const GAS v4u* xp = (const GAS v4u*)((const GAS bf16*)XW + (size_t)(t0 + 8 * wave + tt) * DM + 32 * lane);
#pragma unroll
        for (int j = 0; j < 4; ++j) px_[tt][j] = __builtin_nontemporal_load(xp + j); }
#pragma unroll
    for (int tt = 0; tt < 8; ++tt) { const int tok = 8 * wave + tt;
        v4u p[4]; float am = 0.f;
#pragma unroll
        for (int j = 0; j < 4; ++j) { p[j] = px_[tt][j];
#pragma unroll
            for (int w = 0; w < 4; ++w) am = fmaxf(am, fmaxf(fabsf(bflo(p[j][w])), fabsf(bfhi(p[j][w])))); }
        am = wave_max(am); const float xf = am > 0.f ? 224.f / am : 1.f;
        v4u o[2];
#pragma unroll
        for (int j = 0; j < 4; ++j)
#pragma unroll
            for (int w = 0; w < 2; ++w) { int q_ = __builtin_amdgcn_cvt_pk_fp8_f32(bflo(p[j][2 * w]) * xf, bfhi(p[j][2 * w]) * xf, 0, false);
                q_ = __builtin_amdgcn_cvt_pk_fp8_f32(bflo(p[j][2 * w + 1]) * xf, bfhi(p[j][2 * w + 1]) * xf, q_, true); o[j >> 1][2 * (j & 1) + w] = (unsigned)q_; }
        GAS v4u* qp = (GAS v4u*)(XQ + (size_t)(t0 + tok) * DM + 32 * lane); qp[0] = o[0]; qp[1] = o[1];
        if (lane == 0) XF[tok] = am > 0.f ? am * (1.f / 224.f) : 1.f; }
    VM_WAIT();
    __builtin_amdgcn_fence(__ATOMIC_ACQUIRE, "agent");
    __syncthreads();
    const int el = lane >> 3, pc = lane & 7;
#ifndef PROBE_UREP
#define PROBE_UREP 1
#endif
#pragma unroll 1
    for (int rep_ = 0; rep_ < PROBE_UREP; ++rep_)
    { const int r16 = lane & 15, g4 = lane >> 4;
      if (rep_ > 0) { for (int q = lane; q < 1024; q += 64) DOT[8 * wave * 128 + q] = 0.f; LDS_WAIT(); }
      LAS unsigned char* ring = lds + 82944 + wave * 8192;
      LAS unsigned char* XB = lds + 148480 + wave * 1024;
      const unsigned c0_ = 16u * (unsigned)(pc ^ (el >> 1));
      const int ard_ = r16 * 128 + 16 * (g4 ^ (r16 >> 1));
      const GAS unsigned char* xq_ = XQ + (size_t)(t0 + 8 * wave + el) * DM + 16 * pc;
#define PU_DMA(pass_, tt_, unit_, slot_) do { const int ib_ = (8 * wave + (tt_)) * 128 + 16 * (unit_) + el; const unsigned e0_ = IDX[ib_], e1_ = IDX[ib_ + 8];       \
        const GAS unsigned char* ub_ = U8 + 128 * (pass_);                                                                                                         \
        __builtin_amdgcn_global_load_lds((const GAS unsigned*)(ub_ + (e0_ * 2048u + c0_)), (LAS unsigned*)(ring + (slot_) * 2048), 16, 0, 0);                       \
        __builtin_amdgcn_global_load_lds((const GAS unsigned*)(ub_ + (e1_ * 2048u + (c0_ ^ 64u))), (LAS unsigned*)(ring + (slot_) * 2048 + 1024), 16, 0, 0); } while (0)
#define PU_XDMA(pass_) __builtin_amdgcn_global_load_lds((const GAS unsigned*)(xq_ + 128 * (pass_)), (LAS unsigned*)XB, 16, 0, 0)
#define PU_XREAD(D0, D1, tt_) do { D0 = *(const LAS v4u*)(XB + (tt_) * 128 + 16 * g4); D1 = *(const LAS v4u*)(XB + (tt_) * 128 + 16 * g4 + 64); } while (0)
      v4u xc0, xc1, xn0, xn1; f32x4 pacc = (f32x4){0.f, 0.f, 0.f, 0.f}; LAS f32x4* pdst = (LAS f32x4*)(DOT + 8 * wave * 128 + 4 * g4);
      PU_XDMA(0);
#pragma unroll
      for (int u_ = 0; u_ < 4; ++u_) PU_DMA(0, 0, u_, u_);
      asm volatile("s_waitcnt vmcnt(8)" ::: "memory");
      PU_XREAD(xc0, xc1, 0);
      bool first_ = true;
      for (int pass = 0; pass < 16; ++pass)
#pragma unroll 1
        for (int tt = 0; tt < 8; ++tt) {
            const int ntt = (tt + 1) & 7, npass = (pass + (tt == 7 ? 1 : 0)) & 15;
#pragma unroll
            for (int unit = 0; unit < 8; ++unit) {
                __builtin_amdgcn_sched_barrier(0);
                asm volatile("s_waitcnt vmcnt(6)" ::: "memory");
                __builtin_amdgcn_sched_barrier(0);
                if (unit == 0 && fin_ && !(tt & 1)) { const int c_ = (pass * 8 + tt) >> 1;
                    __builtin_amdgcn_global_load_lds((const GAS unsigned*)((const GAS float*)a->out + (size_t)(t0p_ + 8 * wave + (c_ >> 3)) * DM + 256 * (c_ & 7) + 4 * lane), (LAS unsigned*)CH, 16, 0, 0); }
                if (unit == 6 && fin_ && !(tt & 1)) { const int c_ = (pass * 8 + tt) >> 1;
                    const f32x4 xv_ = *(const LAS f32x4*)(CH + 16 * lane), wv_ = *(const LAS f32x4*)(FW + 256 * (c_ & 7) + 4 * lane); const float rn_ = RNF[8 * wave + (c_ >> 3)];
                    __builtin_nontemporal_store(xv_ * rn_ * wv_, (GAS f32x4*)((GAS float*)a->out + (size_t)(t0p_ + 8 * wave + (c_ >> 3)) * DM + 256 * (c_ & 7) + 4 * lane)); }
                if (unit == 0 && tt == 7) PU_XDMA(npass);
                if (unit == 4) PU_XREAD(xn0, xn1, ntt);
                LAS unsigned char* sl_ = ring + (unit & 3) * 2048;
                const v4u a0_ = *(const LAS v4u*)(sl_ + ard_), a1_ = *(const LAS v4u*)(sl_ + (ard_ ^ 64));
                LAS f32x4* dst_ = (LAS f32x4*)(DOT + (8 * wave + tt) * 128 + 16 * unit + 4 * g4);
                f32x4 acc_ = *dst_;
                typedef int v8i_ __attribute__((ext_vector_type(8)));
                const v8i_ A_ = (v8i_){(int)a0_[0], (int)a0_[1], (int)a0_[2], (int)a0_[3], (int)a1_[0], (int)a1_[1], (int)a1_[2], (int)a1_[3]};
                const v8i_ B_ = (v8i_){(int)xc0[0], (int)xc0[1], (int)xc0[2], (int)xc0[3], (int)xc1[0], (int)xc1[1], (int)xc1[2], (int)xc1[3]};
                acc_ = __builtin_amdgcn_mfma_scale_f32_16x16x128_f8f6f4(A_, B_, acc_, 0, 0, 0, 0, 0, 0);
                __builtin_amdgcn_sched_barrier(0);
                asm volatile("" ::: "memory");
                if (unit < 4) PU_DMA(pass, tt, unit + 4, unit & 3); else PU_DMA(npass, ntt, unit - 4, unit & 3);
                __builtin_amdgcn_sched_barrier(0);
                if (!first_ && r16 == 0) *pdst = pacc;
                first_ = false; pacc = acc_; pdst = dst_;
            }
            xc0 = xn0; xc1 = xn1;
        }
      if (r16 == 0) *pdst = pacc;
      VM_WAIT();
#undef PU_DMA
#undef PU_XDMA
#undef PU_XREAD
    }
    LDS_WAIT();
    LAS float* AS = (LAS float*)(lds + 82688);
    LAS unsigned char* ACT8 = (LAS unsigned char*)DOT + 4096 * wave;
    for (int tt = 0; tt < 8; ++tt) { const int tok = 8 * wave + tt, q0 = tok * 128 + lane, q1 = q0 + 64; const unsigned e0 = IDX[q0], e1 = IDX[q1]; const float xsc_ = RN[tok] * XF[tok];
        const float a0 = gelu_erf(DOT[q0] * (MSM[MS_USC + e0] * xsc_)) * __uint_as_float((unsigned)GAh[q0] << 16) * MSM[MS_VSC + e0], a1 = gelu_erf(DOT[q1] * (MSM[MS_USC + e1] * xsc_)) * __uint_as_float((unsigned)GAh[q1] << 16) * MSM[MS_VSC + e1];
        const float am = wave_max(fmaxf(fabsf(a0), fabsf(a1))); const float sc = am > 0.f ? 224.f / am : 1.f;
        const int h_ = __builtin_amdgcn_cvt_pk_fp8_f32(a0 * sc, a1 * sc, 0, false);
        const float r0 = (a0 * sc - __builtin_amdgcn_cvt_f32_fp8(h_, 0)) * 16.f, r1 = (a1 * sc - __builtin_amdgcn_cvt_f32_fp8(h_, 1)) * 16.f;
        const int l_ = __builtin_amdgcn_cvt_pk_fp8_f32(r0, r1, 0, false);
        LDS_WAIT();
        LAS unsigned char* ap = ACT8 + 256 * tt + lane;
        ap[0] = (unsigned char)(h_ & 0xff); ap[64] = (unsigned char)((h_ >> 8) & 0xff); ap[128] = (unsigned char)(l_ & 0xff); ap[192] = (unsigned char)((l_ >> 8) & 0xff);
        if (lane == 0) AS[tok] = am > 0.f ? am * (1.f / 224.f) : 1.f; }
    LDS_WAIT();
#ifndef PROBE_VREP
#define PROBE_VREP 1
#endif
#pragma unroll 1
    for (int vrep_ = 0; vrep_ < PROBE_VREP; ++vrep_)
    { LAS unsigned char* ring = lds + 82944 + wave * 8192;
      LAS unsigned char* XO = lds + 148480 + wave * 1024;
      const int r16 = lane & 15, g4 = lane >> 4;
      const unsigned c0_ = 16u * (unsigned)(pc ^ (el >> 1));
      GAS float* obase = (GAS float*)(vrep_ == PROBE_VREP - 1 ? (unsigned char*)a->out : ws + WS_MQ) + (size_t)(t0 + 8 * wave) * DM + lane;
#define PV_DMA(pass_, tt_, unit_, slot_) do { const int ib_ = (8 * wave + (tt_)) * 128 + 16 * (unit_) + el; const unsigned e0_ = IDX[ib_], e1_ = IDX[ib_ + 8];       \
        const GAS unsigned char* vb_ = V8 + 128 * (pass_);                                                                                                         \
        __builtin_amdgcn_global_load_lds((const GAS unsigned*)(vb_ + (e0_ * 2048u + c0_)), (LAS unsigned*)(ring + (slot_) * 2048), 16, 0, 0);                       \
        __builtin_amdgcn_global_load_lds((const GAS unsigned*)(vb_ + (e1_ * 2048u + (c0_ ^ 64u))), (LAS unsigned*)(ring + (slot_) * 2048 + 1024), 16, 0, 0); } while (0)
      typedef int v2i_ __attribute__((ext_vector_type(2)));
      const int rr_ = 8 * (g4 & 1) + (r16 >> 1);
      const int trb_ = (int)(unsigned long)(ring + (g4 >> 1) * 2048 + rr_ * 128 + 8 * (r16 & 1));
      int tra_[8];
#pragma unroll
      for (int t = 0; t < 8; ++t) tra_[t] = trb_ + 16 * (t ^ (rr_ >> 1));
      const LAS unsigned char* aab_ = ACT8 + 128 * (r16 & 1) + 8 * g4;
      f32x4 acc[8];
#pragma unroll
      for (int t = 0; t < 8; ++t) acc[t] = (f32x4){0.f, 0.f, 0.f, 0.f};
#pragma unroll
      for (int u_ = 0; u_ < 4; ++u_) PV_DMA(0, 0, u_, u_);
      for (int pass = 0; pass < 16; ++pass)
#pragma unroll 1
        for (int tt = 0; tt < 8; ++tt) {
            const int ntt = (tt + 1) & 7, npass = (pass + (tt == 7 ? 1 : 0)) & 15;
            const bool first_ = (pass | tt) == 0;
#pragma unroll
            for (int c = 0; c < 4; ++c) {
                __builtin_amdgcn_sched_barrier(0);
                if (c == 0) { if (first_) asm volatile("s_waitcnt vmcnt(4)" ::: "memory"); else asm volatile("s_waitcnt vmcnt(6)" ::: "memory"); }
                else if (c == 1) { if (first_) asm volatile("s_waitcnt vmcnt(5)" ::: "memory"); else asm volatile("s_waitcnt vmcnt(7)" ::: "memory"); }
                else asm volatile("s_waitcnt vmcnt(4)" ::: "memory");
                __builtin_amdgcn_sched_barrier(0);
                if (c == 0) __builtin_amdgcn_global_load_lds((const GAS unsigned*)((const GAS float*)a->out + (size_t)(t0 + 8 * wave + tt) * DM + 128 * pass + 4 * (lane & 31)), (LAS unsigned*)XO, 16, 0, 0);
                __builtin_amdgcn_sched_barrier(0);
                const v2i_ av_ = *(const LAS v2i_*)(aab_ + 256 * tt + 32 * c);
                const long A_ = (long)(((unsigned long long)(unsigned)av_[1] << 32) | (unsigned)av_[0]);
                long B_[8];
#pragma unroll
                for (int t = 0; t < 8; ++t) asm volatile("ds_read_b64_tr_b8 %0, %1 offset:%2" : "=&v"(B_[t]) : "v"(tra_[t]), "i"(4096 * (c & 1)) : "memory");
                asm volatile("s_waitcnt lgkmcnt(0)" ::: "memory");
                __builtin_amdgcn_sched_barrier(0);
#pragma unroll
                for (int t = 0; t < 8; ++t) acc[t] = __builtin_amdgcn_mfma_f32_16x16x32_fp8_fp8(A_, B_[t], acc[t], 0, 0, 0);
                __builtin_amdgcn_sched_barrier(0);
                asm volatile("" ::: "memory");
                if (c < 2) { PV_DMA(pass, tt, 2 * c + 4, 2 * (c & 1)); PV_DMA(pass, tt, 2 * c + 5, 2 * (c & 1) + 1); }
                else { PV_DMA(npass, ntt, 2 * c - 4, 2 * (c & 1)); PV_DMA(npass, ntt, 2 * c - 3, 2 * (c & 1) + 1); }
                __builtin_amdgcn_sched_barrier(0);
            }
            { const int tok_ = 8 * wave + tt; float yl_[4], yh_[4];
#pragma unroll
              for (int t = 0; t < 4; ++t) { yl_[t] = acc[t][0] + acc[t][1] * 0.0625f; yh_[t] = acc[t + 4][0] + acc[t + 4][1] * 0.0625f; }
              const float ylo_ = g4 == 0 ? yl_[0] : g4 == 1 ? yl_[1] : g4 == 2 ? yl_[2] : yl_[3], yhi_ = g4 == 0 ? yh_[0] : g4 == 1 ? yh_[1] : g4 == 2 ? yh_[2] : yh_[3];
              const float inv_ = AS[tok_]; const LAS float* xop_ = (const LAS float*)XO + lane;
              const float x0_ = xop_[0] + ylo_ * inv_, x1_ = xop_[64] + yhi_ * inv_;
              GAS float* op = obase + (size_t)tt * DM + 128 * pass; op[0] = x0_; op[64] = x1_;
              float ss = x0_ * x0_ + x1_ * x1_; ss = dpp_sum8(ss); ss = sum_x8_16_32(ss);
              if (lane == 0 && vrep_ == PROBE_VREP - 1) SSQ[tok_] += ss;
#pragma unroll
              for (int t = 0; t < 8; ++t) acc[t] = (f32x4){0.f, 0.f, 0.f, 0.f}; }
        }
      VM_WAIT();
#undef PV_DMA
    }
    VM_WAIT(); LDS_WAIT();
    __builtin_amdgcn_fence(__ATOMIC_ACQUIRE, "agent");
    if (!last_) { if (lane < 8) RNF[8 * wave + lane] = __builtin_amdgcn_rsqf(SSQ[8 * wave + lane] * (1.f / DM) + NORM_EPS); }
    else
    for (int tt = 0; tt < 8; ++tt) { const int tok = 8 * wave + tt; const float rn = __builtin_amdgcn_rsqf(SSQ[tok] * (1.f / DM) + NORM_EPS);
        float* orow = a->out + (size_t)(t0 + tok) * DM;
#pragma unroll
        for (int j = 0; j < 8; ++j) { const f32x4 x = *(const f32x4*)(orow + 256 * j + 4 * lane), w = *(const f32x4*)(a->final_w + 256 * j + 4 * lane);
            __builtin_nontemporal_store((f32x4){x[0] * rn * w[0], x[1] * rn * w[1], x[2] * rn * w[2], x[3] * rn * w[3]}, (f32x4*)(orow + 256 * j + 4 * lane)); } }
    __syncthreads();
}

constexpr int FOX_SEGT = 1024;
__global__ void __launch_bounds__(NTHR, 2) fwd_kernel(Args args) {
    extern __shared__ __attribute__((aligned(16))) unsigned char lds_raw[];
    LAS unsigned char* lds = (LAS unsigned char*)lds_raw;
    volatile LAS unsigned* MISC = (volatile LAS unsigned*)(lds + MISC_OFF);
    const int wave = __builtin_amdgcn_readfirstlane((int)threadIdx.x >> 6) & 7;
#define TIDS() const int lane = mk_lane_id(), tid = wave * 64 + lane
    const int tid0 = wave * 64 + mk_lane_id();
    const int G = gridDim.x; const int bx = blockIdx.x; const int vcu = (G % 8 == 0) ? (bx % 8) * (G / 8) + bx / 8 : bx;
    KA ka = (KA)__builtin_amdgcn_kernarg_segment_ptr();
#define KARGS(name) KA name = ka; asm volatile("" : "+s"(name))
    gu32* ctl; { KARGS(a_); ctl = (gu32*)(a_->ws + WS_CTL); }
    if (tid0 < 64) MISC[tid0] = 0u;
    __syncthreads();
    (void)xcd_barrier_post((unsigned*)ctl + CW_BAR + args.li * XCD_BAR_WORDS, MISC + 8, tid0);
#if MK_N_LAUNCHES == 1
    constexpr int lo = 0, hi = 10;
#else
    const int lo = args.ph_lo, hi = args.ph_hi;
#endif
#ifndef PH_MASK
#define PH_MASK 0x3ff
#endif
#define IN(k) (((PH_MASK >> (k)) & 1) && lo <= (k) && (k) < hi)
#define BOTH(k) (IN(k) && IN((k) + 1))
#ifdef PROBE_K
    int n_stamp = 1; unsigned long long* stamps = (unsigned long long*)(args.ws + WS_CTL + 32768);
    if (bx == 0 && tid0 == 0) stamps[0] = __builtin_amdgcn_s_memrealtime();
#define GRID_BAR() do { xcd_barrier(bar, wave * 64 + mk_lane_id()); if (bx == 0 && wave == 0 && mk_lane_id() == 0) { stamps[n_stamp] = __builtin_amdgcn_s_memrealtime(); } ++n_stamp; } while (0)
#else
#define GRID_BAR() do { KARGS(b_); XcdBarrier bb_; bb_.bar = (unsigned*)(b_->ws + WS_CTL) + CW_BAR + b_->li * XCD_BAR_WORDS; bb_.x = xb_xcc_id(); bb_.st = MISC + 8; xcd_barrier(bb_, wave * 64 + mk_lane_id()); } while (0)
#endif

    if (IN(0)) { KARGS(a_); TIDS(); p0_prologue(a_, lds, tid, lane, wave, vcu, G); if (BOTH(0)) GRID_BAR(); }

    if (IN(1)) {
        KARGS(a_); unsigned char* ws = a_->ws;
        pg8::Gemm g{(const pg8::bf16_t*)(ws + WS_H), (const pg8::bf16_t*)(ws + WS_WINT), T, NZ, DM}; pg8::StaticOrder S; S.init(T, NZ, G, bx);
        static_assert(WS_FK - WS_FQ == (1u << 26) && WS_FV - WS_FK == (1u << 26) && WS_MK - WS_MQ == (1u << 25) && WS_MO - WS_MV == (1u << 26), "EpiZ strides");
        pg8::EpiZ E{ws, WS_FQ, WS_MQ, WS_MV, WS_GATES};
        pg8::gemm_phase<pg8::EpiZ, pg8::StaticOrder, true, true>(lds, g, S, E, wave);
        if (BOTH(1)) GRID_BAR();
    }

    if (IN(2)) {
        KARGS(a_); TIDS();
        for (int s = bx; s < 16; s += G) fox_cumsum(a_, lds, s, tid, lane, wave);
        for (int w = bx; w < 128; w += G) fox_qk_norm_max(a_, w & 15, w >> 4, lane, wave);
        { unsigned* q2 = (unsigned*)(a_->ws + WS_CTL) + CW_QUEUE + 64;
          for (int u = vcu; u < 8 * NCH;) { mlstm_a_unit(a_, lds, u, tid, lane, wave);
              if (tid == 0) MISC[24] = __hip_atomic_fetch_add(q2, 1u, RLX_AGENT) + (unsigned)G;
              __syncthreads(); u = __builtin_amdgcn_readfirstlane((int)MISC[24]); } }
        if (BOTH(2)) GRID_BAR();
    }

    if (IN(3)) { KARGS(a_); TIDS(); { const int gid = bx * NTHR + tid; if (gid < 1024) fox_jlo(a_, gid); } mlstm_scan(a_, vcu, G, tid); if (BOTH(3)) GRID_BAR(); }

    if (IN(4)) {
        KARGS(a_); unsigned char* ws = a_->ws;
        unsigned* qhead = (unsigned*)(ws + WS_CTL) + CW_QUEUE;
        const int p4mode = args.pad;
        int i_cur = bx;
#ifndef NO_ATT
        if (p4mode != 2) {
            using namespace fox;
            typedef __hip_bfloat16 hb;
            static_assert(WS_FK - WS_FQ == (size_t)2 << 25 && WS_FV - WS_FK == (size_t)2 << 25 && WS_FK == FOX_WS_K && WS_MIXED == FOX_WS_O && WS_CTL == 0 && CW_SEGDONE == FOX_CW_DONE && WS_H == SLOT_LO_OFF && WS_END == SLOT_HI_OFF, "the attention body's view of the d_ws map");
            const FoxBases fb{(const float*)(ws + WS_FCUM), a_->fox_nw, ws};
            volatile LAS int* PT = (volatile LAS int*)(lds + 143360);
            if (FOX_SEGT < 260) {
                const int lane = mk_lane_id(), tid = wave * 64 + lane; const int* JLO = (const int*)(ws + WS_MSM) + MS_JLO;
                int ns[2], sl[2];
#pragma unroll
                for (int e = 0; e < 2; ++e) { const int i = 2 * tid + e, h_ = 7 - (i >> 7), b_ = i & 1, qb_ = 63 - ((i & 127) >> 1); const int nt_ = 4 * qb_ + 4 - JLO[(b_ * 8 + h_) * 64 + qb_];
                    ns[e] = (nt_ + FOX_SEGT - 1) / FOX_SEGT; sl[e] = ns[e] > 1 ? ns[e] : 0; }
                int sc = ns[0] + ns[1], sc2 = sl[0] + sl[1];
#pragma unroll
                for (int o = 1; o < 64; o <<= 1) { const int n = __shfl_up(sc, o), n2 = __shfl_up(sc2, o); if (lane >= o) { sc += n; sc2 += n2; } }
                if (lane == 63) { PT[2060 + wave] = sc; PT[2070 + wave] = sc2; }
                __syncthreads();
                int off = sc - ns[0] - ns[1], off2 = sc2 - sl[0] - sl[1];
                for (int w = 0; w < wave; ++w) { off += PT[2060 + w]; off2 += PT[2070 + w]; }
                PT[2 * tid + 1] = off + ns[0]; PT[2 * tid + 2] = off + ns[0] + ns[1]; if (tid == 0) PT[0] = 0;
                PT[1030 + 2 * tid + 1] = off2 + sl[0]; PT[1030 + 2 * tid + 2] = off2 + sl[0] + sl[1]; if (tid == 0) PT[1030] = 0;
                __syncthreads();
            }
            const int n_att = FOX_SEGT < 260 ? __builtin_amdgcn_readfirstlane(PT[1024]) : 1024;
            struct FoxNext {
                unsigned* qhead; volatile LAS unsigned* slots; volatile LAS int* PT; unsigned char* ws; int G, wave, par, n_att, p4m;
                __device__ __forceinline__ void decode(BlockRef<hb, hb>& r, int it) const {
                    int i = it, p0 = it, nseg = 1;
                    if (FOX_SEGT < 260) { int lo = 0, hi2 = 1024;
                        while (hi2 - lo > 1) { const int mid = (lo + hi2) >> 1; if (__builtin_amdgcn_readfirstlane(PT[mid]) <= it) lo = mid; else hi2 = mid; }
                        i = lo; p0 = __builtin_amdgcn_readfirstlane(PT[i]); nseg = __builtin_amdgcn_readfirstlane(PT[i + 1]) - p0; }
                    const int sg = it - p0;
                    const int h_ = 7 - (i >> 7), b_ = i & 1, qb_ = 63 - ((i & 127) >> 1), bh_ = b_ * 8 + h_;
                    const int jl = ((const int*)(ws + WS_MSM))[MS_JLO + bh_ * 64 + qb_], jh = 4 * qb_ + 4, L = (jh - jl + nseg - 1) / nseg;
                    r.P0 = qb_ * QB; r.bh = bh_; r.kvbh = p4m == 5 ? 0 : bh_; r.omib = p4m == 5 ? 128 : 0; r.jlo = jl + sg * L; r.jhi = (r.jlo + L < jh) ? r.jlo + L : jh;
                    r.kind = nseg == 1 ? 0 : (sg == nseg - 1 ? 2 : 1); r.nprev = nseg - 1; r.slot0 = FOX_SEGT < 260 ? __builtin_amdgcn_readfirstlane(PT[1030 + i]) + sg : 0; r.bi = i; }
                __device__ __forceinline__ void claim() const { if (wave == 0 && mk_lane_id() == 0) slots[par] = __hip_atomic_fetch_add(qhead, 1u, RLX_AGENT) + (unsigned)G; }
                __device__ __forceinline__ int resolve(BlockRef<hb, hb>& nxt, const BlockRef<hb, hb>& cur) const {
                    const int idx = __builtin_amdgcn_readfirstlane((int)slots[par]); if (idx < n_att) decode(nxt, idx); else nxt = cur; return idx; }
            };
            FoxNext NX{qhead, MISC + 18, PT, ws, G, wave, 0, n_att, p4mode};
            BlockRef<hb, hb> cur; NX.decode(cur, i_cur);
            Seam<hb> Sm;
            causal_swa_prime<hb, hb>(cur, fb, SEQ, (char*)lds_raw, Sm, wave);
            for (;;) {
                BlockRef<hb, hb> nxt; int nidx;
                causal_swa_block<hb, hb, FoxNext>(cur, nxt, nidx, NX, fb, SEQ, SEQ, (char*)lds_raw, Sm, wave);
                NX.par ^= 1;
                i_cur = nidx - n_att;
                if (nidx >= n_att) break;
                cur = nxt;
            }
        }
#endif
        VM_WAIT(); __syncthreads();
        if (p4mode == 2) i_cur = vcu;
        const int n_att2 = FOX_SEGT < 260 ? __builtin_amdgcn_readfirstlane(((volatile LAS int*)(lds + 143360))[1024]) : 1024;
#ifndef NO_MLC
        for (int par = 0; i_cur < 1024 && p4mode != 1 && p4mode != 5; par ^= 1) {
            const int lane = mk_lane_id(), tid = wave * 64 + lane;
            mlstm_c_unit(a_, lds, i_cur, tid, lane, wave);
            if (tid == 0) MISC[20 + par] = __hip_atomic_fetch_add(qhead, 1u, RLX_AGENT) + (unsigned)G;
            __syncthreads();
            i_cur = p4mode == 2 ? i_cur + G : __builtin_amdgcn_readfirstlane((int)MISC[20 + par]) - n_att2;
        }
#endif
        if (BOTH(4)) GRID_BAR();
    }

    if (IN(5)) {
        KARGS(a_); unsigned char* ws = a_->ws;
        pg8::Gemm g{(const pg8::bf16_t*)(ws + WS_MIXED), (const pg8::bf16_t*)(ws + WS_WOUTT), T, DM, DM}; pg8::StaticOrder S; S.init(T, DM, G, bx);
        pg8::EpiRes E{a_->x, a_->out, DM, a_->norm2_w, (pg8::bf16_t*)(ws + WS_H), (float*)(ws + WS_SSQP)};
        pg8::gemm_phase<pg8::EpiRes, pg8::StaticOrder, true, true>(lds, g, S, E, wave);
        if (BOTH(5)) GRID_BAR();
    }


    if (IN(7)) {
        KARGS(a_); unsigned char* ws = a_->ws;
        pg8::Gemm g{(const pg8::bf16_t*)(ws + WS_H), (const pg8::bf16_t*)(ws + WS_WQT), T, DM, DM}; pg8::StaticOrder S; S.init(T, DM, G, bx);
        pg8::EpiBf16<0> E{(pg8::bf16_t*)(ws + WS_PQ), DM, nullptr, 0, 0, 1.f};
        pg8::gemm_phase<pg8::EpiBf16<0>, pg8::StaticOrder, true, true>(lds, g, S, E, wave);
        if (BOTH(7)) GRID_BAR();
    }

    if (IN(8)) {
        KARGS(a_); TIDS();
        { const bf16* KEYS = (const bf16*)(a_->ws + WS_KEYS);
          for (int q = tid; q < 2 * 128 * 16; q += NTHR) { const int row = q >> 4, ch = q & 15; *(LAS v4u*)(lds + (row * KLP + ch * 8) * 2) = *(const v4u*)(KEYS + row * 128 + ch * 8); } }
        __syncthreads();
        for (int tile = vcu; tile < T / 32; tile += G) peer_select(a_, (const LAS bf16*)lds, tile * 32, lane, wave);
        if (BOTH(8)) GRID_BAR();
    }

    if (IN(9)) {
        KARGS(a_); TIDS();
#ifndef PEER_ROWGATHER
        for (int q = tid; q < 512; q += NTHR) ((LAS f32x4*)(lds + 32768))[q] = ((const GAS f32x4*)a_->final_w)[q];
        for (int it = 0; it * G < T / 64; ++it) { const int g = vcu + it * G;
            if (it > 0) GRID_BAR();
            if (g < T / 64) peer_group(a_, lds, g, tid, lane, wave, it > 0, 64 * (g - G), g + G >= T / 64); }
#else
        for (int tok = vcu * NWAVES + wave; tok < T; tok += G * NWAVES) peer_gather_token(a_, (size_t)tok, lane, 1.f);
#endif
    }
#ifdef PROBE_TILESUM
    if (IN(9) && bx == 0 && wave == 0) { KARGS(a_); const unsigned nt_ = __hip_atomic_load((unsigned*)(a_->ws + WS_CTL) + 3200, RLX_AGENT);
        const unsigned long long t0_ = __builtin_amdgcn_s_memrealtime(); while (__builtin_amdgcn_s_memrealtime() - t0_ < (unsigned long long)nt_) __builtin_amdgcn_s_sleep(8); }
#endif
#undef IN
#undef BOTH
#undef GRID_BAR
}

extern "C" void kernel_launch(void* const* d_in, const int* in_sizes, int n_in, void* d_out, int out_size, void* d_ws, size_t ws_size, hipStream_t stream) {
    static int grid = 0;
    constexpr int NPH = 10;
    if (grid == 0) {
        if (n_in != 17 || in_sizes[0] != T * DM || out_size != T * DM || ws_size < WS_NEED) { fprintf(stderr, "kernel_launch: shape/workspace mismatch (n_in %d, in0 %d, out %d, ws %zu)\n", n_in, n_in > 0 ? in_sizes[0] : -1, out_size, ws_size); grid = -1; return; }
        int dev = 0, cus = 0, per_cu = 0;
        if (hipGetDevice(&dev) != hipSuccess || hipDeviceGetAttribute(&cus, hipDeviceAttributeMultiprocessorCount, dev) != hipSuccess) { grid = -1; return; }
        if (hipFuncSetAttribute((const void*)fwd_kernel, hipFuncAttributeMaxDynamicSharedMemorySize, LDS_BYTES) != hipSuccess) { fprintf(stderr, "kernel_launch: hipFuncSetAttribute failed\n"); grid = -1; return; }
        if (hipOccupancyMaxActiveBlocksPerMultiprocessor(&per_cu, (const void*)fwd_kernel, NTHR, LDS_BYTES) != hipSuccess || per_cu < 1) { fprintf(stderr, "kernel_launch: occupancy query says %d blocks per CU\n", per_cu); (void)hipGetLastError(); grid = -1; return; }
        grid = cus;
    }
    if (grid < 0) return;
    if (hipMemsetAsync((char*)d_ws + WS_CTL, 0, CTL_ZERO_BYTES, stream) != hipSuccess) return;
    Args a{};
    a.x = (const float*)d_in[0]; a.norm1_w = (const float*)d_in[1]; a.w_in = (const float*)d_in[2]; a.fox_f_bias = (const float*)d_in[3];
    a.conv_w = (const float*)d_in[4]; a.conv_b = (const float*)d_in[5]; a.i_bias = (const float*)d_in[6]; a.f_bias = (const float*)d_in[7];
    a.fox_nw = (const float*)d_in[8]; a.ml_nw = (const float*)d_in[9]; a.w_out = (const float*)d_in[10]; a.norm2_w = (const float*)d_in[11];
    a.w_q = (const float*)d_in[12]; a.keys = (const float*)d_in[13]; a.pu = (const float*)d_in[14]; a.pv = (const float*)d_in[15]; a.final_w = (const float*)d_in[16];
    a.out = (float*)d_out; a.ws = (unsigned char*)d_ws;
#if MK_N_LAUNCHES == 1
    a.ph_lo = 0; a.ph_hi = NPH; a.li = 0; a.pad = 0;
    hipLaunchKernelGGL(fwd_kernel, dim3(grid), dim3(NTHR), LDS_BYTES, stream, a);
#elif MK_N_LAUNCHES == 2 || MK_N_LAUNCHES == 3
    { const int cuts[4] = {0, PROBE_CUT1, MK_N_LAUNCHES == 3 ? PROBE_CUT2 : NPH, NPH};
      for (int l = 0; l < MK_N_LAUNCHES; ++l) { a.ph_lo = cuts[l]; a.ph_hi = cuts[l + 1]; a.li = l; a.pad = 0; hipLaunchKernelGGL(fwd_kernel, dim3(grid), dim3(NTHR), LDS_BYTES, stream, a); } }
#else
#ifndef PROBE_MASK
#define PROBE_MASK 0
#endif
#ifndef PROBE_P4MODE
#define PROBE_P4MODE 0
#endif
    for (int p = 0; p < NPH; ++p) for (int rep = 0; rep < (((PROBE_MASK >> p) & 1) ? 2 : 1); ++rep) {
        if (p == 4) (void)hipMemsetAsync((char*)d_ws + WS_CTL + CW_QUEUE * 4, 0, 256, stream);
        a.ph_lo = p; a.ph_hi = p + 1; a.li = 0; a.pad = (p == 4 && rep == 1) ? PROBE_P4MODE : 0; hipLaunchKernelGGL(fwd_kernel, dim3(grid), dim3(NTHR), LDS_BYTES, stream, a); }
#ifdef PROBE_CUTS
#endif
#endif
}
```
